# Optimizing an MI355X kernel written in HIP

```python
import math
import jax, jax.numpy as jnp
from jax import lax
import numpy as np

D_MODEL = 1024
BATCH = 16
SEQ = 2048
DEPTH = 2

CTX_LEN = 256
GRID_W = 64
BR_W = D_MODEL
HG_H = 8
HG_DK = BR_W // HG_H
HG_DV = BR_W // HG_H
GDN_H = 8
GDN_DK = BR_W // GDN_H
GDN_DV = BR_W // GDN_H
GDN_QKV = 2 * GDN_H * GDN_DK + GDN_H * GDN_DV
ML_H = 4
ML_DV = BR_W // ML_H
ML_DK = ML_DV // 2
HG_CHUNK = 32
CHUNK = 64
CONV_K = 3
EPS = 1e-6

IN_LAYOUT = (
    ("hg_q", HG_H * HG_DK), ("hg_i", HG_H * HG_DV),
    ("hg_fg_fwd", HG_H * HG_DK), ("hg_fg_bwd", HG_H * HG_DK), ("hg_z", HG_H * HG_DV),
    ("gdn_qkv", GDN_QKV), ("gdn_z", GDN_H * GDN_DV),
    ("gdn_beta_fwd", GDN_H), ("gdn_beta_bwd", GDN_H), ("gdn_a_fwd", GDN_H), ("gdn_a_bwd", GDN_H),
    ("ml_q", ML_H * ML_DK), ("ml_k", ML_H * ML_DK), ("ml_v", ML_H * ML_DV),
    ("ml_o", ML_H * ML_DV), ("ml_z", ML_H * ML_DV),
    ("ml_ig_fwd", ML_H), ("ml_ig_bwd", ML_H), ("ml_fg_fwd", ML_H), ("ml_fg_bwd", ML_H),
    ("gate_0", D_MODEL), ("gate_1", D_MODEL), ("gate_2", D_MODEL),
)
IN_NAMES = tuple(name for name, _ in IN_LAYOUT)
IN_OFFSETS = tuple(int(o) for o in np.cumsum([w for _, w in IN_LAYOUT])[:-1])
IN_DIM = int(sum(w for _, w in IN_LAYOUT))

kernel_name = "hybrid_hgrn2_gdn_mlstm_prefix_block"

F32 = jnp.float32


def rmsnorm(x, g):
    xf = x.astype(F32)
    y = xf * lax.rsqrt(jnp.mean(xf * xf, axis=-1, keepdims=True) + EPS)
    return (y * g.astype(F32)).astype(x.dtype)


def l2norm(a):
    return a * lax.rsqrt(jnp.sum(a * a, axis=-1, keepdims=True) + EPS)


def heads(a, n):
    B, T, _ = a.shape
    return a.reshape(B, T, n, -1).transpose(0, 2, 1, 3).astype(F32)


def gates(a):
    return jnp.swapaxes(a, 1, 2).astype(F32)


def head_norm(o, g):
    B, H, T, d = o.shape
    y = rmsnorm(o, g.reshape(H, 1, d))
    return y.transpose(0, 2, 1, 3).reshape(B, T, H * d)


def to_chunks(a, size):
    B, H, T = a.shape[:3]
    return jnp.moveaxis(a.reshape(B, H, T // size, size, *a.shape[3:]), 2, 0)


def from_chunks(a):
    a = jnp.moveaxis(a, 0, 2)
    B, H, n, C = a.shape[:4]
    return a.reshape(B, H, n * C, *a.shape[4:])


def adaln(cvec, w, b):
    m = jax.nn.silu(cvec) @ w + b
    return jnp.split(m, 3, axis=-1)


def conv_grid(a, w, rows):
    B, L, C = a.shape
    y = lax.conv_general_dilated(a.reshape(B, rows, GRID_W, C), w[:, :, None, :].astype(a.dtype),
                                 (1, 1), ((1, 1), (1, 1)),
                                 dimension_numbers=("NHWC", "HWIO", "NHWC"), feature_group_count=C)
    return y.reshape(B, L, C)


def conv_seq(a, w):
    C = a.shape[-1]
    return lax.conv_general_dilated(a, w[1][:, None, :].astype(a.dtype), (1,), ((1, 1),),
                                    dimension_numbers=("NWC", "WIO", "NWC"), feature_group_count=C)


def project(h, w_in, conv_w, rows):
    proj = h @ w_in
    p = dict(zip(IN_NAMES, jnp.split(proj, IN_OFFSETS, axis=-1)))
    qkv = p["gdn_qkv"]
    qkv = conv_grid(qkv, conv_w, rows) if rows is not None else conv_seq(qkv, conv_w)
    p["gdn_qkv"] = jax.nn.silu(qkv)
    return p


def bidir(scan_fn, ctx_fwd, lat_fwd, ctx_bwd, lat_bwd, state0):
    rev = lambda arrs: tuple(jnp.flip(a, axis=2) for a in arrs)
    o_cf, s_f = scan_fn(*ctx_fwd, state0)
    o_lf, _ = scan_fn(*lat_fwd, s_f)
    o_cb, s_b = scan_fn(*rev(ctx_bwd), state0)
    o_lb, _ = scan_fn(*rev(lat_bwd), s_b)
    return o_cf + jnp.flip(o_cb, axis=2), o_lf + jnp.flip(o_lb, axis=2)


def hgrn2_scan(q, k, v, logf, s0):
    causal = jnp.tril(jnp.ones((HG_CHUNK, HG_CHUNK), dtype=bool))[:, :, None]
    b = jnp.cumsum(to_chunks(logf, HG_CHUNK), axis=-2)

    def step(S, xs):
        qc, kc, vc, bc = xs
        o = jnp.einsum('bhtd,bhdv->bhtv', qc * jnp.exp(bc), S)
        dec = jnp.exp(jnp.where(causal, bc[:, :, :, None, :] - bc[:, :, None, :, :], -jnp.inf))
        att = jnp.einsum('bhtd,bhsd,bhtsd->bhts', qc, kc, dec)
        o = o + jnp.einsum('bhts,bhsv->bhtv', att, vc)
        b_end = bc[:, :, -1:, :]
        S = jnp.exp(b_end[:, :, 0, :, None]) * S + jnp.einsum('bhsd,bhsv->bhdv', kc * jnp.exp(b_end - bc), vc)
        return S, o

    S, o = lax.scan(step, s0, (to_chunks(q, HG_CHUNK), to_chunks(k, HG_CHUNK), to_chunks(v, HG_CHUNK), b))
    return from_chunks(o), S


def hgrn2_branch(p_ctx, p_lat, lb, onorm):
    lbh = lb.reshape(HG_H, 1, HG_DK)

    def stream(p):
        q, v = heads(p["hg_q"], HG_H), heads(p["hg_i"], HG_H)
        def direction(d):
            fx = heads(p["hg_fg_" + d], HG_H)
            logf = jnp.logaddexp(jnp.log(lbh), jnp.log1p(-lbh) + jax.nn.log_sigmoid(fx))
            k = (1.0 - lbh) * jax.nn.sigmoid(-fx)
            return (q, k, v, logf)
        return direction("fwd"), direction("bwd")

    (cf, cb), (lf, lbw) = stream(p_ctx), stream(p_lat)
    B = p_ctx["hg_q"].shape[0]
    s0 = jnp.zeros((B, HG_H, HG_DK, HG_DV), F32)
    o_c, o_l = bidir(hgrn2_scan, cf, lf, cb, lbw, s0)
    fin = lambda o, p: (head_norm(o, onorm) * jax.nn.silu(p["hg_z"].astype(F32))).astype(p["hg_z"].dtype)
    return fin(o_c, p_ctx), fin(o_l, p_lat)


def gdn_scan(q, k, v, beta, g, s0):
    q, k, v = to_chunks(q, CHUNK), to_chunks(k, CHUNK), to_chunks(v, CHUNK)
    beta, g = to_chunks(beta, CHUNK), to_chunks(g, CHUNK)
    G = jnp.cumsum(g, axis=-1)
    incl = jnp.tril(jnp.ones((CHUNK, CHUNK), dtype=bool))
    strict = jnp.tril(jnp.ones((CHUNK, CHUNK), dtype=bool), -1)
    L = jnp.exp(jnp.where(incl, G[..., :, None] - G[..., None, :], -jnp.inf))
    kb = k * beta[..., None]
    A = jnp.eye(CHUNK, dtype=F32) + jnp.where(strict, jnp.einsum('...td,...sd->...ts', kb, k) * L, 0.0)
    u = lax.linalg.triangular_solve(A, v * beta[..., None], left_side=True, lower=True, unit_diagonal=True)
    w = lax.linalg.triangular_solve(A, kb * jnp.exp(G)[..., None], left_side=True, lower=True, unit_diagonal=True)
    att = jnp.einsum('...td,...sd->...ts', q, k) * L
    qd = q * jnp.exp(G)[..., None]
    kd = k * jnp.exp(G[..., -1:] - G)[..., None]
    g_end = jnp.exp(G[..., -1])

    def step(S, xs):
        qd_c, kd_c, u_c, w_c, att_c, ge_c = xs
        v_new = u_c - jnp.einsum('bhtd,bhdv->bhtv', w_c, S)
        o = jnp.einsum('bhtd,bhdv->bhtv', qd_c, S) + jnp.einsum('bhts,bhsv->bhtv', att_c, v_new)
        S = ge_c[..., None, None] * S + jnp.einsum('bhsd,bhsv->bhdv', kd_c, v_new)
        return S, o

    S, o = lax.scan(step, s0, (qd, kd, u, w, att, g_end))
    return from_chunks(o), S


def gdn_branch(p_ctx, p_lat, a_log, dt_bias, onorm):
    qk_w = GDN_H * GDN_DK

    def stream(p):
        q, k, v = jnp.split(p["gdn_qkv"], [qk_w, 2 * qk_w], axis=-1)
        q = l2norm(heads(q, GDN_H)) * (GDN_DK ** -0.5)
        k = l2norm(heads(k, GDN_H))
        v = heads(v, GDN_H)
        def direction(d, i):
            beta = jax.nn.sigmoid(gates(p["gdn_beta_" + d]))
            g = -jnp.exp(a_log[i].astype(F32))[:, None] * jax.nn.softplus(
                gates(p["gdn_a_" + d]) + dt_bias[i].astype(F32)[:, None])
            return (q, k, v, beta, g)
        return direction("fwd", 0), direction("bwd", 1)

    (cf, cb), (lf, lbw) = stream(p_ctx), stream(p_lat)
    B = p_ctx["gdn_qkv"].shape[0]
    s0 = jnp.zeros((B, GDN_H, GDN_DK, GDN_DV), F32)
    o_c, o_l = bidir(gdn_scan, cf, lf, cb, lbw, s0)
    fin = lambda o, p: (head_norm(o, onorm) * jax.nn.silu(p["gdn_z"].astype(F32))).astype(p["gdn_z"].dtype)
    return fin(o_c, p_ctx), fin(o_l, p_lat)


def mlstm_scan(q, k, v, ig, lf, state0):
    q, k, v = to_chunks(q, CHUNK), to_chunks(k, CHUNK), to_chunks(v, CHUNK)
    ig, lf = to_chunks(ig, CHUNK), to_chunks(lf, CHUNK)
    incl = jnp.tril(jnp.ones((CHUNK, CHUNK), dtype=bool))
    F = jnp.cumsum(lf, axis=-1)
    D = jnp.where(incl, F[..., :, None] - F[..., None, :] + ig[..., None, :], -jnp.inf)
    D_max = jnp.max(D, axis=-1)
    qk = jnp.einsum('...td,...sd->...ts', q, k)
    F_end = F[..., -1]
    a = F_end[..., None] - F + ig
    a_max = jnp.max(a, axis=-1)

    def step(carry, xs):
        Cs, ns, ms = carry
        q_c, k_c, v_c, F_c, D_c, Dm_c, qk_c, a_c, am_c, Fe_c = xs
        inter = F_c + ms[..., None]
        mt = jnp.maximum(inter, Dm_c)
        wi = jnp.exp(inter - mt)
        P = jnp.exp(D_c - mt[..., None]) * qk_c
        num = wi[..., None] * jnp.einsum('bhtd,bhdv->bhtv', q_c, Cs) + jnp.einsum('bhts,bhsv->bhtv', P, v_c)
        den = wi * jnp.einsum('bhtd,bhd->bht', q_c, ns) + jnp.sum(P, axis=-1)
        h = num / jnp.maximum(jnp.abs(den), jnp.exp(-mt))[..., None]
        m_new = jnp.maximum(Fe_c + ms, am_c)
        ws = jnp.exp(a_c - m_new[..., None])
        dec = jnp.exp(Fe_c + ms - m_new)
        kw = k_c * ws[..., None]
        Cs = dec[..., None, None] * Cs + jnp.einsum('bhsd,bhsv->bhdv', kw, v_c)
        ns = dec[..., None] * ns + jnp.sum(kw, axis=-2)
        return (Cs, ns, m_new), h

    state, h = lax.scan(step, state0, (q, k, v, F, D, D_max, qk, a, a_max, F_end))
    return from_chunks(h), state


def mlstm_branch(p_ctx, p_lat, i_bias, f_bias, onorm):
    def stream(p):
        q = heads(p["ml_q"], ML_H) * (ML_DK ** -0.5)
        k, v = heads(p["ml_k"], ML_H), heads(p["ml_v"], ML_H)
        def direction(d, i):
            ig = gates(p["ml_ig_" + d]) + i_bias[i].astype(F32)[:, None]
            lf = jax.nn.log_sigmoid(gates(p["ml_fg_" + d]) + f_bias[i].astype(F32)[:, None])
            return (q, k, v, ig, lf)
        return direction("fwd", 0), direction("bwd", 1)

    (cf, cb), (lf, lbw) = stream(p_ctx), stream(p_lat)
    B = p_ctx["ml_q"].shape[0]
    s0 = (jnp.zeros((B, ML_H, ML_DK, ML_DV), F32), jnp.zeros((B, ML_H, ML_DK), F32), jnp.zeros((B, ML_H), F32))
    o_c, o_l = bidir(mlstm_scan, cf, lf, cb, lbw, s0)
    fin = lambda o, p: (head_norm(o, onorm) * jax.nn.sigmoid(p["ml_o"].astype(F32))
                        * jax.nn.silu(p["ml_z"].astype(F32))).astype(p["ml_z"].dtype)
    return fin(o_c, p_ctx), fin(o_l, p_lat)


def merge(branches, p, w_br, w_o):
    y = 0.0
    for i, br in enumerate(branches):
        y = y + jax.nn.sigmoid(p["gate_%d" % i]) * (br @ w_br[i])
    return y @ w_o


def setup_inputs(seed: int = 0) -> dict:
    key = jax.random.key(seed)
    ks = jax.random.split(key, 20)
    nrm = lambda k, shape, s: jax.random.normal(k, shape, F32) * s
    dt = jnp.exp(jax.random.uniform(ks[12], (DEPTH, 2, GDN_H), F32)
                 * (math.log(0.1) - math.log(0.001)) + math.log(0.001))
    return {
        "x": nrm(ks[0], (BATCH, SEQ, D_MODEL), 1.0),
        "c": nrm(ks[1], (BATCH, D_MODEL), 1.0),
        "ctx": nrm(ks[2], (BATCH, CTX_LEN, D_MODEL), 1.0),
        "c_ctx": nrm(ks[3], (D_MODEL,), 1.0),
        "ada_w": nrm(ks[4], (DEPTH, D_MODEL, 3 * D_MODEL), 0.5 * D_MODEL ** -0.5),
        "ada_b": nrm(ks[5], (DEPTH, 3 * D_MODEL), 0.02),
        "norm_g": 1.0 + nrm(ks[6], (DEPTH, D_MODEL), 0.02),
        "w_in": nrm(ks[7], (DEPTH, D_MODEL, IN_DIM), D_MODEL ** -0.5),
        "hg_lb": nrm(ks[8], (DEPTH, HG_H * HG_DK), 1.0),
        "hg_onorm": 1.0 + nrm(ks[9], (DEPTH, HG_H * HG_DV), 0.02),
        "gdn_conv": nrm(ks[10], (DEPTH, CONV_K, CONV_K, GDN_QKV), 1.0 / CONV_K),
        "gdn_a_log": jnp.log(jax.random.uniform(ks[11], (DEPTH, 2, GDN_H), F32, 1.0, 16.0)),
        "gdn_dt_bias": dt + jnp.log(-jnp.expm1(-dt)),
        "gdn_onorm": 1.0 + nrm(ks[13], (DEPTH, GDN_H * GDN_DV), 0.02),
        "ml_i_bias": nrm(ks[14], (DEPTH, 2, ML_H), 0.1),
        "ml_f_bias": 3.0 + 3.0 * jax.random.uniform(ks[15], (DEPTH, 2, ML_H), F32),
        "ml_onorm": 1.0 + nrm(ks[16], (DEPTH, ML_H * ML_DV), 0.02),
        "w_branch": nrm(ks[17], (DEPTH, 3, BR_W, D_MODEL), BR_W ** -0.5),
        "w_out": nrm(ks[18], (DEPTH, D_MODEL, D_MODEL), D_MODEL ** -0.5),
        "final_g": 1.0 + nrm(ks[19], (D_MODEL,), 0.02),
    }


def reference(x, c, ctx, c_ctx, ada_w, ada_b, norm_g, w_in, hg_lb, hg_onorm, gdn_conv, gdn_a_log,
              gdn_dt_bias, gdn_onorm, ml_i_bias, ml_f_bias, ml_onorm, w_branch, w_out, final_g):
    rows = x.shape[1] // GRID_W
    lb_cum = jnp.cumsum(jax.nn.softmax(hg_lb.astype(F32), axis=0), axis=0)
    lower_bounds = lb_cum - lb_cum[0]
    for l in range(DEPTH):
        sh, sc, gt = adaln(c, ada_w[l], ada_b[l])
        sh_c, sc_c, gt_c = adaln(c_ctx, ada_w[l], ada_b[l])
        h = rmsnorm(x, norm_g[l]) * (1.0 + sc[:, None]) + sh[:, None]
        h_c = rmsnorm(ctx, norm_g[l]) * (1.0 + sc_c) + sh_c
        p = project(h, w_in[l], gdn_conv[l], rows)
        p_c = project(h_c, w_in[l], gdn_conv[l], None)
        a_c, a_l = hgrn2_branch(p_c, p, lower_bounds[l], hg_onorm[l])
        b_c, b_l = gdn_branch(p_c, p, gdn_a_log[l], gdn_dt_bias[l], gdn_onorm[l])
        m_c, m_l = mlstm_branch(p_c, p, ml_i_bias[l], ml_f_bias[l], ml_onorm[l])
        x = x + gt[:, None] * merge((a_l, b_l, m_l), p, w_branch[l], w_out[l])
        if l < DEPTH - 1:
            ctx = ctx + gt_c * merge((a_c, b_c, m_c), p_c, w_branch[l], w_out[l])
    return rmsnorm(x, final_g)
```

```cpp
#include <hip/hip_runtime.h>
#include <hip/hip_bf16.h>
#include <hip/hip_cooperative_groups.h>
#include <cstdio>
namespace cg = cooperative_groups;

#ifndef COOP
#define COOP 0
#endif

typedef unsigned short u16;
using bf16x8 = __attribute__((ext_vector_type(8))) short;
using f32x4 = __attribute__((ext_vector_type(4))) float;

constexpr int D = 1024;
constexpr int NB = 16;
constexpr int SEQ = 2048;
constexpr int CTX = 256;
constexpr int TPB = SEQ + CTX;
constexpr int GB = 4;
constexpr int NGRP = NB / GB;
constexpr int TG = GB * TPB;
constexpr int IN_DIM = 16432;
constexpr int NPAD = 16512;
constexpr int PLD = 16384;
constexpr int GLD = 64;
constexpr int TC = 32;
constexpr int C_HGQ = 0, C_HGI = 1024, C_HGF = 2048, C_HGZ = 4096;
constexpr int C_GQ = 5120, C_GK = 6144, C_GV = 7168, C_GZ = 8192;
constexpr int C_MQ = 9216, C_MK = 9728, C_MV = 10240, C_MO = 11264, C_MZ = 12288;
constexpr int C_GATE = 13312;

struct Params {
  const float *x, *c, *ctx, *c_ctx, *ada_w, *ada_b, *norm_g, *w_in, *hg_lb, *hg_onorm, *gdn_conv,
      *gdn_a_log, *gdn_dt_bias, *gdn_onorm, *ml_i_bias, *ml_f_bias, *ml_onorm, *w_branch, *w_out, *final_g;
  float* out;
  u16 *WinT, *WbrT, *WoT, *hbuf, *proj, *obuf;
  float *mod, *lb, *silc, *gates, *ctxs;
};

__device__ __forceinline__ u16 f2bf(float f) {
  unsigned u = __float_as_uint(f);
  u += 0x7fffu + ((u >> 16) & 1u);
  return (u16)(u >> 16);
}
__device__ __forceinline__ float bf2f(u16 h) { return __uint_as_float(((unsigned)h) << 16); }
__device__ __forceinline__ float sigmoidf_(float x) { return 1.f / (1.f + __expf(-x)); }
__device__ __forceinline__ float siluf_(float x) { return x / (1.f + __expf(-x)); }
__device__ __forceinline__ float softplusf_(float y) { return fmaxf(y, 0.f) + log1pf(__expf(-fabsf(y))); }
__device__ __forceinline__ float wave_sum(float v) {
#pragma unroll
  for (int o = 32; o >= 1; o >>= 1) v += __shfl_xor(v, o);
  return v;
}
__device__ __forceinline__ void unpack8(const uint4& u, float* f) {
  f[0] = __uint_as_float(u.x << 16); f[1] = __uint_as_float(u.x & 0xffff0000u);
  f[2] = __uint_as_float(u.y << 16); f[3] = __uint_as_float(u.y & 0xffff0000u);
  f[4] = __uint_as_float(u.z << 16); f[5] = __uint_as_float(u.z & 0xffff0000u);
  f[6] = __uint_as_float(u.w << 16); f[7] = __uint_as_float(u.w & 0xffff0000u);
}
__device__ __forceinline__ unsigned pack2(float a, float b) { return (unsigned)f2bf(a) | ((unsigned)f2bf(b) << 16); }

__device__ __forceinline__ int win_src_col(int np) {
  if (np < 9216) return np;
  if (np < 13312) return np + 32;
  if (np < 16384) return np + 48;
  if (np < 16416) return 9216 + (np - 16384);
  if (np < 16432) return 13344 + (np - 16416);
  return -1;
}

__device__ void ph_convert(const Params& p, int l, char* smem) {
  float (*tile)[65] = (float (*)[65])smem;
  const int tid = threadIdx.x;
  for (int t = blockIdx.x; t < 5152; t += gridDim.x) {
    const float* src; long sld; u16* dst; int n0, k0, kind;
    if (t < 4128) { kind = 0; n0 = (t / 16) * 64; k0 = (t % 16) * 64; src = p.w_in + (long)l * D * IN_DIM; sld = IN_DIM; dst = p.WinT; }
    else if (t < 4896) { int u = t - 4128; int i = u / 256; u %= 256; kind = 1; n0 = (u / 16) * 64; k0 = (u % 16) * 64;
      src = p.w_branch + ((long)l * 3 + i) * D * D; sld = D; dst = p.WbrT + (long)i * D * D; }
    else { int u = t - 4896; kind = 1; n0 = (u / 16) * 64; k0 = (u % 16) * 64; src = p.w_out + (long)l * D * D; sld = D; dst = p.WoT; }
#pragma unroll 4
    for (int i = 0; i < 16; ++i) {
      int kk = (tid >> 6) + 4 * i, nn = tid & 63;
      int np = n0 + nn;
      int ns = kind == 0 ? win_src_col(np) : np;
      tile[kk][nn] = ns >= 0 ? src[(long)(k0 + kk) * sld + ns] : 0.f;
    }
    __syncthreads();
#pragma unroll 4
    for (int i = 0; i < 16; ++i) {
      int nn = (tid >> 6) + 4 * i, kk = tid & 63;
      dst[(long)(n0 + nn) * D + k0 + kk] = f2bf(tile[kk][nn]);
    }
    __syncthreads();
  }
}

__device__ void ph_prep_small(const Params& p) {
  int gt = blockIdx.x * blockDim.x + threadIdx.x, gs = gridDim.x * blockDim.x;
  for (int i = gt; i < 17 * D + 2 * D; i += gs) {
    if (i < 16 * D) p.silc[i] = siluf_(p.c[i]);
    else if (i < 17 * D) p.silc[i] = siluf_(p.c_ctx[i - 16 * D]);
    else {
      int j = i - 17 * D;
      if (j < D) p.lb[j] = 0.f;
      else { int ch = j - D; p.lb[j] = sigmoidf_(p.hg_lb[D + ch] - p.hg_lb[ch]); }
    }
  }
}

__device__ void ph_mod(const Params& p, char* smem) {
  float (*red)[17][64] = (float (*)[17][64])smem;
  const int tid = threadIdx.x;
  const int kq = __builtin_amdgcn_readfirstlane(tid >> 6), cc = tid & 63;
  for (int u = blockIdx.x; u < 96; u += gridDim.x) {
    int l = u / 48, col = (u % 48) * 64 + cc;
    float acc[17];
#pragma unroll
    for (int r = 0; r < 17; ++r) acc[r] = 0.f;
    const float* w = p.ada_w + (long)l * D * 3072 + col;
    for (int k = kq * 256; k < kq * 256 + 256; ++k) {
      float wv = w[(long)k * 3072];
#pragma unroll
      for (int r = 0; r < 17; ++r) acc[r] += p.silc[r * D + k] * wv;
    }
#pragma unroll
    for (int r = 0; r < 17; ++r) red[kq][r][cc] = acc[r];
    __syncthreads();
    for (int i = tid; i < 17 * 64; i += 256) {
      int r = i / 64, c2 = i % 64;
      int colo = (u % 48) * 64 + c2;
      float s = red[0][r][c2] + red[1][r][c2] + red[2][r][c2] + red[3][r][c2] + p.ada_b[l * 3072 + colo];
      p.mod[((long)l * 17 + r) * 3072 + colo] = s;
    }
    __syncthreads();
  }
}

__device__ void ph_prenorm(const Params& p, int l, int g) {
  const int lane = threadIdx.x & 63;
  const int gw = blockIdx.x * 4 + (threadIdx.x >> 6), nw = gridDim.x * 4;
  for (int row = gw; row < TG; row += nw) {
    int bl = row / TPB, pp = row % TPB, b = g * GB + bl;
    const float* src; int mrow;
    if (pp < CTX) { src = (l == 0 ? p.ctx : p.ctxs) + ((long)b * CTX + pp) * D; mrow = 16; }
    else { src = (l == 0 ? p.x : p.out) + ((long)b * SEQ + (pp - CTX)) * D; mrow = b; }
    const float* md = p.mod + ((long)l * 17 + mrow) * 3072;
    float4 v[4]; float ss = 0.f;
#pragma unroll
    for (int i = 0; i < 4; ++i) {
      v[i] = ((const float4*)src)[lane + 64 * i];
      ss += v[i].x * v[i].x + v[i].y * v[i].y + v[i].z * v[i].z + v[i].w * v[i].w;
    }
    ss = wave_sum(ss);
    float rs = rsqrtf(ss * (1.f / D) + 1e-6f);
#pragma unroll
    for (int i = 0; i < 4; ++i) {
      int idx = (lane + 64 * i) * 4;
      float4 g4 = *(const float4*)(p.norm_g + l * D + idx);
      float4 sh = *(const float4*)(md + idx);
      float4 sc = *(const float4*)(md + D + idx);
      float h0 = v[i].x * rs * g4.x * (1.f + sc.x) + sh.x;
      float h1 = v[i].y * rs * g4.y * (1.f + sc.y) + sh.y;
      float h2 = v[i].z * rs * g4.z * (1.f + sc.z) + sh.z;
      float h3 = v[i].w * rs * g4.w * (1.f + sc.w) + sh.w;
      uint2 o; o.x = pack2(h0, h1); o.y = pack2(h2, h3);
      *(uint2*)(p.hbuf + (long)row * D + idx) = o;
    }
  }
}

__device__ __forceinline__ void gemm_kloop(const u16* Ag, long lda, const u16* Bg, long ldb, int K, char* smem, f32x4 (&acc)[4][4]) {
  const int tid = threadIdx.x;
  const int wid = tid >> 6, lane = tid & 63, wr = wid >> 1, wc = wid & 1, fr = lane & 15, fq = lane >> 4;
  char* SA = smem; char* SB = smem + 8192;
  for (int t = 0; t < K / 32; ++t) {
#pragma unroll
    for (int i = 0; i < 2; ++i) {
      int b = tid * 16 + i * 4096, r = b / 64, c = (b % 64) / 2;
      __builtin_amdgcn_global_load_lds((const unsigned*)(Ag + (long)r * lda + t * 32 + c), (__attribute__((address_space(3))) unsigned*)(SA + b), 16, 0, 0);
      __builtin_amdgcn_global_load_lds((const unsigned*)(Bg + (long)r * ldb + t * 32 + c), (__attribute__((address_space(3))) unsigned*)(SB + b), 16, 0, 0);
    }
    asm volatile("s_waitcnt vmcnt(0)" ::: "memory");
    __syncthreads();
    bf16x8 At[4], Bl[4];
#pragma unroll
    for (int m = 0; m < 4; ++m) At[m] = *(const bf16x8*)(SA + (wr * 64 + m * 16 + fr) * 64 + fq * 16);
#pragma unroll
    for (int n = 0; n < 4; ++n) Bl[n] = *(const bf16x8*)(SB + (wc * 64 + n * 16 + fr) * 64 + fq * 16);
#pragma unroll
    for (int m = 0; m < 4; ++m)
#pragma unroll
      for (int n = 0; n < 4; ++n) acc[m][n] = __builtin_amdgcn_mfma_f32_16x16x32_bf16(At[m], Bl[n], acc[m][n], 0, 0, 0);
    __syncthreads();
  }
}

__device__ void ph_gemm_in(const Params& p, char* smem) {
  const int tid = threadIdx.x;
  const int wid = tid >> 6, lane = tid & 63, wr = wid >> 1, wc = wid & 1, fr = lane & 15, fq = lane >> 4;
  for (int t = blockIdx.x; t < 72 * 129; t += gridDim.x) {
    int nt = t / 72, mt = t % 72;
    f32x4 acc[4][4];
#pragma unroll
    for (int m = 0; m < 4; ++m)
#pragma unroll
      for (int n = 0; n < 4; ++n) acc[m][n] = f32x4{0.f, 0.f, 0.f, 0.f};
    gemm_kloop(p.hbuf + (long)mt * 128 * D, D, p.WinT + (long)nt * 128 * D, D, D, smem, acc);
    if (nt < 128) {
#pragma unroll
      for (int m = 0; m < 4; ++m)
#pragma unroll
        for (int n = 0; n < 4; ++n)
#pragma unroll
          for (int j = 0; j < 4; ++j) {
            int row = mt * 128 + wr * 64 + m * 16 + fq * 4 + j, col = nt * 128 + wc * 64 + n * 16 + fr;
            p.proj[(long)row * PLD + col] = f2bf(acc[m][n][j]);
          }
    } else if (wc == 0) {
#pragma unroll
      for (int m = 0; m < 4; ++m)
#pragma unroll
        for (int n = 0; n < 4; ++n)
#pragma unroll
          for (int j = 0; j < 4; ++j) {
            int row = mt * 128 + wr * 64 + m * 16 + fq * 4 + j, col = n * 16 + fr;
            p.gates[(long)row * GLD + col] = acc[m][n][j];
          }
    }
  }
}

struct ScanSmem {
  float q[TC][128];
  float k[TC][128];
  float f[TC][128];
  float v[TC][64];
  float sc[TC][4];
};

__device__ __forceinline__ int scan_row(int bl, int dir, int pos) {
  int t;
  if (pos < CTX) t = dir ? (CTX - 1 - pos) : pos;
  else { int u = pos - CTX; t = CTX + (dir ? (SEQ - 1 - u) : u); }
  return bl * TPB + t;
}

__device__ void scan_unit(const Params& p, int l, int g, int u, ScanSmem& sm) {
  const int tid = threadIdx.x, lane = tid & 63, w = tid >> 6;
  const int j = lane & 15, gq = lane >> 4;
  const int mixer = u / 128, r = u % 128;
  int bl, h, dir, vs;
  bl = r / 32;
  if (mixer < 2) { h = (r % 32) / 4; dir = (r % 4) / 2; vs = r % 2; }
  else { h = (r % 32) / 8; dir = (r % 8) / 4; vs = r % 4; }
  int cq, ck, cv, ocol;
  if (mixer == 0) { cq = C_HGQ + h * 128; ck = C_HGF + dir * 1024 + h * 128; cv = C_HGI + h * 128 + vs * 64; ocol = h * 128 + vs * 64; }
  else if (mixer == 1) { cq = C_GQ + h * 128; ck = C_GK + h * 128; cv = C_GV + h * 128 + vs * 64; ocol = 1024 + h * 128 + vs * 64; }
  else { cq = C_MQ + h * 128; ck = C_MK + h * 128; cv = C_MV + h * 256 + vs * 64; ocol = 2048 + h * 256 + vs * 64; }

  float S[32];
#pragma unroll
  for (int i = 0; i < 32; ++i) S[i] = 0.f;
  float n0 = 0.f, n1 = 0.f;
  float mstate = 0.f;
  float gA = 0.f, gDt = 0.f, ibias = 0.f, fbias = 0.f;
  if (mixer == 1) { gA = -__expf(p.gdn_a_log[l * 16 + dir * 8 + h]); gDt = p.gdn_dt_bias[l * 16 + dir * 8 + h]; }
  if (mixer == 2) { ibias = p.ml_i_bias[l * 8 + dir * 4 + h]; fbias = p.ml_f_bias[l * 8 + dir * 4 + h]; }

  __syncthreads();
  if (mixer == 1) {
    float* cw = &sm.f[0][0];
    for (int i = tid; i < 9 * 320; i += 256) {
      int tap = i / 320, lc = i % 320;
      int ch = lc < 128 ? (h * 128 + lc) : (lc < 256 ? (1024 + h * 128 + lc - 128) : (2048 + h * 128 + vs * 64 + lc - 256));
      cw[i] = p.gdn_conv[((long)l * 9 + tap) * 3072 + ch];
    }
    __syncthreads();
  }

  for (int ch0 = 0; ch0 < TPB / TC; ++ch0) {
    const int pos0 = ch0 * TC;
    const bool is_ctx = pos0 < CTX;
    __syncthreads();
    for (int idx = tid; idx < TC * 40; idx += 256) {
      int tok = idx / 40, cgp = idx % 40;
      int row = scan_row(bl, dir, pos0 + tok);
      int col, lc;
      if (cgp < 16) { col = cq + cgp * 8; lc = cgp * 8; }
      else if (cgp < 32) { col = ck + (cgp - 16) * 8; lc = 128 + (cgp - 16) * 8; }
      else { col = cv + (cgp - 32) * 8; lc = 256 + (cgp - 32) * 8; }
      float val[8];
      if (mixer != 1) {
        uint4 raw = *(const uint4*)(p.proj + (long)row * PLD + col);
        unpack8(raw, val);
      } else {
        const float* cw = &sm.f[0][0];
#pragma unroll
        for (int e = 0; e < 8; ++e) val[e] = 0.f;
        int t = row - bl * TPB;
        if (is_ctx) {
#pragma unroll
          for (int jj = 0; jj < 3; ++jj) {
            int tt = t + jj - 1;
            if (tt >= 0 && tt < CTX) {
              uint4 raw = *(const uint4*)(p.proj + (long)(bl * TPB + tt) * PLD + col);
              float xv[8]; unpack8(raw, xv);
              const float* wv = cw + (3 + jj) * 320 + lc;
#pragma unroll
              for (int e = 0; e < 8; ++e) val[e] += xv[e] * wv[e];
            }
          }
        } else {
          int lt = t - CTX, rr0 = lt >> 6, cc0 = lt & 63;
#pragma unroll
          for (int ii = 0; ii < 3; ++ii) {
            int rr = rr0 + ii - 1;
            if (rr < 0 || rr >= 32) continue;
#pragma unroll
            for (int jj = 0; jj < 3; ++jj) {
              int cc = cc0 + jj - 1;
              if (cc < 0 || cc >= 64) continue;
              uint4 raw = *(const uint4*)(p.proj + (long)(bl * TPB + CTX + rr * 64 + cc) * PLD + col);
              float xv[8]; unpack8(raw, xv);
              const float* wv = cw + (ii * 3 + jj) * 320 + lc;
#pragma unroll
              for (int e = 0; e < 8; ++e) val[e] += xv[e] * wv[e];
            }
          }
        }
#pragma unroll
        for (int e = 0; e < 8; ++e) val[e] = siluf_(val[e]);
      }
      if (cgp < 16) {
        float scl = (mixer == 2) ? 0.08838834764831845f : 1.f;
#pragma unroll
        for (int e = 0; e < 8; ++e) sm.q[tok][lc + e] = val[e] * scl;
      } else if (cgp < 32) {
        int d0 = lc - 128;
        if (mixer == 0) {
#pragma unroll
          for (int e = 0; e < 8; ++e) {
            float lbv = p.lb[l * D + h * 128 + d0 + e];
            float f = lbv + (1.f - lbv) * sigmoidf_(val[e]);
            sm.f[tok][d0 + e] = f;
            sm.k[tok][d0 + e] = 1.f - f;
          }
        } else {
#pragma unroll
          for (int e = 0; e < 8; ++e) sm.k[tok][d0 + e] = val[e];
        }
      } else {
        int c0 = lc - 256;
#pragma unroll
        for (int e = 0; e < 8; ++e) sm.v[tok][c0 + e] = val[e];
      }
    }
    if (mixer == 2 && tid < TC) {
      int row = scan_row(bl, dir, pos0 + tid);
      float ig = p.gates[(long)row * GLD + 32 + dir * 4 + h] + ibias;
      float fx = p.gates[(long)row * GLD + 40 + dir * 4 + h] + fbias;
      sm.sc[tid][0] = ig;
      sm.sc[tid][1] = -softplusf_(-fx);
    }
    __syncthreads();
    if (mixer == 1) {
      for (int tk = w * 8; tk < w * 8 + 8; ++tk) {
        float q0 = sm.q[tk][lane], q1 = sm.q[tk][lane + 64], k0 = sm.k[tk][lane], k1 = sm.k[tk][lane + 64];
        float sq = wave_sum(q0 * q0 + q1 * q1), sk = wave_sum(k0 * k0 + k1 * k1), qk = wave_sum(q0 * k0 + q1 * k1);
        float rq = rsqrtf(sq + 1e-6f) * 0.08838834764831845f, rk = rsqrtf(sk + 1e-6f);
        sm.q[tk][lane] = q0 * rq; sm.q[tk][lane + 64] = q1 * rq;
        sm.k[tk][lane] = k0 * rk; sm.k[tk][lane + 64] = k1 * rk;
        if (lane == 0) {
          int row = scan_row(bl, dir, pos0 + tk);
          float beta = sigmoidf_(p.gates[(long)row * GLD + dir * 8 + h]);
          float gg = gA * softplusf_(p.gates[(long)row * GLD + 16 + dir * 8 + h] + gDt);
          sm.sc[tk][0] = __expf(gg); sm.sc[tk][1] = beta; sm.sc[tk][2] = qk * rq * rk;
        }
      }
      __syncthreads();
    } else if (mixer == 2) {
      if (tid == 0) {
        float m = mstate;
        for (int tk = 0; tk < TC; ++tk) {
          float ig = sm.sc[tk][0], lf = sm.sc[tk][1];
          float mn = fmaxf(lf + m, ig);
          sm.sc[tk][0] = __expf(lf + m - mn);
          sm.sc[tk][1] = __expf(ig - mn);
          sm.sc[tk][2] = __expf(-mn);
          m = mn;
        }
        mstate = m;
      }
      __syncthreads();
    }
    if (mixer == 0) {
      for (int tk = 0; tk < TC; ++tk) {
        float vj = sm.v[tk][w * 16 + j];
        const float4* qp = (const float4*)&sm.q[tk][gq * 32];
        const float4* kp = (const float4*)&sm.k[tk][gq * 32];
        const float4* fp = (const float4*)&sm.f[tk][gq * 32];
        float acc = 0.f;
#pragma unroll
        for (int i = 0; i < 8; ++i) {
          float4 q4 = qp[i], k4 = kp[i], f4 = fp[i];
          S[4 * i + 0] = f4.x * S[4 * i + 0] + k4.x * vj; acc += q4.x * S[4 * i + 0];
          S[4 * i + 1] = f4.y * S[4 * i + 1] + k4.y * vj; acc += q4.y * S[4 * i + 1];
          S[4 * i + 2] = f4.z * S[4 * i + 2] + k4.z * vj; acc += q4.z * S[4 * i + 2];
          S[4 * i + 3] = f4.w * S[4 * i + 3] + k4.w * vj; acc += q4.w * S[4 * i + 3];
        }
        acc += __shfl_xor(acc, 16); acc += __shfl_xor(acc, 32);
        if (gq == 0) sm.v[tk][w * 16 + j] = acc;
      }
    } else if (mixer == 1) {
      for (int tk = 0; tk < TC; ++tk) {
        float vj = sm.v[tk][w * 16 + j];
        float a = sm.sc[tk][0], beta = sm.sc[tk][1], qk = sm.sc[tk][2];
        const float4* qp = (const float4*)&sm.q[tk][gq * 32];
        const float4* kp = (const float4*)&sm.k[tk][gq * 32];
        float kr[32];
        float rr = 0.f, pq = 0.f;
#pragma unroll
        for (int i = 0; i < 8; ++i) {
          float4 q4 = qp[i], k4 = kp[i];
          kr[4 * i + 0] = k4.x; kr[4 * i + 1] = k4.y; kr[4 * i + 2] = k4.z; kr[4 * i + 3] = k4.w;
          rr += k4.x * S[4 * i + 0]; pq += q4.x * S[4 * i + 0];
          rr += k4.y * S[4 * i + 1]; pq += q4.y * S[4 * i + 1];
          rr += k4.z * S[4 * i + 2]; pq += q4.z * S[4 * i + 2];
          rr += k4.w * S[4 * i + 3]; pq += q4.w * S[4 * i + 3];
        }
        rr += __shfl_xor(rr, 16); pq += __shfl_xor(pq, 16);
        rr += __shfl_xor(rr, 32); pq += __shfl_xor(pq, 32);
        float vn = beta * (vj - a * rr);
        float ov = a * pq + qk * vn;
#pragma unroll
        for (int i = 0; i < 32; ++i) S[i] = a * S[i] + kr[i] * vn;
        if (gq == 0) sm.v[tk][w * 16 + j] = ov;
      }
    } else {
      for (int tk = 0; tk < TC; ++tk) {
        float vj = sm.v[tk][w * 16 + j];
        float fd = sm.sc[tk][0], iw = sm.sc[tk][1], em = sm.sc[tk][2];
        float ivj = iw * vj;
        const float4* qp = (const float4*)&sm.q[tk][gq * 32];
        const float4* kp = (const float4*)&sm.k[tk][gq * 32];
        float acc = 0.f;
#pragma unroll
        for (int i = 0; i < 8; ++i) {
          float4 q4 = qp[i], k4 = kp[i];
          S[4 * i + 0] = fd * S[4 * i + 0] + k4.x * ivj; acc += q4.x * S[4 * i + 0];
          S[4 * i + 1] = fd * S[4 * i + 1] + k4.y * ivj; acc += q4.y * S[4 * i + 1];
          S[4 * i + 2] = fd * S[4 * i + 2] + k4.z * ivj; acc += q4.z * S[4 * i + 2];
          S[4 * i + 3] = fd * S[4 * i + 3] + k4.w * ivj; acc += q4.w * S[4 * i + 3];
        }
        float2 kk = *(const float2*)&sm.k[tk][gq * 32 + 2 * j];
        float2 qq = *(const float2*)&sm.q[tk][gq * 32 + 2 * j];
        n0 = fd * n0 + iw * kk.x; n1 = fd * n1 + iw * kk.y;
        float den = n0 * qq.x + n1 * qq.y;
        den = wave_sum(den);
        acc += __shfl_xor(acc, 16); acc += __shfl_xor(acc, 32);
        if (gq == 0) sm.v[tk][w * 16 + j] = acc / fmaxf(fabsf(den), em);
      }
    }
    __syncthreads();
    {
      int tok = tid >> 3, c8 = tid & 7;
      int row = scan_row(bl, dir, pos0 + tok);
      const float* op = &sm.v[tok][c8 * 8];
      uint4 o;
      o.x = pack2(op[0], op[1]); o.y = pack2(op[2], op[3]); o.z = pack2(op[4], op[5]); o.w = pack2(op[6], op[7]);
      *(uint4*)(p.obuf + ((long)dir * TG + row) * 3072 + ocol + c8 * 8) = o;
    }
  }
}

__device__ void ph_scan(const Params& p, int l, int g, char* smem) {
  ScanSmem& sm = *(ScanSmem*)smem;
  for (int u = blockIdx.x; u < 384; u += gridDim.x) scan_unit(p, l, g, u, sm);
}

__device__ void ph_brfin(const Params& p, int l, int g) {
  const int lane = threadIdx.x & 63;
  const int gw = blockIdx.x * 4 + (threadIdx.x >> 6), nw = gridDim.x * 4;
  for (int wu = gw; wu < TG * 3; wu += nw) {
    int row = wu / 3, mixer = wu % 3;
    int pp = row % TPB;
    if (l == 1 && pp < CTX) continue;
    const u16* of = p.obuf + (long)row * 3072 + mixer * 1024 + lane * 16;
    const u16* ob = p.obuf + ((long)TG + row) * 3072 + mixer * 1024 + lane * 16;
    float o[16], t8[8];
    uint4 a0 = *(const uint4*)of, a1 = *(const uint4*)(of + 8), b0 = *(const uint4*)ob, b1 = *(const uint4*)(ob + 8);
    unpack8(a0, o); unpack8(a1, o + 8);
    unpack8(b0, t8);
#pragma unroll
    for (int e = 0; e < 8; ++e) o[e] += t8[e];
    unpack8(b1, t8);
#pragma unroll
    for (int e = 0; e < 8; ++e) o[8 + e] += t8[e];
    float ss = 0.f;
#pragma unroll
    for (int e = 0; e < 16; ++e) ss += o[e] * o[e];
    ss += __shfl_xor(ss, 1); ss += __shfl_xor(ss, 2); ss += __shfl_xor(ss, 4);
    float hd = 128.f;
    if (mixer == 2) { ss += __shfl_xor(ss, 8); hd = 256.f; }
    float rs = rsqrtf(ss / hd + 1e-6f);
    const float* on = (mixer == 0 ? p.hg_onorm : (mixer == 1 ? p.gdn_onorm : p.ml_onorm)) + l * D + lane * 16;
    int zc = mixer == 0 ? C_HGZ : (mixer == 1 ? C_GZ : C_MZ);
    const u16* zp = p.proj + (long)row * PLD + zc + lane * 16;
    float z[16];
    uint4 z0 = *(const uint4*)zp, z1 = *(const uint4*)(zp + 8);
    unpack8(z0, z); unpack8(z1, z + 8);
    float res[16];
#pragma unroll
    for (int e = 0; e < 16; ++e) res[e] = o[e] * rs * on[e] * siluf_(z[e]);
    if (mixer == 2) {
      const u16* gp = p.proj + (long)row * PLD + C_MO + lane * 16;
      uint4 g0 = *(const uint4*)gp, g1 = *(const uint4*)(gp + 8);
      unpack8(g0, z); unpack8(g1, z + 8);
#pragma unroll
      for (int e = 0; e < 16; ++e) res[e] *= sigmoidf_(z[e]);
    }
    uint4 w0, w1;
    w0.x = pack2(res[0], res[1]); w0.y = pack2(res[2], res[3]); w0.z = pack2(res[4], res[5]); w0.w = pack2(res[6], res[7]);
    w1.x = pack2(res[8], res[9]); w1.y = pack2(res[10], res[11]); w1.z = pack2(res[12], res[13]); w1.w = pack2(res[14], res[15]);
    u16* dst = p.obuf + (long)row * 3072 + mixer * 1024 + lane * 16;
    *(uint4*)dst = w0; *(uint4*)(dst + 8) = w1;
  }
}

__device__ void ph_gemm_merge(const Params& p, int l, char* smem) {
  const int tid = threadIdx.x;
  const int wid = tid >> 6, lane = tid & 63, wr = wid >> 1, wc = wid & 1, fr = lane & 15, fq = lane >> 4;
  for (int t = blockIdx.x; t < 72 * 8; t += gridDim.x) {
    int nt = t / 72, mt = t % 72;
    if (l == 1 && (mt % 18) < 2) continue;
    f32x4 tot[4][4];
#pragma unroll
    for (int m = 0; m < 4; ++m)
#pragma unroll
      for (int n = 0; n < 4; ++n) tot[m][n] = f32x4{0.f, 0.f, 0.f, 0.f};
    for (int i = 0; i < 3; ++i) {
      f32x4 acc[4][4];
#pragma unroll
      for (int m = 0; m < 4; ++m)
#pragma unroll
        for (int n = 0; n < 4; ++n) acc[m][n] = f32x4{0.f, 0.f, 0.f, 0.f};
      gemm_kloop(p.obuf + (long)mt * 128 * 3072 + i * 1024, 3072, p.WbrT + ((long)i * D + nt * 128) * D, D, D, smem, acc);
#pragma unroll
      for (int m = 0; m < 4; ++m)
#pragma unroll
        for (int n = 0; n < 4; ++n)
#pragma unroll
          for (int j = 0; j < 4; ++j) {
            int row = mt * 128 + wr * 64 + m * 16 + fq * 4 + j, col = nt * 128 + wc * 64 + n * 16 + fr;
            float gv = bf2f(p.proj[(long)row * PLD + C_GATE + i * 1024 + col]);
            tot[m][n][j] += sigmoidf_(gv) * acc[m][n][j];
          }
    }
#pragma unroll
    for (int m = 0; m < 4; ++m)
#pragma unroll
      for (int n = 0; n < 4; ++n)
#pragma unroll
        for (int j = 0; j < 4; ++j) {
          int row = mt * 128 + wr * 64 + m * 16 + fq * 4 + j, col = nt * 128 + wc * 64 + n * 16 + fr;
          p.hbuf[(long)row * D + col] = f2bf(tot[m][n][j]);
        }
  }
}

__device__ void ph_gemm_out(const Params& p, int l, int g, char* smem) {
  const int tid = threadIdx.x;
  const int wid = tid >> 6, lane = tid & 63, wr = wid >> 1, wc = wid & 1, fr = lane & 15, fq = lane >> 4;
  for (int t = blockIdx.x; t < 72 * 8; t += gridDim.x) {
    int nt = t / 72, mt = t % 72;
    if (l == 1 && (mt % 18) < 2) continue;
    f32x4 acc[4][4];
#pragma unroll
    for (int m = 0; m < 4; ++m)
#pragma unroll
      for (int n = 0; n < 4; ++n) acc[m][n] = f32x4{0.f, 0.f, 0.f, 0.f};
    gemm_kloop(p.hbuf + (long)mt * 128 * D, D, p.WoT + (long)nt * 128 * D, D, D, smem, acc);
#pragma unroll
    for (int m = 0; m < 4; ++m)
#pragma unroll
      for (int j = 0; j < 4; ++j) {
        int row = mt * 128 + wr * 64 + m * 16 + fq * 4 + j;
        int bl = row / TPB, pp = row % TPB, b = g * GB + bl;
        const float* src; float* dst; int mrow;
        if (pp < CTX) { src = p.ctx + ((long)b * CTX + pp) * D; dst = p.ctxs + ((long)b * CTX + pp) * D; mrow = 16; }
        else { long off = ((long)b * SEQ + (pp - CTX)) * D; src = (l == 0 ? p.x : p.out) + off; dst = p.out + off; mrow = b; }
        const float* gt = p.mod + ((long)l * 17 + mrow) * 3072 + 2048;
#pragma unroll
        for (int n = 0; n < 4; ++n) {
          int col = nt * 128 + wc * 64 + n * 16 + fr;
          dst[col] = src[col] + gt[col] * acc[m][n][j];
        }
      }
  }
}

__device__ void ph_final(const Params& p) {
  const int lane = threadIdx.x & 63;
  const int gw = blockIdx.x * 4 + (threadIdx.x >> 6), nw = gridDim.x * 4;
  for (int row = gw; row < NB * SEQ; row += nw) {
    float4* src = (float4*)(p.out + (long)row * D);
    float4 v[4]; float ss = 0.f;
#pragma unroll
    for (int i = 0; i < 4; ++i) {
      v[i] = src[lane + 64 * i];
      ss += v[i].x * v[i].x + v[i].y * v[i].y + v[i].z * v[i].z + v[i].w * v[i].w;
    }
    ss = wave_sum(ss);
    float rs = rsqrtf(ss * (1.f / D) + 1e-6f);
#pragma unroll
    for (int i = 0; i < 4; ++i) {
      float4 g4 = ((const float4*)p.final_g)[lane + 64 * i];
      float4 o; o.x = v[i].x * rs * g4.x; o.y = v[i].y * rs * g4.y; o.z = v[i].z * rs * g4.z; o.w = v[i].w * rs * g4.w;
      src[lane + 64 * i] = o;
    }
  }
}

constexpr int NSTEPS = 2 + 24 + 1 + 24 + 1;

__device__ void run_step(const Params& p, int step, char* smem) {
  if (step == 0) { ph_convert(p, 0, smem); ph_prep_small(p); return; }
  if (step == 1) { ph_mod(p, smem); return; }
  if (step == 26) { ph_convert(p, 1, smem); return; }
  if (step == NSTEPS - 1) { ph_final(p); return; }
  int l, s;
  if (step < 26) { l = 0; s = step - 2; } else { l = 1; s = step - 27; }
  int g = s / 6, k = s % 6;
  switch (k) {
    case 0: ph_prenorm(p, l, g); break;
    case 1: ph_gemm_in(p, smem); break;
    case 2: ph_scan(p, l, g, smem); break;
    case 3: ph_brfin(p, l, g); break;
    case 4: ph_gemm_merge(p, l, smem); break;
    case 5: ph_gemm_out(p, l, g, smem); break;
  }
}

#if !COOP
__global__ void __launch_bounds__(256, 2) k_step(Params p, int step) {
  __shared__ __attribute__((aligned(16))) char smem[sizeof(ScanSmem)];
  run_step(p, step, smem);
}
#else
__global__ void __launch_bounds__(256, 2) k_mega(Params p) {
  __shared__ __attribute__((aligned(16))) char smem[sizeof(ScanSmem)];
  cg::grid_group grid = cg::this_grid();
  for (int step = 0; step < NSTEPS; ++step) {
    run_step(p, step, smem);
    if (step + 1 < NSTEPS) grid.sync();
  }
}
#endif

extern "C" void kernel_launch(void* const* d_in, const int* in_sizes, int n_in, void* d_out, int out_size, void* d_ws,
                              size_t ws_size, hipStream_t stream) {
  Params p{};
  p.x = (const float*)d_in[0]; p.c = (const float*)d_in[1]; p.ctx = (const float*)d_in[2]; p.c_ctx = (const float*)d_in[3];
  p.ada_w = (const float*)d_in[4]; p.ada_b = (const float*)d_in[5]; p.norm_g = (const float*)d_in[6]; p.w_in = (const float*)d_in[7];
  p.hg_lb = (const float*)d_in[8]; p.hg_onorm = (const float*)d_in[9]; p.gdn_conv = (const float*)d_in[10];
  p.gdn_a_log = (const float*)d_in[11]; p.gdn_dt_bias = (const float*)d_in[12]; p.gdn_onorm = (const float*)d_in[13];
  p.ml_i_bias = (const float*)d_in[14]; p.ml_f_bias = (const float*)d_in[15]; p.ml_onorm = (const float*)d_in[16];
  p.w_branch = (const float*)d_in[17]; p.w_out = (const float*)d_in[18]; p.final_g = (const float*)d_in[19];
  p.out = (float*)d_out;
  char* ws = (char*)d_ws;
  size_t off = 0;
  auto take = [&](size_t bytes) { char* r = ws + off; off += (bytes + 255) & ~(size_t)255; return r; };
  p.WinT = (u16*)take((size_t)NPAD * D * 2);
  p.WbrT = (u16*)take((size_t)3 * D * D * 2);
  p.WoT = (u16*)take((size_t)D * D * 2);
  p.hbuf = (u16*)take((size_t)TG * D * 2);
  p.proj = (u16*)take((size_t)TG * PLD * 2);
  p.obuf = (u16*)take((size_t)2 * TG * 3072 * 2);
  p.mod = (float*)take((size_t)2 * 17 * 3072 * 4);
  p.lb = (float*)take((size_t)2 * D * 4);
  p.silc = (float*)take((size_t)17 * D * 4);
  p.gates = (float*)take((size_t)TG * GLD * 4);
  p.ctxs = (float*)take((size_t)NB * CTX * D * 4);
  if (off > ws_size) { fprintf(stderr, "workspace too small: need %zu have %zu\n", off, ws_size); return; }

  static int grid_blocks = 0;
  if (!grid_blocks) {
    int dev = 0, cus = 0, per_cu = 0;
    hipGetDevice(&dev);
    hipDeviceGetAttribute(&cus, hipDeviceAttributeMultiprocessorCount, dev);
#if COOP
    hipOccupancyMaxActiveBlocksPerMultiprocessor(&per_cu, k_mega, 256, 0);
#else
    hipOccupancyMaxActiveBlocksPerMultiprocessor(&per_cu, k_step, 256, 0);
#endif
    if (per_cu < 1) per_cu = 1;
    if (per_cu > 2) per_cu = 2;
    grid_blocks = cus * per_cu;
  }
#if COOP
  void* args[] = {&p};
  hipError_t e = hipLaunchCooperativeKernel((void*)k_mega, dim3(grid_blocks), dim3(256), args, 0, stream);
  if (e != hipSuccess) fprintf(stderr, "cooperative launch failed: %s (grid %d)\n", hipGetErrorString(e), grid_blocks);
#else
  for (int s = 0; s < NSTEPS; ++s) k_step<<<grid_blocks, 256, 0, stream>>>(p, s);
#endif
}
```

```cpp
#include <hip/hip_runtime.h>
#include <hip/hip_bf16.h>
#include <hip/hip_cooperative_groups.h>
#include <cstdio>
namespace cg = cooperative_groups;

#ifndef COOP
#define COOP 1
#endif

typedef unsigned short u16;
using bf16x8 = __attribute__((ext_vector_type(8))) short;
using f32x4 = __attribute__((ext_vector_type(4))) float;

constexpr int D = 1024;
constexpr int NB = 16;
constexpr int SEQ = 2048;
constexpr int CTX = 256;
constexpr int TPB = SEQ + CTX;
constexpr int GB = 4;
constexpr int NGRP = NB / GB;
constexpr int TG = GB * TPB;
constexpr int IN_DIM = 16432;
constexpr int NPAD = 16512;
constexpr int PLD = 16384;
constexpr int GLD = 64;
constexpr int TC = 32;
constexpr int C_HGQ = 0, C_HGI = 1024, C_HGF = 2048, C_HGZ = 4096;
constexpr int C_GQ = 5120, C_GK = 6144, C_GV = 7168, C_GZ = 8192;
constexpr int C_MQ = 9216, C_MK = 9728, C_MV = 10240, C_MO = 11264, C_MZ = 12288;
constexpr int C_GATE = 13312;

struct Params {
  const float *x, *c, *ctx, *c_ctx, *ada_w, *ada_b, *norm_g, *w_in, *hg_lb, *hg_onorm, *gdn_conv,
      *gdn_a_log, *gdn_dt_bias, *gdn_onorm, *ml_i_bias, *ml_f_bias, *ml_onorm, *w_branch, *w_out, *final_g;
  float* out;
  u16 *WinT, *WbrT, *WoT, *hbuf, *proj, *obuf;
  float *mod, *lb, *silc, *gates, *ctxs;
};

__device__ __forceinline__ u16 f2bf(float f) {
  unsigned u = __float_as_uint(f);
  u += 0x7fffu + ((u >> 16) & 1u);
  return (u16)(u >> 16);
}
__device__ __forceinline__ float bf2f(u16 h) { return __uint_as_float(((unsigned)h) << 16); }
__device__ __forceinline__ float sigmoidf_(float x) { return 1.f / (1.f + __expf(-x)); }
__device__ __forceinline__ float siluf_(float x) { return x / (1.f + __expf(-x)); }
__device__ __forceinline__ float softplusf_(float y) { return fmaxf(y, 0.f) + log1pf(__expf(-fabsf(y))); }
__device__ __forceinline__ float wave_sum(float v) {
#pragma unroll
  for (int o = 32; o >= 1; o >>= 1) v += __shfl_xor(v, o);
  return v;
}
__device__ __forceinline__ void unpack8(const uint4& u, float* f) {
  f[0] = __uint_as_float(u.x << 16); f[1] = __uint_as_float(u.x & 0xffff0000u);
  f[2] = __uint_as_float(u.y << 16); f[3] = __uint_as_float(u.y & 0xffff0000u);
  f[4] = __uint_as_float(u.z << 16); f[5] = __uint_as_float(u.z & 0xffff0000u);
  f[6] = __uint_as_float(u.w << 16); f[7] = __uint_as_float(u.w & 0xffff0000u);
}
__device__ __forceinline__ unsigned pack2(float a, float b) { return (unsigned)f2bf(a) | ((unsigned)f2bf(b) << 16); }

__device__ __forceinline__ int otid() { int t = threadIdx.x; asm volatile("" : "+v"(t)); return t; }
__device__ __forceinline__ int win_src_col(int np) {
  if (np < 9216) return np;
  if (np < 13312) return np + 32;
  if (np < 16384) return np + 48;
  if (np < 16416) return 9216 + (np - 16384);
  if (np < 16432) return 13344 + (np - 16416);
  return -1;
}

__device__ void ph_convert(const Params& p, int l, char* smem) {
  float (*tile)[65] = (float (*)[65])smem;
  const int tid = otid();
  for (int t = blockIdx.x; t < 5152; t += gridDim.x) {
    const float* src; long sld; u16* dst; int n0, k0, kind;
    if (t < 4128) { kind = 0; n0 = (t / 16) * 64; k0 = (t % 16) * 64; src = p.w_in + (long)l * D * IN_DIM; sld = IN_DIM; dst = p.WinT; }
    else if (t < 4896) { int u = t - 4128; int i = u / 256; u %= 256; kind = 1; n0 = (u / 16) * 64; k0 = (u % 16) * 64;
      src = p.w_branch + ((long)l * 3 + i) * D * D; sld = D; dst = p.WbrT + (long)i * D * D; }
    else { int u = t - 4896; kind = 1; n0 = (u / 16) * 64; k0 = (u % 16) * 64; src = p.w_out + (long)l * D * D; sld = D; dst = p.WoT; }
#pragma unroll 4
    for (int i = 0; i < 16; ++i) {
      int kk = (tid >> 6) + 4 * i, nn = tid & 63;
      int np = n0 + nn;
      int ns = kind == 0 ? win_src_col(np) : np;
      tile[kk][nn] = ns >= 0 ? src[(long)(k0 + kk) * sld + ns] : 0.f;
    }
    __syncthreads();
#pragma unroll 4
    for (int i = 0; i < 16; ++i) {
      int nn = (tid >> 6) + 4 * i, kk = tid & 63;
      dst[(long)(n0 + nn) * D + k0 + kk] = f2bf(tile[kk][nn]);
    }
    __syncthreads();
  }
}

__device__ void ph_prep_small(const Params& p) {
  int gt = blockIdx.x * blockDim.x + otid(), gs = gridDim.x * blockDim.x;
  for (int i = gt; i < 17 * D + 2 * D; i += gs) {
    if (i < 16 * D) p.silc[i] = siluf_(p.c[i]);
    else if (i < 17 * D) p.silc[i] = siluf_(p.c_ctx[i - 16 * D]);
    else {
      int j = i - 17 * D;
      if (j < D) p.lb[j] = 0.f;
      else { int ch = j - D; p.lb[j] = sigmoidf_(p.hg_lb[D + ch] - p.hg_lb[ch]); }
    }
  }
}

__device__ void ph_mod(const Params& p, char* smem) {
  float (*red)[17][64] = (float (*)[17][64])smem;
  const int tid = otid();
  const int kq = __builtin_amdgcn_readfirstlane(tid >> 6), cc = tid & 63;
  for (int u = blockIdx.x; u < 96; u += gridDim.x) {
    int l = u / 48, col = (u % 48) * 64 + cc;
    float acc[17];
#pragma unroll
    for (int r = 0; r < 17; ++r) acc[r] = 0.f;
    const float* w = p.ada_w + (long)l * D * 3072 + col;
    for (int k = kq * 256; k < kq * 256 + 256; ++k) {
      float wv = w[(long)k * 3072];
#pragma unroll
      for (int r = 0; r < 17; ++r) acc[r] += p.silc[r * D + k] * wv;
    }
#pragma unroll
    for (int r = 0; r < 17; ++r) red[kq][r][cc] = acc[r];
    __syncthreads();
    for (int i = tid; i < 17 * 64; i += 256) {
      int r = i / 64, c2 = i % 64;
      int colo = (u % 48) * 64 + c2;
      float s = red[0][r][c2] + red[1][r][c2] + red[2][r][c2] + red[3][r][c2] + p.ada_b[l * 3072 + colo];
      p.mod[((long)l * 17 + r) * 3072 + colo] = s;
    }
    __syncthreads();
  }
}

__device__ void ph_prenorm(const Params& p, int l, int g) {
  const int tid = otid();
  const int lane = tid & 63;
  const int gw = blockIdx.x * 4 + (tid >> 6), nw = gridDim.x * 4;
  for (int row = gw; row < TG; row += nw) {
    int bl = row / TPB, pp = row % TPB, b = g * GB + bl;
    const float* src; int mrow;
    if (pp < CTX) { src = (l == 0 ? p.ctx : p.ctxs) + ((long)b * CTX + pp) * D; mrow = 16; }
    else { src = (l == 0 ? p.x : p.out) + ((long)b * SEQ + (pp - CTX)) * D; mrow = b; }
    const float* md = p.mod + ((long)l * 17 + mrow) * 3072;
    float4 v[4]; float ss = 0.f;
#pragma unroll
    for (int i = 0; i < 4; ++i) {
      v[i] = ((const float4*)src)[lane + 64 * i];
      ss += v[i].x * v[i].x + v[i].y * v[i].y + v[i].z * v[i].z + v[i].w * v[i].w;
    }
    ss = wave_sum(ss);
    float rs = rsqrtf(ss * (1.f / D) + 1e-6f);
#pragma unroll
    for (int i = 0; i < 4; ++i) {
      int idx = (lane + 64 * i) * 4;
      float4 g4 = *(const float4*)(p.norm_g + l * D + idx);
      float4 sh = *(const float4*)(md + idx);
      float4 sc = *(const float4*)(md + D + idx);
      float h0 = v[i].x * rs * g4.x * (1.f + sc.x) + sh.x;
      float h1 = v[i].y * rs * g4.y * (1.f + sc.y) + sh.y;
      float h2 = v[i].z * rs * g4.z * (1.f + sc.z) + sh.z;
      float h3 = v[i].w * rs * g4.w * (1.f + sc.w) + sh.w;
      uint2 o; o.x = pack2(h0, h1); o.y = pack2(h2, h3);
      *(uint2*)(p.hbuf + (long)row * D + idx) = o;
    }
  }
}

template <int NF>
__device__ __forceinline__ void gemm_kloop(const u16* Ag, long lda, const u16* Bg, long ldb, int K, char* smem, f32x4 (&acc)[4][NF]) {
  const int tid = otid();
  const int wid = tid >> 6, lane = tid & 63, wr = wid >> 1, wc = wid & 1, fr = lane & 15, fq = lane >> 4;
  char* SA = smem; char* SB = smem + 8192;
  for (int t = 0; t < K / 32; ++t) {
#pragma unroll
    for (int i = 0; i < 2; ++i) {
      int b = tid * 16 + i * 4096, r = b / 64, c = (b % 64) / 2;
      __builtin_amdgcn_global_load_lds((const unsigned*)(Ag + (long)r * lda + t * 32 + c), (__attribute__((address_space(3))) unsigned*)(SA + b), 16, 0, 0);
      if (NF == 4 || i == 0)
        __builtin_amdgcn_global_load_lds((const unsigned*)(Bg + (long)r * ldb + t * 32 + c), (__attribute__((address_space(3))) unsigned*)(SB + b), 16, 0, 0);
    }
    asm volatile("s_waitcnt vmcnt(0)" ::: "memory");
    __syncthreads();
    bf16x8 At[4], Bl[NF];
#pragma unroll
    for (int m = 0; m < 4; ++m) At[m] = *(const bf16x8*)(SA + (wr * 64 + m * 16 + fr) * 64 + fq * 16);
#pragma unroll
    for (int n = 0; n < NF; ++n) Bl[n] = *(const bf16x8*)(SB + (wc * NF * 16 + n * 16 + fr) * 64 + fq * 16);
#pragma unroll
    for (int m = 0; m < 4; ++m)
#pragma unroll
      for (int n = 0; n < NF; ++n) acc[m][n] = __builtin_amdgcn_mfma_f32_16x16x32_bf16(At[m], Bl[n], acc[m][n], 0, 0, 0);
    __syncthreads();
  }
}

__device__ void ph_gemm_in(const Params& p, char* smem) {
  const int tid = otid();
  const int wid = tid >> 6, lane = tid & 63, wr = wid >> 1, wc = wid & 1, fr = lane & 15, fq = lane >> 4;
  for (int t = blockIdx.x; t < 72 * 129; t += gridDim.x) {
    int nt = t / 72, mt = t % 72;
    f32x4 acc[4][4];
#pragma unroll
    for (int m = 0; m < 4; ++m)
#pragma unroll
      for (int n = 0; n < 4; ++n) acc[m][n] = f32x4{0.f, 0.f, 0.f, 0.f};
    gemm_kloop<4>(p.hbuf + (long)mt * 128 * D, D, p.WinT + (long)nt * 128 * D, D, D, smem, acc);
    if (nt < 128) {
#pragma unroll
      for (int m = 0; m < 4; ++m)
#pragma unroll
        for (int n = 0; n < 4; ++n)
#pragma unroll
          for (int j = 0; j < 4; ++j) {
            int row = mt * 128 + wr * 64 + m * 16 + fq * 4 + j, col = nt * 128 + wc * 64 + n * 16 + fr;
            p.proj[(long)row * PLD + col] = f2bf(acc[m][n][j]);
          }
    } else if (wc == 0) {
#pragma unroll
      for (int m = 0; m < 4; ++m)
#pragma unroll
        for (int n = 0; n < 4; ++n)
#pragma unroll
          for (int j = 0; j < 4; ++j) {
            int row = mt * 128 + wr * 64 + m * 16 + fq * 4 + j, col = n * 16 + fr;
            p.gates[(long)row * GLD + col] = acc[m][n][j];
          }
    }
  }
}

struct ScanSmem {
  float q[TC][128];
  float k[TC][128];
  float f[TC][128];
  float v[TC][64];
  float sc[TC][4];
};

__device__ __forceinline__ int scan_row(int bl, int dir, int pos) {
  int t;
  if (pos < CTX) t = dir ? (CTX - 1 - pos) : pos;
  else { int u = pos - CTX; t = CTX + (dir ? (SEQ - 1 - u) : u); }
  return bl * TPB + t;
}

__device__ void scan_unit(const Params& p, int l, int g, int u, ScanSmem& sm) {
  const int tid = otid(), lane = tid & 63, w = tid >> 6;
  const int j = lane & 15, gq = lane >> 4;
  const int mixer = u / 128, r = u % 128;
  int bl, h, dir, vs;
  bl = r / 32;
  if (mixer < 2) { h = (r % 32) / 4; dir = (r % 4) / 2; vs = r % 2; }
  else { h = (r % 32) / 8; dir = (r % 8) / 4; vs = r % 4; }
  int cq, ck, cv, ocol;
  if (mixer == 0) { cq = C_HGQ + h * 128; ck = C_HGF + dir * 1024 + h * 128; cv = C_HGI + h * 128 + vs * 64; ocol = h * 128 + vs * 64; }
  else if (mixer == 1) { cq = C_GQ + h * 128; ck = C_GK + h * 128; cv = C_GV + h * 128 + vs * 64; ocol = 1024 + h * 128 + vs * 64; }
  else { cq = C_MQ + h * 128; ck = C_MK + h * 128; cv = C_MV + h * 256 + vs * 64; ocol = 2048 + h * 256 + vs * 64; }

  float S[32];
#pragma unroll
  for (int i = 0; i < 32; ++i) S[i] = 0.f;
  float n0 = 0.f, n1 = 0.f;
  float mstate = 0.f;
  float gA = 0.f, gDt = 0.f, ibias = 0.f, fbias = 0.f;
  if (mixer == 1) { gA = -__expf(p.gdn_a_log[l * 16 + dir * 8 + h]); gDt = p.gdn_dt_bias[l * 16 + dir * 8 + h]; }
  if (mixer == 2) { ibias = p.ml_i_bias[l * 8 + dir * 4 + h]; fbias = p.ml_f_bias[l * 8 + dir * 4 + h]; }

  __syncthreads();
  if (mixer == 1) {
    float* cw = &sm.f[0][0];
    for (int i = tid; i < 9 * 320; i += 256) {
      int tap = i / 320, lc = i % 320;
      int ch = lc < 128 ? (h * 128 + lc) : (lc < 256 ? (1024 + h * 128 + lc - 128) : (2048 + h * 128 + vs * 64 + lc - 256));
      cw[i] = p.gdn_conv[((long)l * 9 + tap) * 3072 + ch];
    }
    __syncthreads();
  }

  for (int ch0 = 0; ch0 < TPB / TC; ++ch0) {
    const int pos0 = ch0 * TC;
    const bool is_ctx = pos0 < CTX;
    __syncthreads();
    for (int idx = tid; idx < TC * 40; idx += 256) {
      int tok = idx / 40, cgp = idx % 40;
      int row = scan_row(bl, dir, pos0 + tok);
      int col, lc;
      if (cgp < 16) { col = cq + cgp * 8; lc = cgp * 8; }
      else if (cgp < 32) { col = ck + (cgp - 16) * 8; lc = 128 + (cgp - 16) * 8; }
      else { col = cv + (cgp - 32) * 8; lc = 256 + (cgp - 32) * 8; }
      float val[8];
      if (mixer != 1) {
        uint4 raw = *(const uint4*)(p.proj + (long)row * PLD + col);
        unpack8(raw, val);
      } else {
        const float* cw = &sm.f[0][0];
#pragma unroll
        for (int e = 0; e < 8; ++e) val[e] = 0.f;
        int t = row - bl * TPB;
        if (is_ctx) {
#pragma unroll
          for (int jj = 0; jj < 3; ++jj) {
            int tt = t + jj - 1;
            if (tt >= 0 && tt < CTX) {
              uint4 raw = *(const uint4*)(p.proj + (long)(bl * TPB + tt) * PLD + col);
              float xv[8]; unpack8(raw, xv);
              const float* wv = cw + (3 + jj) * 320 + lc;
#pragma unroll
              for (int e = 0; e < 8; ++e) val[e] += xv[e] * wv[e];
            }
          }
        } else {
          int lt = t - CTX, rr0 = lt >> 6, cc0 = lt & 63;
#pragma unroll
          for (int ii = 0; ii < 3; ++ii) {
            int rr = rr0 + ii - 1;
            if (rr < 0 || rr >= 32) continue;
#pragma unroll
            for (int jj = 0; jj < 3; ++jj) {
              int cc = cc0 + jj - 1;
              if (cc < 0 || cc >= 64) continue;
              uint4 raw = *(const uint4*)(p.proj + (long)(bl * TPB + CTX + rr * 64 + cc) * PLD + col);
              float xv[8]; unpack8(raw, xv);
              const float* wv = cw + (ii * 3 + jj) * 320 + lc;
#pragma unroll
              for (int e = 0; e < 8; ++e) val[e] += xv[e] * wv[e];
            }
          }
        }
#pragma unroll
        for (int e = 0; e < 8; ++e) val[e] = siluf_(val[e]);
      }
      if (cgp < 16) {
        float scl = (mixer == 2) ? 0.08838834764831845f : 1.f;
#pragma unroll
        for (int e = 0; e < 8; ++e) sm.q[tok][lc + e] = val[e] * scl;
      } else if (cgp < 32) {
        int d0 = lc - 128;
        if (mixer == 0) {
#pragma unroll
          for (int e = 0; e < 8; ++e) {
            float lbv = p.lb[l * D + h * 128 + d0 + e];
            float f = lbv + (1.f - lbv) * sigmoidf_(val[e]);
            sm.f[tok][d0 + e] = f;
            sm.k[tok][d0 + e] = 1.f - f;
          }
        } else {
#pragma unroll
          for (int e = 0; e < 8; ++e) sm.k[tok][d0 + e] = val[e];
        }
      } else {
        int c0 = lc - 256;
#pragma unroll
        for (int e = 0; e < 8; ++e) sm.v[tok][c0 + e] = val[e];
      }
    }
    if (mixer == 2 && tid < TC) {
      int row = scan_row(bl, dir, pos0 + tid);
      float ig = p.gates[(long)row * GLD + 32 + dir * 4 + h] + ibias;
      float fx = p.gates[(long)row * GLD + 40 + dir * 4 + h] + fbias;
      sm.sc[tid][0] = ig;
      sm.sc[tid][1] = -softplusf_(-fx);
    }
    __syncthreads();
    if (mixer == 1) {
      for (int tk = w * 8; tk < w * 8 + 8; ++tk) {
        float q0 = sm.q[tk][lane], q1 = sm.q[tk][lane + 64], k0 = sm.k[tk][lane], k1 = sm.k[tk][lane + 64];
        float sq = wave_sum(q0 * q0 + q1 * q1), sk = wave_sum(k0 * k0 + k1 * k1), qk = wave_sum(q0 * k0 + q1 * k1);
        float rq = rsqrtf(sq + 1e-6f) * 0.08838834764831845f, rk = rsqrtf(sk + 1e-6f);
        sm.q[tk][lane] = q0 * rq; sm.q[tk][lane + 64] = q1 * rq;
        sm.k[tk][lane] = k0 * rk; sm.k[tk][lane + 64] = k1 * rk;
        if (lane == 0) {
          int row = scan_row(bl, dir, pos0 + tk);
          float beta = sigmoidf_(p.gates[(long)row * GLD + dir * 8 + h]);
          float gg = gA * softplusf_(p.gates[(long)row * GLD + 16 + dir * 8 + h] + gDt);
          sm.sc[tk][0] = __expf(gg); sm.sc[tk][1] = beta; sm.sc[tk][2] = qk * rq * rk;
        }
      }
      __syncthreads();
    } else if (mixer == 2) {
      if (tid == 0) {
        float m = mstate;
        for (int tk = 0; tk < TC; ++tk) {
          float ig = sm.sc[tk][0], lf = sm.sc[tk][1];
          float mn = fmaxf(lf + m, ig);
          sm.sc[tk][0] = __expf(lf + m - mn);
          sm.sc[tk][1] = __expf(ig - mn);
          sm.sc[tk][2] = __expf(-mn);
          m = mn;
        }
        mstate = m;
      }
      __syncthreads();
    }
    if (mixer == 0) {
      for (int tk = 0; tk < TC; ++tk) {
        float vj = sm.v[tk][w * 16 + j];
        const float4* qp = (const float4*)&sm.q[tk][gq * 32];
        const float4* kp = (const float4*)&sm.k[tk][gq * 32];
        const float4* fp = (const float4*)&sm.f[tk][gq * 32];
        float acc = 0.f;
#pragma unroll
        for (int i = 0; i < 8; ++i) {
          float4 q4 = qp[i], k4 = kp[i], f4 = fp[i];
          S[4 * i + 0] = f4.x * S[4 * i + 0] + k4.x * vj; acc += q4.x * S[4 * i + 0];
          S[4 * i + 1] = f4.y * S[4 * i + 1] + k4.y * vj; acc += q4.y * S[4 * i + 1];
          S[4 * i + 2] = f4.z * S[4 * i + 2] + k4.z * vj; acc += q4.z * S[4 * i + 2];
          S[4 * i + 3] = f4.w * S[4 * i + 3] + k4.w * vj; acc += q4.w * S[4 * i + 3];
        }
        acc += __shfl_xor(acc, 16); acc += __shfl_xor(acc, 32);
        if (gq == 0) sm.v[tk][w * 16 + j] = acc;
      }
    } else if (mixer == 1) {
      for (int tk = 0; tk < TC; ++tk) {
        float vj = sm.v[tk][w * 16 + j];
        float a = sm.sc[tk][0], beta = sm.sc[tk][1], qk = sm.sc[tk][2];
        const float4* qp = (const float4*)&sm.q[tk][gq * 32];
        const float4* kp = (const float4*)&sm.k[tk][gq * 32];
        float kr[32];
        float rr = 0.f, pq = 0.f;
#pragma unroll
        for (int i = 0; i < 8; ++i) {
          float4 q4 = qp[i], k4 = kp[i];
          kr[4 * i + 0] = k4.x; kr[4 * i + 1] = k4.y; kr[4 * i + 2] = k4.z; kr[4 * i + 3] = k4.w;
          rr += k4.x * S[4 * i + 0]; pq += q4.x * S[4 * i + 0];
          rr += k4.y * S[4 * i + 1]; pq += q4.y * S[4 * i + 1];
          rr += k4.z * S[4 * i + 2]; pq += q4.z * S[4 * i + 2];
          rr += k4.w * S[4 * i + 3]; pq += q4.w * S[4 * i + 3];
        }
        rr += __shfl_xor(rr, 16); pq += __shfl_xor(pq, 16);
        rr += __shfl_xor(rr, 32); pq += __shfl_xor(pq, 32);
        float vn = beta * (vj - a * rr);
        float ov = a * pq + qk * vn;
#pragma unroll
        for (int i = 0; i < 32; ++i) S[i] = a * S[i] + kr[i] * vn;
        if (gq == 0) sm.v[tk][w * 16 + j] = ov;
      }
    } else {
      for (int tk = 0; tk < TC; ++tk) {
        float vj = sm.v[tk][w * 16 + j];
        float fd = sm.sc[tk][0], iw = sm.sc[tk][1], em = sm.sc[tk][2];
        float ivj = iw * vj;
        const float4* qp = (const float4*)&sm.q[tk][gq * 32];
        const float4* kp = (const float4*)&sm.k[tk][gq * 32];
        float acc = 0.f;
#pragma unroll
        for (int i = 0; i < 8; ++i) {
          float4 q4 = qp[i], k4 = kp[i];
          S[4 * i + 0] = fd * S[4 * i + 0] + k4.x * ivj; acc += q4.x * S[4 * i + 0];
          S[4 * i + 1] = fd * S[4 * i + 1] + k4.y * ivj; acc += q4.y * S[4 * i + 1];
          S[4 * i + 2] = fd * S[4 * i + 2] + k4.z * ivj; acc += q4.z * S[4 * i + 2];
          S[4 * i + 3] = fd * S[4 * i + 3] + k4.w * ivj; acc += q4.w * S[4 * i + 3];
        }
        float2 kk = *(const float2*)&sm.k[tk][gq * 32 + 2 * j];
        float2 qq = *(const float2*)&sm.q[tk][gq * 32 + 2 * j];
        n0 = fd * n0 + iw * kk.x; n1 = fd * n1 + iw * kk.y;
        float den = n0 * qq.x + n1 * qq.y;
        den = wave_sum(den);
        acc += __shfl_xor(acc, 16); acc += __shfl_xor(acc, 32);
        if (gq == 0) sm.v[tk][w * 16 + j] = acc / fmaxf(fabsf(den), em);
      }
    }
    __syncthreads();
    {
      int tok = tid >> 3, c8 = tid & 7;
      int row = scan_row(bl, dir, pos0 + tok);
      const float* op = &sm.v[tok][c8 * 8];
      uint4 o;
      o.x = pack2(op[0], op[1]); o.y = pack2(op[2], op[3]); o.z = pack2(op[4], op[5]); o.w = pack2(op[6], op[7]);
      *(uint4*)(p.obuf + ((long)dir * TG + row) * 3072 + ocol + c8 * 8) = o;
    }
  }
}

__device__ void ph_scan(const Params& p, int l, int g, char* smem) {
  ScanSmem& sm = *(ScanSmem*)smem;
  for (int u = blockIdx.x; u < 384; u += gridDim.x) scan_unit(p, l, g, u, sm);
}

__device__ void ph_brfin(const Params& p, int l, int g) {
  const int tid = otid();
  const int lane = tid & 63;
  const int gw = blockIdx.x * 4 + (tid >> 6), nw = gridDim.x * 4;
  for (int wu = gw; wu < TG * 3; wu += nw) {
    int row = wu / 3, mixer = wu % 3;
    int pp = row % TPB;
    if (l == 1 && pp < CTX) continue;
    const u16* of = p.obuf + (long)row * 3072 + mixer * 1024 + lane * 16;
    const u16* ob = p.obuf + ((long)TG + row) * 3072 + mixer * 1024 + lane * 16;
    float o[16], t8[8];
    uint4 a0 = *(const uint4*)of, a1 = *(const uint4*)(of + 8), b0 = *(const uint4*)ob, b1 = *(const uint4*)(ob + 8);
    unpack8(a0, o); unpack8(a1, o + 8);
    unpack8(b0, t8);
#pragma unroll
    for (int e = 0; e < 8; ++e) o[e] += t8[e];
    unpack8(b1, t8);
#pragma unroll
    for (int e = 0; e < 8; ++e) o[8 + e] += t8[e];
    float ss = 0.f;
#pragma unroll
    for (int e = 0; e < 16; ++e) ss += o[e] * o[e];
    ss += __shfl_xor(ss, 1); ss += __shfl_xor(ss, 2); ss += __shfl_xor(ss, 4);
    float hd = 128.f;
    if (mixer == 2) { ss += __shfl_xor(ss, 8); hd = 256.f; }
    float rs = rsqrtf(ss / hd + 1e-6f);
    const float* on = (mixer == 0 ? p.hg_onorm : (mixer == 1 ? p.gdn_onorm : p.ml_onorm)) + l * D + lane * 16;
    int zc = mixer == 0 ? C_HGZ : (mixer == 1 ? C_GZ : C_MZ);
    const u16* zp = p.proj + (long)row * PLD + zc + lane * 16;
    float z[16];
    uint4 z0 = *(const uint4*)zp, z1 = *(const uint4*)(zp + 8);
    unpack8(z0, z); unpack8(z1, z + 8);
    float res[16];
#pragma unroll
    for (int e = 0; e < 16; ++e) res[e] = o[e] * rs * on[e] * siluf_(z[e]);
    if (mixer == 2) {
      const u16* gp = p.proj + (long)row * PLD + C_MO + lane * 16;
      uint4 g0 = *(const uint4*)gp, g1 = *(const uint4*)(gp + 8);
      unpack8(g0, z); unpack8(g1, z + 8);
#pragma unroll
      for (int e = 0; e < 16; ++e) res[e] *= sigmoidf_(z[e]);
    }
    uint4 w0, w1;
    w0.x = pack2(res[0], res[1]); w0.y = pack2(res[2], res[3]); w0.z = pack2(res[4], res[5]); w0.w = pack2(res[6], res[7]);
    w1.x = pack2(res[8], res[9]); w1.y = pack2(res[10], res[11]); w1.z = pack2(res[12], res[13]); w1.w = pack2(res[14], res[15]);
    u16* dst = p.obuf + (long)row * 3072 + mixer * 1024 + lane * 16;
    *(uint4*)dst = w0; *(uint4*)(dst + 8) = w1;
  }
}

__device__ void ph_gemm_merge(const Params& p, int l, char* smem) {
  const int tid = otid();
  const int wid = tid >> 6, lane = tid & 63, wr = wid >> 1, wc = wid & 1, fr = lane & 15, fq = lane >> 4;
  for (int t = blockIdx.x; t < 72 * 16; t += gridDim.x) {
    int nt = t / 72, mt = t % 72;
    if (l == 1 && (mt % 18) < 2) continue;
    f32x4 tot[4][2];
#pragma unroll
    for (int m = 0; m < 4; ++m)
#pragma unroll
      for (int n = 0; n < 2; ++n) tot[m][n] = f32x4{0.f, 0.f, 0.f, 0.f};
    for (int i = 0; i < 3; ++i) {
      f32x4 acc[4][2];
#pragma unroll
      for (int m = 0; m < 4; ++m)
#pragma unroll
        for (int n = 0; n < 2; ++n) acc[m][n] = f32x4{0.f, 0.f, 0.f, 0.f};
      gemm_kloop<2>(p.obuf + (long)mt * 128 * 3072 + i * 1024, 3072, p.WbrT + ((long)i * D + nt * 64) * D, D, D, smem, acc);
#pragma unroll
      for (int m = 0; m < 4; ++m)
#pragma unroll
        for (int n = 0; n < 2; ++n)
#pragma unroll
          for (int j = 0; j < 4; ++j) {
            int row = mt * 128 + wr * 64 + m * 16 + fq * 4 + j, col = nt * 64 + wc * 32 + n * 16 + fr;
            float gv = bf2f(p.proj[(long)row * PLD + C_GATE + i * 1024 + col]);
            tot[m][n][j] += sigmoidf_(gv) * acc[m][n][j];
          }
    }
#pragma unroll
    for (int m = 0; m < 4; ++m)
#pragma unroll
      for (int n = 0; n < 2; ++n)
#pragma unroll
        for (int j = 0; j < 4; ++j) {
          int row = mt * 128 + wr * 64 + m * 16 + fq * 4 + j, col = nt * 64 + wc * 32 + n * 16 + fr;
          p.hbuf[(long)row * D + col] = f2bf(tot[m][n][j]);
        }
  }
}

__device__ void ph_gemm_out(const Params& p, int l, int g, char* smem) {
  const int tid = otid();
  const int wid = tid >> 6, lane = tid & 63, wr = wid >> 1, wc = wid & 1, fr = lane & 15, fq = lane >> 4;
  for (int t = blockIdx.x; t < 72 * 8; t += gridDim.x) {
    int nt = t / 72, mt = t % 72;
    if (l == 1 && (mt % 18) < 2) continue;
    f32x4 acc[4][4];
#pragma unroll
    for (int m = 0; m < 4; ++m)
#pragma unroll
      for (int n = 0; n < 4; ++n) acc[m][n] = f32x4{0.f, 0.f, 0.f, 0.f};
    gemm_kloop<4>(p.hbuf + (long)mt * 128 * D, D, p.WoT + (long)nt * 128 * D, D, D, smem, acc);
#pragma unroll
    for (int m = 0; m < 4; ++m)
#pragma unroll
      for (int j = 0; j < 4; ++j) {
        int row = mt * 128 + wr * 64 + m * 16 + fq * 4 + j;
        int bl = row / TPB, pp = row % TPB, b = g * GB + bl;
        const float* src; float* dst; int mrow;
        if (pp < CTX) { src = p.ctx + ((long)b * CTX + pp) * D; dst = p.ctxs + ((long)b * CTX + pp) * D; mrow = 16; }
        else { long off = ((long)b * SEQ + (pp - CTX)) * D; src = (l == 0 ? p.x : p.out) + off; dst = p.out + off; mrow = b; }
        const float* gt = p.mod + ((long)l * 17 + mrow) * 3072 + 2048;
#pragma unroll
        for (int n = 0; n < 4; ++n) {
          int col = nt * 128 + wc * 64 + n * 16 + fr;
          dst[col] = src[col] + gt[col] * acc[m][n][j];
        }
      }
  }
}

__device__ void ph_final(const Params& p) {
  const int tid = otid();
  const int lane = tid & 63;
  const int gw = blockIdx.x * 4 + (tid >> 6), nw = gridDim.x * 4;
  for (int row = gw; row < NB * SEQ; row += nw) {
    float4* src = (float4*)(p.out + (long)row * D);
    float4 v[4]; float ss = 0.f;
#pragma unroll
    for (int i = 0; i < 4; ++i) {
      v[i] = src[lane + 64 * i];
      ss += v[i].x * v[i].x + v[i].y * v[i].y + v[i].z * v[i].z + v[i].w * v[i].w;
    }
    ss = wave_sum(ss);
    float rs = rsqrtf(ss * (1.f / D) + 1e-6f);
#pragma unroll
    for (int i = 0; i < 4; ++i) {
      float4 g4 = ((const float4*)p.final_g)[lane + 64 * i];
      float4 o; o.x = v[i].x * rs * g4.x; o.y = v[i].y * rs * g4.y; o.z = v[i].z * rs * g4.z; o.w = v[i].w * rs * g4.w;
      src[lane + 64 * i] = o;
    }
  }
}

constexpr int NSTEPS = 2 + 24 + 1 + 24 + 1;

__device__ void run_step(const Params& p, int step, char* smem) {
  if (step == 0) { ph_convert(p, 0, smem); ph_prep_small(p); return; }
  if (step == 1) { ph_mod(p, smem); return; }
  if (step == 26) { ph_convert(p, 1, smem); return; }
  if (step == NSTEPS - 1) { ph_final(p); return; }
  int l, s;
  if (step < 26) { l = 0; s = step - 2; } else { l = 1; s = step - 27; }
  int g = s / 6, k = s % 6;
  switch (k) {
    case 0: ph_prenorm(p, l, g); break;
    case 1: ph_gemm_in(p, smem); break;
    case 2: ph_scan(p, l, g, smem); break;
    case 3: ph_brfin(p, l, g); break;
    case 4: ph_gemm_merge(p, l, smem); break;
    case 5: ph_gemm_out(p, l, g, smem); break;
  }
}

#if !COOP
__global__ void __launch_bounds__(256, 2) k_step(Params p, int step) {
  __shared__ __attribute__((aligned(16))) char smem[sizeof(ScanSmem)];
  run_step(p, step, smem);
}
#else
__global__ void __launch_bounds__(256, 2) k_mega(Params p) {
  __shared__ __attribute__((aligned(16))) char smem[sizeof(ScanSmem)];
  cg::grid_group grid = cg::this_grid();
  ph_prep_small(p);
#pragma unroll 1
  for (int l = 0; l < 2; ++l) {
    ph_convert(p, l, smem);
    grid.sync();
    if (l == 0) { ph_mod(p, smem); grid.sync(); }
#pragma unroll 1
    for (int g = 0; g < NGRP; ++g) {
      ph_prenorm(p, l, g); grid.sync();
      ph_gemm_in(p, smem); grid.sync();
      ph_scan(p, l, g, smem); grid.sync();
      ph_brfin(p, l, g); grid.sync();
      ph_gemm_merge(p, l, smem); grid.sync();
      ph_gemm_out(p, l, g, smem); grid.sync();
    }
  }
  ph_final(p);
}
#endif

extern "C" void kernel_launch(void* const* d_in, const int* in_sizes, int n_in, void* d_out, int out_size, void* d_ws,
                              size_t ws_size, hipStream_t stream) {
  Params p{};
  p.x = (const float*)d_in[0]; p.c = (const float*)d_in[1]; p.ctx = (const float*)d_in[2]; p.c_ctx = (const float*)d_in[3];
  p.ada_w = (const float*)d_in[4]; p.ada_b = (const float*)d_in[5]; p.norm_g = (const float*)d_in[6]; p.w_in = (const float*)d_in[7];
  p.hg_lb = (const float*)d_in[8]; p.hg_onorm = (const float*)d_in[9]; p.gdn_conv = (const float*)d_in[10];
  p.gdn_a_log = (const float*)d_in[11]; p.gdn_dt_bias = (const float*)d_in[12]; p.gdn_onorm = (const float*)d_in[13];
  p.ml_i_bias = (const float*)d_in[14]; p.ml_f_bias = (const float*)d_in[15]; p.ml_onorm = (const float*)d_in[16];
  p.w_branch = (const float*)d_in[17]; p.w_out = (const float*)d_in[18]; p.final_g = (const float*)d_in[19];
  p.out = (float*)d_out;
  char* ws = (char*)d_ws;
  size_t off = 0;
  auto take = [&](size_t bytes) { char* r = ws + off; off += (bytes + 255) & ~(size_t)255; return r; };
  p.WinT = (u16*)take((size_t)NPAD * D * 2);
  p.WbrT = (u16*)take((size_t)3 * D * D * 2);
  p.WoT = (u16*)take((size_t)D * D * 2);
  p.hbuf = (u16*)take((size_t)TG * D * 2);
  p.proj = (u16*)take((size_t)TG * PLD * 2);
  p.obuf = (u16*)take((size_t)2 * TG * 3072 * 2);
  p.mod = (float*)take((size_t)2 * 17 * 3072 * 4);
  p.lb = (float*)take((size_t)2 * D * 4);
  p.silc = (float*)take((size_t)17 * D * 4);
  p.gates = (float*)take((size_t)TG * GLD * 4);
  p.ctxs = (float*)take((size_t)NB * CTX * D * 4);
  if (off > ws_size) { fprintf(stderr, "workspace too small: need %zu have %zu\n", off, ws_size); return; }

  static int grid_blocks = 0;
  if (!grid_blocks) {
    int dev = 0, cus = 0, per_cu = 0;
    hipGetDevice(&dev);
    hipDeviceGetAttribute(&cus, hipDeviceAttributeMultiprocessorCount, dev);
#if COOP
    hipOccupancyMaxActiveBlocksPerMultiprocessor(&per_cu, k_mega, 256, 0);
#else
    hipOccupancyMaxActiveBlocksPerMultiprocessor(&per_cu, k_step, 256, 0);
#endif
    if (per_cu < 1) per_cu = 1;
    if (per_cu > 2) per_cu = 2;
    grid_blocks = cus * per_cu;
  }
#if COOP
  void* args[] = {&p};
  hipError_t e = hipLaunchCooperativeKernel((void*)k_mega, dim3(grid_blocks), dim3(256), args, 0, stream);
  if (e != hipSuccess) fprintf(stderr, "cooperative launch failed: %s (grid %d)\n", hipGetErrorString(e), grid_blocks);
#else
  for (int s = 0; s < NSTEPS; ++s) k_step<<<grid_blocks, 256, 0, stream>>>(p, s);
#endif
}
```

```cpp
#include <hip/hip_runtime.h>
#include <hip/hip_bf16.h>
#include <hip/hip_cooperative_groups.h>
#include <cstdio>
namespace cg = cooperative_groups;

#define REP_PRE 1
#define REP_GIN 1
#define REP_SCAN 1
#define REP_MRG 1
#define REP_SYNC 0
#ifndef COOP
#define COOP 1
#endif

typedef unsigned short u16;
using bf16x8 = __attribute__((ext_vector_type(8))) short;
using f32x4 = __attribute__((ext_vector_type(4))) float;

constexpr int D = 1024;
constexpr int NB = 16;
constexpr int SEQ = 2048;
constexpr int CTX = 256;
constexpr int TPB = SEQ + CTX;
constexpr int GB = 4;
constexpr int NGRP = NB / GB;
constexpr int TG = GB * TPB;
constexpr int IN_DIM = 16432;
constexpr int NPAD = 16512;
constexpr int PLD = 16384;
constexpr int GLD = 64;
constexpr int TC = 32;
constexpr int C_HGQ = 0, C_HGI = 1024, C_HGF = 2048, C_HGZ = 4096;
constexpr int C_GQ = 5120, C_GK = 6144, C_GV = 7168, C_GZ = 8192;
constexpr int C_MQ = 9216, C_MK = 9728, C_MV = 10240, C_MO = 11264, C_MZ = 12288;
constexpr int C_GATE = 13312;

struct Params {
  const float *x, *c, *ctx, *c_ctx, *ada_w, *ada_b, *norm_g, *w_in, *hg_lb, *hg_onorm, *gdn_conv,
      *gdn_a_log, *gdn_dt_bias, *gdn_onorm, *ml_i_bias, *ml_f_bias, *ml_onorm, *w_branch, *w_out, *final_g;
  float* out;
  u16 *WinT, *WbrT, *WoT, *hbuf, *proj, *obuf;
  float *mod, *lb, *silc, *gates, *ctxs;
};

__device__ __forceinline__ u16 f2bf(float f) {
  unsigned u = __float_as_uint(f);
  u += 0x7fffu + ((u >> 16) & 1u);
  return (u16)(u >> 16);
}
__device__ __forceinline__ float bf2f(u16 h) { return __uint_as_float(((unsigned)h) << 16); }
__device__ __forceinline__ float sigmoidf_(float x) { return 1.f / (1.f + __expf(-x)); }
__device__ __forceinline__ float siluf_(float x) { return x / (1.f + __expf(-x)); }
__device__ __forceinline__ float softplusf_(float y) { return fmaxf(y, 0.f) + log1pf(__expf(-fabsf(y))); }
__device__ __forceinline__ float wave_sum(float v) {
#pragma unroll
  for (int o = 32; o >= 1; o >>= 1) v += __shfl_xor(v, o);
  return v;
}
__device__ __forceinline__ void unpack8(const uint4& u, float* f) {
  f[0] = __uint_as_float(u.x << 16); f[1] = __uint_as_float(u.x & 0xffff0000u);
  f[2] = __uint_as_float(u.y << 16); f[3] = __uint_as_float(u.y & 0xffff0000u);
  f[4] = __uint_as_float(u.z << 16); f[5] = __uint_as_float(u.z & 0xffff0000u);
  f[6] = __uint_as_float(u.w << 16); f[7] = __uint_as_float(u.w & 0xffff0000u);
}
__device__ __forceinline__ unsigned pack2(float a, float b) { return (unsigned)f2bf(a) | ((unsigned)f2bf(b) << 16); }

__device__ __forceinline__ int otid() { int t = threadIdx.x; asm volatile("" : "+v"(t)); return t; }
__device__ __forceinline__ int win_src_col(int np) {
  if (np < 9216) return np;
  if (np < 13312) return np + 32;
  if (np < 16384) return np + 48;
  if (np < 16416) return 9216 + (np - 16384);
  if (np < 16432) return 13344 + (np - 16416);
  return -1;
}

__device__ void ph_convert(const Params& p, int l, char* smem) {
  float (*tile)[65] = (float (*)[65])smem;
  const int tid = otid();
  for (int t = blockIdx.x; t < 5152; t += gridDim.x) {
    const float* src; long sld; u16* dst; int n0, k0, kind;
    if (t < 4128) { kind = 0; n0 = (t / 16) * 64; k0 = (t % 16) * 64; src = p.w_in + (long)l * D * IN_DIM; sld = IN_DIM; dst = p.WinT; }
    else if (t < 4896) { int u = t - 4128; int i = u / 256; u %= 256; kind = 1; n0 = (u / 16) * 64; k0 = (u % 16) * 64;
      src = p.w_branch + ((long)l * 3 + i) * D * D; sld = D; dst = p.WbrT + (long)i * D * D; }
    else { int u = t - 4896; kind = 1; n0 = (u / 16) * 64; k0 = (u % 16) * 64; src = p.w_out + (long)l * D * D; sld = D; dst = p.WoT; }
#pragma unroll 4
    for (int i = 0; i < 16; ++i) {
      int kk = (tid >> 6) + 4 * i, nn = tid & 63;
      int np = n0 + nn;
      int ns = kind == 0 ? win_src_col(np) : np;
      tile[kk][nn] = ns >= 0 ? src[(long)(k0 + kk) * sld + ns] : 0.f;
    }
    __syncthreads();
#pragma unroll 4
    for (int i = 0; i < 16; ++i) {
      int nn = (tid >> 6) + 4 * i, kk = tid & 63;
      dst[(long)(n0 + nn) * D + k0 + kk] = f2bf(tile[kk][nn]);
    }
    __syncthreads();
  }
}

__device__ void ph_prep_small(const Params& p) {
  int gt = blockIdx.x * blockDim.x + otid(), gs = gridDim.x * blockDim.x;
  for (int i = gt; i < 17 * D + 2 * D; i += gs) {
    if (i < 16 * D) p.silc[i] = siluf_(p.c[i]);
    else if (i < 17 * D) p.silc[i] = siluf_(p.c_ctx[i - 16 * D]);
    else {
      int j = i - 17 * D;
      if (j < D) p.lb[j] = 0.f;
      else { int ch = j - D; p.lb[j] = sigmoidf_(p.hg_lb[D + ch] - p.hg_lb[ch]); }
    }
  }
}

__device__ void ph_mod(const Params& p, char* smem) {
  float (*red)[17][64] = (float (*)[17][64])smem;
  const int tid = otid();
  const int kq = __builtin_amdgcn_readfirstlane(tid >> 6), cc = tid & 63;
  for (int u = blockIdx.x; u < 96; u += gridDim.x) {
    int l = u / 48, col = (u % 48) * 64 + cc;
    float acc[17];
#pragma unroll
    for (int r = 0; r < 17; ++r) acc[r] = 0.f;
    const float* w = p.ada_w + (long)l * D * 3072 + col;
    for (int k = kq * 256; k < kq * 256 + 256; ++k) {
      float wv = w[(long)k * 3072];
#pragma unroll
      for (int r = 0; r < 17; ++r) acc[r] += p.silc[r * D + k] * wv;
    }
#pragma unroll
    for (int r = 0; r < 17; ++r) red[kq][r][cc] = acc[r];
    __syncthreads();
    for (int i = tid; i < 17 * 64; i += 256) {
      int r = i / 64, c2 = i % 64;
      int colo = (u % 48) * 64 + c2;
      float s = red[0][r][c2] + red[1][r][c2] + red[2][r][c2] + red[3][r][c2] + p.ada_b[l * 3072 + colo];
      p.mod[((long)l * 17 + r) * 3072 + colo] = s;
    }
    __syncthreads();
  }
}

__device__ void ph_prenorm(const Params& p, int l, int g) {
  const int tid = otid();
  const int lane = tid & 63;
  const int gw = blockIdx.x * 4 + (tid >> 6), nw = gridDim.x * 4;
  for (int row = gw; row < TG; row += nw) {
    int bl = row / TPB, pp = row % TPB, b = g * GB + bl;
    const float* src; int mrow;
    if (pp < CTX) { src = (l == 0 ? p.ctx : p.ctxs) + ((long)b * CTX + pp) * D; mrow = 16; }
    else { src = (l == 0 ? p.x : p.out) + ((long)b * SEQ + (pp - CTX)) * D; mrow = b; }
    const float* md = p.mod + ((long)l * 17 + mrow) * 3072;
    float4 v[4]; float ss = 0.f;
#pragma unroll
    for (int i = 0; i < 4; ++i) {
      v[i] = ((const float4*)src)[lane + 64 * i];
      ss += v[i].x * v[i].x + v[i].y * v[i].y + v[i].z * v[i].z + v[i].w * v[i].w;
    }
    ss = wave_sum(ss);
    float rs = rsqrtf(ss * (1.f / D) + 1e-6f);
#pragma unroll
    for (int i = 0; i < 4; ++i) {
      int idx = (lane + 64 * i) * 4;
      float4 g4 = *(const float4*)(p.norm_g + l * D + idx);
      float4 sh = *(const float4*)(md + idx);
      float4 sc = *(const float4*)(md + D + idx);
      float h0 = v[i].x * rs * g4.x * (1.f + sc.x) + sh.x;
      float h1 = v[i].y * rs * g4.y * (1.f + sc.y) + sh.y;
      float h2 = v[i].z * rs * g4.z * (1.f + sc.z) + sh.z;
      float h3 = v[i].w * rs * g4.w * (1.f + sc.w) + sh.w;
      uint2 o; o.x = pack2(h0, h1); o.y = pack2(h2, h3);
      *(uint2*)(p.hbuf + (long)row * D + idx) = o;
    }
  }
}

template <int NF>
__device__ __forceinline__ void gemm_kloop(const u16* Ag, long lda, const u16* Bg, long ldb, int K, char* smem, f32x4 (&acc)[4][NF]) {
  const int tid = otid();
  const int wid = tid >> 6, lane = tid & 63, wr = wid >> 1, wc = wid & 1, fr = lane & 15, fq = lane >> 4;
  char* SA = smem; char* SB = smem + 8192;
  for (int t = 0; t < K / 32; ++t) {
#pragma unroll
    for (int i = 0; i < 2; ++i) {
      int b = tid * 16 + i * 4096, r = b / 64, c = (b % 64) / 2;
      __builtin_amdgcn_global_load_lds((const unsigned*)(Ag + (long)r * lda + t * 32 + c), (__attribute__((address_space(3))) unsigned*)(SA + b), 16, 0, 0);
      if (NF == 4 || i == 0)
        __builtin_amdgcn_global_load_lds((const unsigned*)(Bg + (long)r * ldb + t * 32 + c), (__attribute__((address_space(3))) unsigned*)(SB + b), 16, 0, 0);
    }
    asm volatile("s_waitcnt vmcnt(0)" ::: "memory");
    __syncthreads();
    bf16x8 At[4], Bl[NF];
#pragma unroll
    for (int m = 0; m < 4; ++m) At[m] = *(const bf16x8*)(SA + (wr * 64 + m * 16 + fr) * 64 + fq * 16);
#pragma unroll
    for (int n = 0; n < NF; ++n) Bl[n] = *(const bf16x8*)(SB + (wc * NF * 16 + n * 16 + fr) * 64 + fq * 16);
#pragma unroll
    for (int m = 0; m < 4; ++m)
#pragma unroll
      for (int n = 0; n < NF; ++n) acc[m][n] = __builtin_amdgcn_mfma_f32_16x16x32_bf16(At[m], Bl[n], acc[m][n], 0, 0, 0);
    __syncthreads();
  }
}

__device__ void ph_gemm_in(const Params& p, char* smem) {
  const int tid = otid();
  const int wid = tid >> 6, lane = tid & 63, wr = wid >> 1, wc = wid & 1, fr = lane & 15, fq = lane >> 4;
  for (int t = blockIdx.x; t < 72 * 129; t += gridDim.x) {
    int nt = t / 72, mt = t % 72;
    f32x4 acc[4][4];
#pragma unroll
    for (int m = 0; m < 4; ++m)
#pragma unroll
      for (int n = 0; n < 4; ++n) acc[m][n] = f32x4{0.f, 0.f, 0.f, 0.f};
    gemm_kloop<4>(p.hbuf + (long)mt * 128 * D, D, p.WinT + (long)nt * 128 * D, D, D, smem, acc);
    if (nt < 128) {
#pragma unroll
      for (int m = 0; m < 4; ++m)
#pragma unroll
        for (int n = 0; n < 4; ++n)
#pragma unroll
          for (int j = 0; j < 4; ++j) {
            int row = mt * 128 + wr * 64 + m * 16 + fq * 4 + j, col = nt * 128 + wc * 64 + n * 16 + fr;
            p.proj[(long)row * PLD + col] = f2bf(acc[m][n][j]);
          }
    } else if (wc == 0) {
#pragma unroll
      for (int m = 0; m < 4; ++m)
#pragma unroll
        for (int n = 0; n < 4; ++n)
#pragma unroll
          for (int j = 0; j < 4; ++j) {
            int row = mt * 128 + wr * 64 + m * 16 + fq * 4 + j, col = n * 16 + fr;
            p.gates[(long)row * GLD + col] = acc[m][n][j];
          }
    }
  }
}

struct ScanSmem {
  float q[TC][128];
  float k[TC][128];
  float f[TC][128];
  float v[TC][64];
  float sc[TC][4];
};

__device__ __forceinline__ int scan_row(int bl, int dir, int pos) {
  int t;
  if (pos < CTX) t = dir ? (CTX - 1 - pos) : pos;
  else { int u = pos - CTX; t = CTX + (dir ? (SEQ - 1 - u) : u); }
  return bl * TPB + t;
}

__device__ void scan_unit(const Params& p, int l, int g, int u, ScanSmem& sm) {
  const int tid = otid(), lane = tid & 63, w = tid >> 6;
  const int j = lane & 15, gq = lane >> 4;
  const int mixer = u / 128, r = u % 128;
  int bl, h, dir, vs;
  bl = r / 32;
  if (mixer < 2) { h = (r % 32) / 4; dir = (r % 4) / 2; vs = r % 2; }
  else { h = (r % 32) / 8; dir = (r % 8) / 4; vs = r % 4; }
  int cq, ck, cv, ocol;
  if (mixer == 0) { cq = C_HGQ + h * 128; ck = C_HGF + dir * 1024 + h * 128; cv = C_HGI + h * 128 + vs * 64; ocol = h * 128 + vs * 64; }
  else if (mixer == 1) { cq = C_GQ + h * 128; ck = C_GK + h * 128; cv = C_GV + h * 128 + vs * 64; ocol = 1024 + h * 128 + vs * 64; }
  else { cq = C_MQ + h * 128; ck = C_MK + h * 128; cv = C_MV + h * 256 + vs * 64; ocol = 2048 + h * 256 + vs * 64; }

  float S[32];
#pragma unroll
  for (int i = 0; i < 32; ++i) S[i] = 0.f;
  float n0 = 0.f, n1 = 0.f;
  float mstate = 0.f;
  float gA = 0.f, gDt = 0.f, ibias = 0.f, fbias = 0.f;
  if (mixer == 1) { gA = -__expf(p.gdn_a_log[l * 16 + dir * 8 + h]); gDt = p.gdn_dt_bias[l * 16 + dir * 8 + h]; }
  if (mixer == 2) { ibias = p.ml_i_bias[l * 8 + dir * 4 + h]; fbias = p.ml_f_bias[l * 8 + dir * 4 + h]; }

  __syncthreads();
  if (mixer == 1) {
    float* cw = &sm.f[0][0];
    for (int i = tid; i < 9 * 320; i += 256) {
      int tap = i / 320, lc = i % 320;
      int ch = lc < 128 ? (h * 128 + lc) : (lc < 256 ? (1024 + h * 128 + lc - 128) : (2048 + h * 128 + vs * 64 + lc - 256));
      cw[i] = p.gdn_conv[((long)l * 9 + tap) * 3072 + ch];
    }
    __syncthreads();
  }

  for (int ch0 = 0; ch0 < TPB / TC; ++ch0) {
    const int pos0 = ch0 * TC;
    const bool is_ctx = pos0 < CTX;
    __syncthreads();
    for (int idx = tid; idx < TC * 40; idx += 256) {
      int tok = idx / 40, cgp = idx % 40;
      int row = scan_row(bl, dir, pos0 + tok);
      int col, lc;
      if (cgp < 16) { col = cq + cgp * 8; lc = cgp * 8; }
      else if (cgp < 32) { col = ck + (cgp - 16) * 8; lc = 128 + (cgp - 16) * 8; }
      else { col = cv + (cgp - 32) * 8; lc = 256 + (cgp - 32) * 8; }
      float val[8];
      if (mixer != 1) {
        uint4 raw = *(const uint4*)(p.proj + (long)row * PLD + col);
        unpack8(raw, val);
      } else {
        const float* cw = &sm.f[0][0];
#pragma unroll
        for (int e = 0; e < 8; ++e) val[e] = 0.f;
        int t = row - bl * TPB;
        if (is_ctx) {
#pragma unroll
          for (int jj = 0; jj < 3; ++jj) {
            int tt = t + jj - 1;
            if (tt >= 0 && tt < CTX) {
              uint4 raw = *(const uint4*)(p.proj + (long)(bl * TPB + tt) * PLD + col);
              float xv[8]; unpack8(raw, xv);
              const float* wv = cw + (3 + jj) * 320 + lc;
#pragma unroll
              for (int e = 0; e < 8; ++e) val[e] += xv[e] * wv[e];
            }
          }
        } else {
          int lt = t - CTX, rr0 = lt >> 6, cc0 = lt & 63;
#pragma unroll
          for (int ii = 0; ii < 3; ++ii) {
            int rr = rr0 + ii - 1;
            if (rr < 0 || rr >= 32) continue;
#pragma unroll
            for (int jj = 0; jj < 3; ++jj) {
              int cc = cc0 + jj - 1;
              if (cc < 0 || cc >= 64) continue;
              uint4 raw = *(const uint4*)(p.proj + (long)(bl * TPB + CTX + rr * 64 + cc) * PLD + col);
              float xv[8]; unpack8(raw, xv);
              const float* wv = cw + (ii * 3 + jj) * 320 + lc;
#pragma unroll
              for (int e = 0; e < 8; ++e) val[e] += xv[e] * wv[e];
            }
          }
        }
#pragma unroll
        for (int e = 0; e < 8; ++e) val[e] = siluf_(val[e]);
      }
      if (cgp < 16) {
        float scl = (mixer == 2) ? 0.08838834764831845f : 1.f;
#pragma unroll
        for (int e = 0; e < 8; ++e) sm.q[tok][lc + e] = val[e] * scl;
      } else if (cgp < 32) {
        int d0 = lc - 128;
        if (mixer == 0) {
#pragma unroll
          for (int e = 0; e < 8; ++e) {
            float lbv = p.lb[l * D + h * 128 + d0 + e];
            float f = lbv + (1.f - lbv) * sigmoidf_(val[e]);
            sm.f[tok][d0 + e] = f;
            sm.k[tok][d0 + e] = 1.f - f;
          }
        } else {
#pragma unroll
          for (int e = 0; e < 8; ++e) sm.k[tok][d0 + e] = val[e];
        }
      } else {
        int c0 = lc - 256;
#pragma unroll
        for (int e = 0; e < 8; ++e) sm.v[tok][c0 + e] = val[e];
      }
    }
    if (mixer == 2 && tid < TC) {
      int row = scan_row(bl, dir, pos0 + tid);
      float ig = p.gates[(long)row * GLD + 32 + dir * 4 + h] + ibias;
      float fx = p.gates[(long)row * GLD + 40 + dir * 4 + h] + fbias;
      sm.sc[tid][0] = ig;
      sm.sc[tid][1] = -softplusf_(-fx);
    }
    __syncthreads();
    if (mixer == 1) {
      for (int tk = w * 8; tk < w * 8 + 8; ++tk) {
        float q0 = sm.q[tk][lane], q1 = sm.q[tk][lane + 64], k0 = sm.k[tk][lane], k1 = sm.k[tk][lane + 64];
        float sq = wave_sum(q0 * q0 + q1 * q1), sk = wave_sum(k0 * k0 + k1 * k1), qk = wave_sum(q0 * k0 + q1 * k1);
        float rq = rsqrtf(sq + 1e-6f) * 0.08838834764831845f, rk = rsqrtf(sk + 1e-6f);
        sm.q[tk][lane] = q0 * rq; sm.q[tk][lane + 64] = q1 * rq;
        sm.k[tk][lane] = k0 * rk; sm.k[tk][lane + 64] = k1 * rk;
        if (lane == 0) {
          int row = scan_row(bl, dir, pos0 + tk);
          float beta = sigmoidf_(p.gates[(long)row * GLD + dir * 8 + h]);
          float gg = gA * softplusf_(p.gates[(long)row * GLD + 16 + dir * 8 + h] + gDt);
          sm.sc[tk][0] = __expf(gg); sm.sc[tk][1] = beta; sm.sc[tk][2] = qk * rq * rk;
        }
      }
      __syncthreads();
    } else if (mixer == 2) {
      if (tid == 0) {
        float m = mstate;
        for (int tk = 0; tk < TC; ++tk) {
          float ig = sm.sc[tk][0], lf = sm.sc[tk][1];
          float mn = fmaxf(lf + m, ig);
          sm.sc[tk][0] = __expf(lf + m - mn);
          sm.sc[tk][1] = __expf(ig - mn);
          sm.sc[tk][2] = __expf(-mn);
          m = mn;
        }
        mstate = m;
      }
      __syncthreads();
    }
    if (mixer == 0) {
      for (int tk = 0; tk < TC; ++tk) {
        float vj = sm.v[tk][w * 16 + j];
        const float4* qp = (const float4*)&sm.q[tk][gq * 32];
        const float4* kp = (const float4*)&sm.k[tk][gq * 32];
        const float4* fp = (const float4*)&sm.f[tk][gq * 32];
        float acc = 0.f;
#pragma unroll
        for (int i = 0; i < 8; ++i) {
          float4 q4 = qp[i], k4 = kp[i], f4 = fp[i];
          S[4 * i + 0] = f4.x * S[4 * i + 0] + k4.x * vj; acc += q4.x * S[4 * i + 0];
          S[4 * i + 1] = f4.y * S[4 * i + 1] + k4.y * vj; acc += q4.y * S[4 * i + 1];
          S[4 * i + 2] = f4.z * S[4 * i + 2] + k4.z * vj; acc += q4.z * S[4 * i + 2];
          S[4 * i + 3] = f4.w * S[4 * i + 3] + k4.w * vj; acc += q4.w * S[4 * i + 3];
        }
        acc += __shfl_xor(acc, 16); acc += __shfl_xor(acc, 32);
        if (gq == 0) sm.v[tk][w * 16 + j] = acc;
      }
    } else if (mixer == 1) {
      for (int tk = 0; tk < TC; ++tk) {
        float vj = sm.v[tk][w * 16 + j];
        float a = sm.sc[tk][0], beta = sm.sc[tk][1], qk = sm.sc[tk][2];
        const float4* qp = (const float4*)&sm.q[tk][gq * 32];
        const float4* kp = (const float4*)&sm.k[tk][gq * 32];
        float kr[32];
        float rr = 0.f, pq = 0.f;
#pragma unroll
        for (int i = 0; i < 8; ++i) {
          float4 q4 = qp[i], k4 = kp[i];
          kr[4 * i + 0] = k4.x; kr[4 * i + 1] = k4.y; kr[4 * i + 2] = k4.z; kr[4 * i + 3] = k4.w;
          rr += k4.x * S[4 * i + 0]; pq += q4.x * S[4 * i + 0];
          rr += k4.y * S[4 * i + 1]; pq += q4.y * S[4 * i + 1];
          rr += k4.z * S[4 * i + 2]; pq += q4.z * S[4 * i + 2];
          rr += k4.w * S[4 * i + 3]; pq += q4.w * S[4 * i + 3];
        }
        rr += __shfl_xor(rr, 16); pq += __shfl_xor(pq, 16);
        rr += __shfl_xor(rr, 32); pq += __shfl_xor(pq, 32);
        float vn = beta * (vj - a * rr);
        float ov = a * pq + qk * vn;
#pragma unroll
        for (int i = 0; i < 32; ++i) S[i] = a * S[i] + kr[i] * vn;
        if (gq == 0) sm.v[tk][w * 16 + j] = ov;
      }
    } else {
      for (int tk = 0; tk < TC; ++tk) {
        float vj = sm.v[tk][w * 16 + j];
        float fd = sm.sc[tk][0], iw = sm.sc[tk][1], em = sm.sc[tk][2];
        float ivj = iw * vj;
        const float4* qp = (const float4*)&sm.q[tk][gq * 32];
        const float4* kp = (const float4*)&sm.k[tk][gq * 32];
        float acc = 0.f;
#pragma unroll
        for (int i = 0; i < 8; ++i) {
          float4 q4 = qp[i], k4 = kp[i];
          S[4 * i + 0] = fd * S[4 * i + 0] + k4.x * ivj; acc += q4.x * S[4 * i + 0];
          S[4 * i + 1] = fd * S[4 * i + 1] + k4.y * ivj; acc += q4.y * S[4 * i + 1];
          S[4 * i + 2] = fd * S[4 * i + 2] + k4.z * ivj; acc += q4.z * S[4 * i + 2];
          S[4 * i + 3] = fd * S[4 * i + 3] + k4.w * ivj; acc += q4.w * S[4 * i + 3];
        }
        float2 kk = *(const float2*)&sm.k[tk][gq * 32 + 2 * j];
        float2 qq = *(const float2*)&sm.q[tk][gq * 32 + 2 * j];
        n0 = fd * n0 + iw * kk.x; n1 = fd * n1 + iw * kk.y;
        float den = n0 * qq.x + n1 * qq.y;
        den = wave_sum(den);
        acc += __shfl_xor(acc, 16); acc += __shfl_xor(acc, 32);
        if (gq == 0) sm.v[tk][w * 16 + j] = acc / fmaxf(fabsf(den), em);
      }
    }
    __syncthreads();
    {
      int tok = tid >> 3, c8 = tid & 7;
      int row = scan_row(bl, dir, pos0 + tok);
      const float* op = &sm.v[tok][c8 * 8];
      uint4 o;
      o.x = pack2(op[0], op[1]); o.y = pack2(op[2], op[3]); o.z = pack2(op[4], op[5]); o.w = pack2(op[6], op[7]);
      *(uint4*)(p.obuf + ((long)dir * TG + row) * 3072 + ocol + c8 * 8) = o;
    }
  }
}

struct CSmem {
  u16 QA[32][136];
  u16 KA[32][136];
  u16 KDT[128][40];
  u16 XT[64][40];
  u16 ATT[32][40];
  u16 ST[64][136];
  float sc[32][8];
  union {
    struct { u16 QD[32][136]; float dec[128]; float hsum[2][128]; } hg;
    struct { u16 YT[64][40]; u16 TM[32][40]; float NM[32][36]; u16 VF[32][72]; } gd;
    struct { float nvec[128]; } ml;
  } u;
};

__device__ __forceinline__ f32x4 mfma16(bf16x8 a, bf16x8 b, f32x4 c) { return __builtin_amdgcn_mfma_f32_16x16x32_bf16(a, b, c, 0, 0, 0); }
__device__ __forceinline__ bf16x8 ldf(const u16* base, int ld, int row, int k) { return *(const bf16x8*)(base + row * ld + k); }
__device__ __forceinline__ void st4(u16* dst, float a, float b, float c, float d) { uint2 v; v.x = pack2(a, b); v.y = pack2(c, d); *(uint2*)dst = v; }

__device__ void scan_unit_mma(const Params& p, int l, int g, int u, CSmem& sm) {
  const int tid0 = otid();
  const int mixer = u / 128, r = u % 128;
  int bl, h, dir, vs;
  bl = r / 32;
  if (mixer < 2) { h = (r % 32) / 4; dir = (r % 4) / 2; vs = r % 2; }
  else { h = (r % 32) / 8; dir = (r % 8) / 4; vs = r % 4; }
  int cq, ck, cv, ocol;
  if (mixer == 0) { cq = C_HGQ + h * 128; ck = C_HGF + dir * 1024 + h * 128; cv = C_HGI + h * 128 + vs * 64; ocol = h * 128 + vs * 64; }
  else if (mixer == 1) { cq = C_GQ + h * 128; ck = C_GK + h * 128; cv = C_GV + h * 128 + vs * 64; ocol = 1024 + h * 128 + vs * 64; }
  else { cq = C_MQ + h * 128; ck = C_MK + h * 128; cv = C_MV + h * 256 + vs * 64; ocol = 2048 + h * 256 + vs * 64; }
  const float QS = 0.08838834764831845f;

  f32x4 S[2][4];
#pragma unroll
  for (int a = 0; a < 2; ++a)
#pragma unroll
    for (int b = 0; b < 4; ++b) S[a][b] = f32x4{0.f, 0.f, 0.f, 0.f};
  float mcar = 0.f;
  float gA = 0.f, gDt = 0.f, ibias = 0.f, fbias = 0.f;
  if (mixer == 1) { gA = -__expf(p.gdn_a_log[l * 16 + dir * 8 + h]); gDt = p.gdn_dt_bias[l * 16 + dir * 8 + h]; }
  if (mixer == 2) { ibias = p.ml_i_bias[l * 8 + dir * 4 + h]; fbias = p.ml_f_bias[l * 8 + dir * 4 + h]; }

  __syncthreads();
  for (int i = tid0; i < 64 * 136 / 2; i += 256) ((unsigned*)&sm.ST[0][0])[i] = 0u;
  if (mixer == 2 && tid0 < 128) sm.u.ml.nvec[tid0] = 0.f;
  __syncthreads();


  for (int ch0 = 0; ch0 < TPB / 32; ++ch0) {
    const int tid = otid(), lane = tid & 63, w = tid >> 6, fr = lane & 15, fq = lane >> 4;
    const int rt_o = w & 1, cp_o = w >> 1;
    const int pos0 = ch0 * 32;
    const bool is_ctx = pos0 < CTX;
    float mnew = 0.f;
    if (mixer == 0) {
      const int d = tid & 127, hh = tid >> 7;
      const float lbv = p.lb[l * D + h * 128 + d];
      float bb[16], qv[16], kv[16];
      float run = 0.f;
#pragma unroll
      for (int i = 0; i < 16; ++i) {
        int row = scan_row(bl, dir, pos0 + hh * 16 + i);
        const u16* pr = p.proj + (long)row * PLD;
        float fx = bf2f(pr[ck + d]);
        qv[i] = bf2f(pr[cq + d]);
        float f = lbv + (1.f - lbv) * sigmoidf_(fx);
        kv[i] = 1.f - f;
        run += __logf(f);
        bb[i] = run;
      }
      sm.u.hg.hsum[hh][d] = run;
      {
        int t = tid >> 3, c8 = tid & 7;
        int row = scan_row(bl, dir, pos0 + t);
        uint4 raw = *(const uint4*)(p.proj + (long)row * PLD + cv + c8 * 8);
        sm.XT[c8 * 8 + 0][t] = (u16)(raw.x & 0xffffu); sm.XT[c8 * 8 + 1][t] = (u16)(raw.x >> 16);
        sm.XT[c8 * 8 + 2][t] = (u16)(raw.y & 0xffffu); sm.XT[c8 * 8 + 3][t] = (u16)(raw.y >> 16);
        sm.XT[c8 * 8 + 4][t] = (u16)(raw.z & 0xffffu); sm.XT[c8 * 8 + 5][t] = (u16)(raw.z >> 16);
        sm.XT[c8 * 8 + 6][t] = (u16)(raw.w & 0xffffu); sm.XT[c8 * 8 + 7][t] = (u16)(raw.w >> 16);
      }
      __syncthreads();
      float h0 = sm.u.hg.hsum[0][d], h1 = sm.u.hg.hsum[1][d];
      float bref = h0, bend = h0 + h1, off = hh ? h0 : 0.f;
      if (hh == 0) sm.u.hg.dec[d] = __expf(bend);
      unsigned kd2[8];
#pragma unroll
      for (int i = 0; i < 16; ++i) {
        float b = bb[i] + off;
        float qa = qv[i] * __expf(fminf(b - bref, 80.f));
        float ka = kv[i] * __expf(fminf(bref - b, 80.f));
        float qd = qv[i] * __expf(b);
        float kd = kv[i] * __expf(bend - b);
        int t = hh * 16 + i;
        sm.QA[t][d] = f2bf(qa); sm.KA[t][d] = f2bf(ka); sm.u.hg.QD[t][d] = f2bf(qd);
        if (i & 1) kd2[i >> 1] |= ((unsigned)f2bf(kd)) << 16; else kd2[i >> 1] = (unsigned)f2bf(kd);
      }
      *(uint4*)&sm.KDT[d][hh * 16] = uint4{kd2[0], kd2[1], kd2[2], kd2[3]};
      *(uint4*)&sm.KDT[d][hh * 16 + 8] = uint4{kd2[4], kd2[5], kd2[6], kd2[7]};
      __syncthreads();
    } else if (mixer == 1) {
      for (int idx = tid; idx < 32 * 40; idx += 256) {
        int tok = idx / 40, cgp = idx % 40;
        int row = scan_row(bl, dir, pos0 + tok);
        int col, chn;
        if (cgp < 16) { col = cq + cgp * 8; chn = h * 128 + cgp * 8; }
        else if (cgp < 32) { col = ck + (cgp - 16) * 8; chn = 1024 + h * 128 + (cgp - 16) * 8; }
        else { col = cv + (cgp - 32) * 8; chn = 2048 + h * 128 + vs * 64 + (cgp - 32) * 8; }
        const float* cwb = p.gdn_conv + (long)l * 9 * 3072 + chn;
        float val[8];
#pragma unroll
        for (int e = 0; e < 8; ++e) val[e] = 0.f;
        int t = row - bl * TPB;
        if (is_ctx) {
#pragma unroll
          for (int jj = 0; jj < 3; ++jj) {
            int tt = t + jj - 1;
            if (tt >= 0 && tt < CTX) {
              uint4 raw = *(const uint4*)(p.proj + (long)(bl * TPB + tt) * PLD + col);
              float xv[8]; unpack8(raw, xv);
              float4 w0 = *(const float4*)(cwb + (3 + jj) * 3072), w1 = *(const float4*)(cwb + (3 + jj) * 3072 + 4);
              val[0] += xv[0] * w0.x; val[1] += xv[1] * w0.y; val[2] += xv[2] * w0.z; val[3] += xv[3] * w0.w;
              val[4] += xv[4] * w1.x; val[5] += xv[5] * w1.y; val[6] += xv[6] * w1.z; val[7] += xv[7] * w1.w;
            }
          }
        } else {
          int lt = t - CTX, rr0 = lt >> 6, cc0 = lt & 63;
#pragma unroll
          for (int ii = 0; ii < 3; ++ii) {
            int rr = rr0 + ii - 1;
            if (rr < 0 || rr >= 32) continue;
#pragma unroll
            for (int jj = 0; jj < 3; ++jj) {
              int cc = cc0 + jj - 1;
              if (cc < 0 || cc >= 64) continue;
              uint4 raw = *(const uint4*)(p.proj + (long)(bl * TPB + CTX + rr * 64 + cc) * PLD + col);
              float xv[8]; unpack8(raw, xv);
              float4 w0 = *(const float4*)(cwb + (ii * 3 + jj) * 3072), w1 = *(const float4*)(cwb + (ii * 3 + jj) * 3072 + 4);
              val[0] += xv[0] * w0.x; val[1] += xv[1] * w0.y; val[2] += xv[2] * w0.z; val[3] += xv[3] * w0.w;
              val[4] += xv[4] * w1.x; val[5] += xv[5] * w1.y; val[6] += xv[6] * w1.z; val[7] += xv[7] * w1.w;
            }
          }
        }
        uint4 o;
        o.x = pack2(siluf_(val[0]), siluf_(val[1])); o.y = pack2(siluf_(val[2]), siluf_(val[3]));
        o.z = pack2(siluf_(val[4]), siluf_(val[5])); o.w = pack2(siluf_(val[6]), siluf_(val[7]));
        if (cgp < 16) *(uint4*)&sm.QA[tok][cgp * 8] = o;
        else if (cgp < 32) *(uint4*)&sm.KA[tok][(cgp - 16) * 8] = o;
        else *(uint4*)&sm.u.gd.VF[tok][(cgp - 32) * 8] = o;
      }
      __syncthreads();
      for (int tk = w * 8; tk < w * 8 + 8; ++tk) {
        float q0 = bf2f(sm.QA[tk][lane]), q1 = bf2f(sm.QA[tk][lane + 64]), k0 = bf2f(sm.KA[tk][lane]), k1 = bf2f(sm.KA[tk][lane + 64]);
        float sq = wave_sum(q0 * q0 + q1 * q1), sk = wave_sum(k0 * k0 + k1 * k1);
        if (lane == 0) { sm.sc[tk][2] = rsqrtf(sq + 1e-6f) * QS; sm.sc[tk][3] = rsqrtf(sk + 1e-6f); }
      }
      if (w == 0) {
        int tk = lane & 31;
        int row = scan_row(bl, dir, pos0 + tk);
        float beta = sigmoidf_(p.gates[(long)row * GLD + dir * 8 + h]);
        float gg = gA * softplusf_(p.gates[(long)row * GLD + 16 + dir * 8 + h] + gDt);
        float G = gg;
#pragma unroll
        for (int o = 1; o < 32; o <<= 1) { float t2 = __shfl_up(G, o); if (tk >= o) G += t2; }
        if (lane < 32) { sm.sc[tk][0] = G; sm.sc[tk][1] = beta; }
      }
      __syncthreads();
      {
        const int d = tid & 127, hh = tid >> 7;
        float Gend = sm.sc[31][0];
        unsigned kd2[8];
#pragma unroll
        for (int i = 0; i < 16; ++i) {
          int s_ = hh * 16 + i;
          float kd = bf2f(sm.KA[s_][d]) * sm.sc[s_][3] * __expf(Gend - sm.sc[s_][0]);
          if (i & 1) kd2[i >> 1] |= ((unsigned)f2bf(kd)) << 16; else kd2[i >> 1] = (unsigned)f2bf(kd);
        }
        *(uint4*)&sm.KDT[d][hh * 16] = uint4{kd2[0], kd2[1], kd2[2], kd2[3]};
        *(uint4*)&sm.KDT[d][hh * 16 + 8] = uint4{kd2[4], kd2[5], kd2[6], kd2[7]};
      }
      {
        const int ai = w & 1, bi = w >> 1;
        if (ai >= bi) {
          f32x4 acc = f32x4{0.f, 0.f, 0.f, 0.f};
#pragma unroll
          for (int kk = 0; kk < 4; ++kk)
            acc = mfma16(ldf(&sm.KA[0][0], 136, ai * 16 + fr, kk * 32 + fq * 8), ldf(&sm.KA[0][0], 136, bi * 16 + fr, kk * 32 + fq * 8), acc);
          int b = bi * 16 + fr;
          float Gb = sm.sc[b][0], rkb = sm.sc[b][3];
#pragma unroll
          for (int j = 0; j < 4; ++j) {
            int a = ai * 16 + fq * 4 + j;
            if (a > b) sm.u.gd.NM[a][b] = sm.sc[a][1] * sm.sc[a][3] * rkb * acc[j] * __expf(sm.sc[a][0] - Gb);
          }
        }
      }
      __syncthreads();
    } else {
      for (int idx = tid; idx < 32 * 32; idx += 256) {
        int tok = idx >> 5, c = idx & 31;
        int row = scan_row(bl, dir, pos0 + tok);
        if (c < 16) *(uint4*)&sm.QA[tok][c * 8] = *(const uint4*)(p.proj + (long)row * PLD + cq + c * 8);
        else *(uint4*)&sm.KA[tok][(c - 16) * 8] = *(const uint4*)(p.proj + (long)row * PLD + ck + (c - 16) * 8);
      }
      {
        int t = tid >> 3, c8 = tid & 7;
        int row = scan_row(bl, dir, pos0 + t);
        uint4 raw = *(const uint4*)(p.proj + (long)row * PLD + cv + c8 * 8);
        sm.XT[c8 * 8 + 0][t] = (u16)(raw.x & 0xffffu); sm.XT[c8 * 8 + 1][t] = (u16)(raw.x >> 16);
        sm.XT[c8 * 8 + 2][t] = (u16)(raw.y & 0xffffu); sm.XT[c8 * 8 + 3][t] = (u16)(raw.y >> 16);
        sm.XT[c8 * 8 + 4][t] = (u16)(raw.z & 0xffffu); sm.XT[c8 * 8 + 5][t] = (u16)(raw.z >> 16);
        sm.XT[c8 * 8 + 6][t] = (u16)(raw.w & 0xffffu); sm.XT[c8 * 8 + 7][t] = (u16)(raw.w >> 16);
      }
      if (w == 0) {
        int tk = lane & 31;
        int row = scan_row(bl, dir, pos0 + tk);
        float ig = p.gates[(long)row * GLD + 32 + dir * 4 + h] + ibias;
        float fx = p.gates[(long)row * GLD + 40 + dir * 4 + h] + fbias;
        float F = -softplusf_(-fx);
#pragma unroll
        for (int o = 1; o < 32; o <<= 1) { float t2 = __shfl_up(F, o); if (tk >= o) F += t2; }
        float a = ig - F;
        float pm = a;
#pragma unroll
        for (int o = 1; o < 32; o <<= 1) { float t2 = __shfl_up(pm, o); if (tk >= o) pm = fmaxf(pm, t2); }
        float M = fmaxf(mcar, pm);
        if (lane < 32) { sm.sc[tk][0] = F; sm.sc[tk][1] = a; sm.sc[tk][2] = M; }
      }
      __syncthreads();
      {
        const int d = tid & 127, hh = tid >> 7;
        float Mend = sm.sc[31][2];
        mnew = sm.sc[31][0] + Mend;
        unsigned kd2[8];
#pragma unroll
        for (int i = 0; i < 16; ++i) {
          int s_ = hh * 16 + i;
          float kd = bf2f(sm.KA[s_][d]) * __expf(sm.sc[s_][1] - Mend);
          if (i & 1) kd2[i >> 1] |= ((unsigned)f2bf(kd)) << 16; else kd2[i >> 1] = (unsigned)f2bf(kd);
        }
        *(uint4*)&sm.KDT[d][hh * 16] = uint4{kd2[0], kd2[1], kd2[2], kd2[3]};
        *(uint4*)&sm.KDT[d][hh * 16 + 8] = uint4{kd2[4], kd2[5], kd2[6], kd2[7]};
      }
    }
    if (mixer == 1 && w == 0) {
      if (lane < 32) {
        const int c = lane;
        float Tc[32];
#pragma unroll
        for (int t = 0; t < 32; ++t) {
          float v = (t == c) ? 1.f : 0.f;
#pragma unroll
          for (int s4 = 0; s4 < (t + 3) / 4; ++s4) {
            float4 n4 = *(const float4*)&sm.u.gd.NM[t][s4 * 4];
            if (s4 * 4 + 0 < t) v -= n4.x * Tc[s4 * 4 + 0];
            if (s4 * 4 + 1 < t) v -= n4.y * Tc[s4 * 4 + 1];
            if (s4 * 4 + 2 < t) v -= n4.z * Tc[s4 * 4 + 2];
            if (s4 * 4 + 3 < t) v -= n4.w * Tc[s4 * 4 + 3];
          }
          Tc[t] = v;
          sm.u.gd.TM[t][c] = f2bf(v);
          __builtin_amdgcn_sched_barrier(0);
        }
      }
      { int t = lane >> 2, s4 = (lane & 3) * 4; *(uint2*)&sm.ATT[t][16 + s4] = uint2{0u, 0u}; }
    } else {
      int si, ti; bool doit = true;
      if (mixer == 1) { si = (w == 3) ? 1 : 0; ti = (w == 1) ? 0 : 1; }
      else { si = w & 1; ti = w >> 1; doit = !(si == 1 && ti == 0); }
      if (doit) {
        f32x4 acc = f32x4{0.f, 0.f, 0.f, 0.f};
#pragma unroll
        for (int kk = 0; kk < 4; ++kk)
          acc = mfma16(ldf(&sm.KA[0][0], 136, si * 16 + fr, kk * 32 + fq * 8), ldf(&sm.QA[0][0], 136, ti * 16 + fr, kk * 32 + fq * 8), acc);
        const int t = ti * 16 + fr;
        float o4[4];
        if (mixer == 0) {
#pragma unroll
          for (int j = 0; j < 4; ++j) { int s_ = si * 16 + fq * 4 + j; o4[j] = (s_ <= t) ? acc[j] : 0.f; }
        } else if (mixer == 1) {
          float Gt = sm.sc[t][0], rqt = sm.sc[t][2];
#pragma unroll
          for (int j = 0; j < 4; ++j) { int s_ = si * 16 + fq * 4 + j; o4[j] = (s_ <= t) ? acc[j] * rqt * sm.sc[s_][3] * __expf(Gt - sm.sc[s_][0]) : 0.f; }
        } else {
          float Mt = sm.sc[t][2];
#pragma unroll
          for (int j = 0; j < 4; ++j) { int s_ = si * 16 + fq * 4 + j; o4[j] = (s_ <= t) ? acc[j] * QS * __expf(sm.sc[s_][1] - Mt) : 0.f; }
        }
        st4(&sm.ATT[t][si * 16 + fq * 4], o4[0], o4[1], o4[2], o4[3]);
      } else {
        int t = lane >> 2, s4 = (lane & 3) * 4; *(uint2*)&sm.ATT[t][16 + s4] = uint2{0u, 0u};
      }
    }
    __syncthreads();
    if (mixer == 1) {
      f32x4 acc[2];
      acc[0] = acc[1] = f32x4{0.f, 0.f, 0.f, 0.f};
#pragma unroll
      for (int kk = 0; kk < 4; ++kk) {
        bf16x8 a = ldf(&sm.KA[0][0], 136, rt_o * 16 + fr, kk * 32 + fq * 8);
#pragma unroll
        for (int c = 0; c < 2; ++c) acc[c] = mfma16(a, ldf(&sm.ST[0][0], 136, (cp_o * 2 + c) * 16 + fr, kk * 32 + fq * 8), acc[c]);
      }
#pragma unroll
      for (int c = 0; c < 2; ++c) {
        int v = (cp_o * 2 + c) * 16 + fr;
        float y4[4];
#pragma unroll
        for (int j = 0; j < 4; ++j) {
          int t = rt_o * 16 + fq * 4 + j;
          float kg = sm.sc[t][3] * __expf(sm.sc[t][0]);
          y4[j] = sm.sc[t][1] * (bf2f(sm.u.gd.VF[t][v]) - kg * acc[c][j]);
        }
        st4(&sm.u.gd.YT[v][rt_o * 16 + fq * 4], y4[0], y4[1], y4[2], y4[3]);
      }
      __syncthreads();
      {
        bf16x8 a = ldf(&sm.u.gd.TM[0][0], 40, rt_o * 16 + fr, fq * 8);
#pragma unroll
        for (int c = 0; c < 2; ++c) {
          int vt = cp_o * 2 + c;
          f32x4 vn = mfma16(a, ldf(&sm.u.gd.YT[0][0], 40, vt * 16 + fr, fq * 8), f32x4{0.f, 0.f, 0.f, 0.f});
          st4(&sm.XT[vt * 16 + fr][rt_o * 16 + fq * 4], vn[0], vn[1], vn[2], vn[3]);
        }
      }
      __syncthreads();
    } else if (mixer == 2) {
      int t = tid >> 3, part = tid & 7;
      float qn = 0.f;
#pragma unroll
      for (int e = 0; e < 16; ++e) qn += bf2f(sm.QA[t][part * 16 + e]) * sm.u.ml.nvec[part * 16 + e];
      float as = 0.f;
#pragma unroll
      for (int e = 0; e < 4; ++e) as += bf2f(sm.ATT[t][part * 4 + e]);
      float Mt = sm.sc[t][2];
      float den = QS * __expf(mcar - Mt) * qn + as;
      den += __shfl_xor(den, 1); den += __shfl_xor(den, 2); den += __shfl_xor(den, 4);
      if (part == 0) sm.sc[t][4] = 1.f / fmaxf(fabsf(den), __expf(-(sm.sc[t][0] + Mt)));
      __syncthreads();
    }
    {
      f32x4 acc[2];
      acc[0] = acc[1] = f32x4{0.f, 0.f, 0.f, 0.f};
      const u16* Qs = (mixer == 0) ? &sm.u.hg.QD[0][0] : &sm.QA[0][0];
#pragma unroll
      for (int kk = 0; kk < 4; ++kk) {
        bf16x8 a = ldf(Qs, 136, rt_o * 16 + fr, kk * 32 + fq * 8);
#pragma unroll
        for (int c = 0; c < 2; ++c) acc[c] = mfma16(a, ldf(&sm.ST[0][0], 136, (cp_o * 2 + c) * 16 + fr, kk * 32 + fq * 8), acc[c]);
      }
      float rs[4], fs[4];
#pragma unroll
      for (int j = 0; j < 4; ++j) {
        int t = rt_o * 16 + fq * 4 + j;
        if (mixer == 0) { rs[j] = 1.f; fs[j] = 1.f; }
        else if (mixer == 1) { rs[j] = sm.sc[t][2] * __expf(sm.sc[t][0]); fs[j] = 1.f; }
        else { rs[j] = QS * __expf(mcar - sm.sc[t][2]); fs[j] = sm.sc[t][4]; }
      }
#pragma unroll
      for (int c = 0; c < 2; ++c)
#pragma unroll
        for (int j = 0; j < 4; ++j) acc[c][j] *= rs[j];
      {
        bf16x8 a = ldf(&sm.ATT[0][0], 40, rt_o * 16 + fr, fq * 8);
#pragma unroll
        for (int c = 0; c < 2; ++c) acc[c] = mfma16(a, ldf(&sm.XT[0][0], 40, (cp_o * 2 + c) * 16 + fr, fq * 8), acc[c]);
      }
#pragma unroll
      for (int j = 0; j < 4; ++j) {
        int t = rt_o * 16 + fq * 4 + j;
        int row = scan_row(bl, dir, pos0 + t);
        u16* dst = p.obuf + ((long)dir * TG + row) * 3072 + ocol;
#pragma unroll
        for (int c = 0; c < 2; ++c) dst[(cp_o * 2 + c) * 16 + fr] = f2bf(acc[c][j] * fs[j]);
      }
    }
    __syncthreads();
    {
      float dsc = 1.f;
      if (mixer == 1) dsc = __expf(sm.sc[31][0]);
      else if (mixer == 2) dsc = __expf(mcar - sm.sc[31][2]);
#pragma unroll
      for (int rt = 0; rt < 2; ++rt) {
        if (mixer == 0) {
          float4 d4 = *(const float4*)&sm.u.hg.dec[w * 32 + rt * 16 + fq * 4];
#pragma unroll
          for (int ct = 0; ct < 4; ++ct) { S[rt][ct][0] *= d4.x; S[rt][ct][1] *= d4.y; S[rt][ct][2] *= d4.z; S[rt][ct][3] *= d4.w; }
        } else {
#pragma unroll
          for (int ct = 0; ct < 4; ++ct) { S[rt][ct][0] *= dsc; S[rt][ct][1] *= dsc; S[rt][ct][2] *= dsc; S[rt][ct][3] *= dsc; }
        }
        bf16x8 a = ldf(&sm.KDT[0][0], 40, w * 32 + rt * 16 + fr, fq * 8);
#pragma unroll
        for (int ct = 0; ct < 4; ++ct) {
          S[rt][ct] = mfma16(a, ldf(&sm.XT[0][0], 40, ct * 16 + fr, fq * 8), S[rt][ct]);
          st4(&sm.ST[ct * 16 + fr][w * 32 + rt * 16 + fq * 4], S[rt][ct][0], S[rt][ct][1], S[rt][ct][2], S[rt][ct][3]);
        }
      }
      if (mixer == 2) {
        if (tid < 128) {
          float sum = 0.f;
#pragma unroll
          for (int e = 0; e < 32; ++e) sum += bf2f(sm.KDT[tid][e]);
          sm.u.ml.nvec[tid] = dsc * sm.u.ml.nvec[tid] + sum;
        }
        mcar = mnew;
      }
    }
    __syncthreads();
  }
}

#define MMA_MASK 7
__device__ void ph_scan(const Params& p, int l, int g, char* smem) {
  for (int u = blockIdx.x; u < 384; u += gridDim.x) {
    int mixer = u / 128;
#if MMA_MASK == 7
    scan_unit_mma(p, l, g, u, *(CSmem*)smem);
#else
    if ((MMA_MASK >> mixer) & 1) scan_unit_mma(p, l, g, u, *(CSmem*)smem);
    else scan_unit(p, l, g, u, *(ScanSmem*)smem);
#endif
  }
}

__device__ void ph_brfin(const Params& p, int l, int g) {
  const int tid = otid();
  const int lane = tid & 63;
  const int gw = blockIdx.x * 4 + (tid >> 6), nw = gridDim.x * 4;
  for (int wu = gw; wu < TG * 3; wu += nw) {
    int row = wu / 3, mixer = wu % 3;
    int pp = row % TPB;
    if (l == 1 && pp < CTX) continue;
    const u16* of = p.obuf + (long)row * 3072 + mixer * 1024 + lane * 16;
    const u16* ob = p.obuf + ((long)TG + row) * 3072 + mixer * 1024 + lane * 16;
    float o[16], t8[8];
    uint4 a0 = *(const uint4*)of, a1 = *(const uint4*)(of + 8), b0 = *(const uint4*)ob, b1 = *(const uint4*)(ob + 8);
    unpack8(a0, o); unpack8(a1, o + 8);
    unpack8(b0, t8);
#pragma unroll
    for (int e = 0; e < 8; ++e) o[e] += t8[e];
    unpack8(b1, t8);
#pragma unroll
    for (int e = 0; e < 8; ++e) o[8 + e] += t8[e];
    float ss = 0.f;
#pragma unroll
    for (int e = 0; e < 16; ++e) ss += o[e] * o[e];
    ss += __shfl_xor(ss, 1); ss += __shfl_xor(ss, 2); ss += __shfl_xor(ss, 4);
    float hd = 128.f;
    if (mixer == 2) { ss += __shfl_xor(ss, 8); hd = 256.f; }
    float rs = rsqrtf(ss / hd + 1e-6f);
    const float* on = (mixer == 0 ? p.hg_onorm : (mixer == 1 ? p.gdn_onorm : p.ml_onorm)) + l * D + lane * 16;
    int zc = mixer == 0 ? C_HGZ : (mixer == 1 ? C_GZ : C_MZ);
    const u16* zp = p.proj + (long)row * PLD + zc + lane * 16;
    float z[16];
    uint4 z0 = *(const uint4*)zp, z1 = *(const uint4*)(zp + 8);
    unpack8(z0, z); unpack8(z1, z + 8);
    float res[16];
#pragma unroll
    for (int e = 0; e < 16; ++e) res[e] = o[e] * rs * on[e] * siluf_(z[e]);
    if (mixer == 2) {
      const u16* gp = p.proj + (long)row * PLD + C_MO + lane * 16;
      uint4 g0 = *(const uint4*)gp, g1 = *(const uint4*)(gp + 8);
      unpack8(g0, z); unpack8(g1, z + 8);
#pragma unroll
      for (int e = 0; e < 16; ++e) res[e] *= sigmoidf_(z[e]);
    }
    uint4 w0, w1;
    w0.x = pack2(res[0], res[1]); w0.y = pack2(res[2], res[3]); w0.z = pack2(res[4], res[5]); w0.w = pack2(res[6], res[7]);
    w1.x = pack2(res[8], res[9]); w1.y = pack2(res[10], res[11]); w1.z = pack2(res[12], res[13]); w1.w = pack2(res[14], res[15]);
    u16* dst = p.obuf + (long)row * 3072 + mixer * 1024 + lane * 16;
    *(uint4*)dst = w0; *(uint4*)(dst + 8) = w1;
  }
}

__device__ void ph_gemm_merge(const Params& p, int l, char* smem) {
  const int tid = otid();
  const int wid = tid >> 6, lane = tid & 63, wr = wid >> 1, wc = wid & 1, fr = lane & 15, fq = lane >> 4;
  for (int t = blockIdx.x; t < 72 * 16; t += gridDim.x) {
    int nt = t / 72, mt = t % 72;
    if (l == 1 && (mt % 18) < 2) continue;
    f32x4 tot[4][2];
#pragma unroll
    for (int m = 0; m < 4; ++m)
#pragma unroll
      for (int n = 0; n < 2; ++n) tot[m][n] = f32x4{0.f, 0.f, 0.f, 0.f};
    for (int i = 0; i < 3; ++i) {
      f32x4 acc[4][2];
#pragma unroll
      for (int m = 0; m < 4; ++m)
#pragma unroll
        for (int n = 0; n < 2; ++n) acc[m][n] = f32x4{0.f, 0.f, 0.f, 0.f};
      gemm_kloop<2>(p.obuf + (long)mt * 128 * 3072 + i * 1024, 3072, p.WbrT + ((long)i * D + nt * 64) * D, D, D, smem, acc);
#pragma unroll
      for (int m = 0; m < 4; ++m)
#pragma unroll
        for (int n = 0; n < 2; ++n)
#pragma unroll
          for (int j = 0; j < 4; ++j) {
            int row = mt * 128 + wr * 64 + m * 16 + fq * 4 + j, col = nt * 64 + wc * 32 + n * 16 + fr;
            float gv = bf2f(p.proj[(long)row * PLD + C_GATE + i * 1024 + col]);
            tot[m][n][j] += sigmoidf_(gv) * acc[m][n][j];
          }
    }
#pragma unroll
    for (int m = 0; m < 4; ++m)
#pragma unroll
      for (int n = 0; n < 2; ++n)
#pragma unroll
        for (int j = 0; j < 4; ++j) {
          int row = mt * 128 + wr * 64 + m * 16 + fq * 4 + j, col = nt * 64 + wc * 32 + n * 16 + fr;
          p.hbuf[(long)row * D + col] = f2bf(tot[m][n][j]);
        }
  }
}

__device__ void ph_gemm_out(const Params& p, int l, int g, char* smem) {
  const int tid = otid();
  const int wid = tid >> 6, lane = tid & 63, wr = wid >> 1, wc = wid & 1, fr = lane & 15, fq = lane >> 4;
  for (int t = blockIdx.x; t < 72 * 8; t += gridDim.x) {
    int nt = t / 72, mt = t % 72;
    if (l == 1 && (mt % 18) < 2) continue;
    f32x4 acc[4][4];
#pragma unroll
    for (int m = 0; m < 4; ++m)
#pragma unroll
      for (int n = 0; n < 4; ++n) acc[m][n] = f32x4{0.f, 0.f, 0.f, 0.f};
    gemm_kloop<4>(p.hbuf + (long)mt * 128 * D, D, p.WoT + (long)nt * 128 * D, D, D, smem, acc);
#pragma unroll
    for (int m = 0; m < 4; ++m)
#pragma unroll
      for (int j = 0; j < 4; ++j) {
        int row = mt * 128 + wr * 64 + m * 16 + fq * 4 + j;
        int bl = row / TPB, pp = row % TPB, b = g * GB + bl;
        const float* src; float* dst; int mrow;
        if (pp < CTX) { src = p.ctx + ((long)b * CTX + pp) * D; dst = p.ctxs + ((long)b * CTX + pp) * D; mrow = 16; }
        else { long off = ((long)b * SEQ + (pp - CTX)) * D; src = (l == 0 ? p.x : p.out) + off; dst = p.out + off; mrow = b; }
        const float* gt = p.mod + ((long)l * 17 + mrow) * 3072 + 2048;
#pragma unroll
        for (int n = 0; n < 4; ++n) {
          int col = nt * 128 + wc * 64 + n * 16 + fr;
          dst[col] = src[col] + gt[col] * acc[m][n][j];
        }
      }
  }
}

__device__ void ph_final(const Params& p) {
  const int tid = otid();
  const int lane = tid & 63;
  const int gw = blockIdx.x * 4 + (tid >> 6), nw = gridDim.x * 4;
  for (int row = gw; row < NB * SEQ; row += nw) {
    float4* src = (float4*)(p.out + (long)row * D);
    float4 v[4]; float ss = 0.f;
#pragma unroll
    for (int i = 0; i < 4; ++i) {
      v[i] = src[lane + 64 * i];
      ss += v[i].x * v[i].x + v[i].y * v[i].y + v[i].z * v[i].z + v[i].w * v[i].w;
    }
    ss = wave_sum(ss);
    float rs = rsqrtf(ss * (1.f / D) + 1e-6f);
#pragma unroll
    for (int i = 0; i < 4; ++i) {
      float4 g4 = ((const float4*)p.final_g)[lane + 64 * i];
      float4 o; o.x = v[i].x * rs * g4.x; o.y = v[i].y * rs * g4.y; o.z = v[i].z * rs * g4.z; o.w = v[i].w * rs * g4.w;
      src[lane + 64 * i] = o;
    }
  }
}

constexpr int NSTEPS = 2 + 24 + 1 + 24 + 1;

__device__ void run_step(const Params& p, int step, char* smem) {
  if (step == 0) { ph_convert(p, 0, smem); ph_prep_small(p); return; }
  if (step == 1) { ph_mod(p, smem); return; }
  if (step == 26) { ph_convert(p, 1, smem); return; }
  if (step == NSTEPS - 1) { ph_final(p); return; }
  int l, s;
  if (step < 26) { l = 0; s = step - 2; } else { l = 1; s = step - 27; }
  int g = s / 6, k = s % 6;
  switch (k) {
    case 0: ph_prenorm(p, l, g); break;
    case 1: ph_gemm_in(p, smem); break;
    case 2: ph_scan(p, l, g, smem); break;
    case 3: ph_brfin(p, l, g); break;
    case 4: ph_gemm_merge(p, l, smem); break;
    case 5: ph_gemm_out(p, l, g, smem); break;
  }
}

#if !COOP
__global__ void __launch_bounds__(256, 2) k_step(Params p, int step) {
  __shared__ __attribute__((aligned(16))) char smem[sizeof(CSmem) > sizeof(ScanSmem) ? sizeof(CSmem) : sizeof(ScanSmem)];
  run_step(p, step, smem);
}
#else
__global__ void __launch_bounds__(256, 2) k_mega(Params p) {
  __shared__ __attribute__((aligned(16))) char smem[sizeof(CSmem) > sizeof(ScanSmem) ? sizeof(CSmem) : sizeof(ScanSmem)];
  cg::grid_group grid = cg::this_grid();
  ph_prep_small(p);
#pragma unroll 1
  for (int l = 0; l < 2; ++l) {
    ph_convert(p, l, smem);
    grid.sync();
    if (l == 0) { ph_mod(p, smem); grid.sync(); }
#pragma unroll 1
    for (int g = 0; g < NGRP; ++g) {
      for (int r = 0; r < REP_PRE; ++r) { ph_prenorm(p, l, g); grid.sync(); }
      for (int r = 0; r < REP_GIN; ++r) { ph_gemm_in(p, smem); grid.sync(); }
      for (int r = 0; r < REP_SCAN; ++r) { ph_scan(p, l, g, smem); grid.sync(); }
      ph_brfin(p, l, g); grid.sync();
      for (int r = 0; r < REP_MRG; ++r) { ph_gemm_merge(p, l, smem); grid.sync(); }
      ph_gemm_out(p, l, g, smem); grid.sync();
      for (int r = 0; r < REP_SYNC; ++r) grid.sync();
    }
  }
  ph_final(p);
}
#endif

extern "C" void kernel_launch(void* const* d_in, const int* in_sizes, int n_in, void* d_out, int out_size, void* d_ws,
                              size_t ws_size, hipStream_t stream) {
  Params p{};
  p.x = (const float*)d_in[0]; p.c = (const float*)d_in[1]; p.ctx = (const float*)d_in[2]; p.c_ctx = (const float*)d_in[3];
  p.ada_w = (const float*)d_in[4]; p.ada_b = (const float*)d_in[5]; p.norm_g = (const float*)d_in[6]; p.w_in = (const float*)d_in[7];
  p.hg_lb = (const float*)d_in[8]; p.hg_onorm = (const float*)d_in[9]; p.gdn_conv = (const float*)d_in[10];
  p.gdn_a_log = (const float*)d_in[11]; p.gdn_dt_bias = (const float*)d_in[12]; p.gdn_onorm = (const float*)d_in[13];
  p.ml_i_bias = (const float*)d_in[14]; p.ml_f_bias = (const float*)d_in[15]; p.ml_onorm = (const float*)d_in[16];
  p.w_branch = (const float*)d_in[17]; p.w_out = (const float*)d_in[18]; p.final_g = (const float*)d_in[19];
  p.out = (float*)d_out;
  char* ws = (char*)d_ws;
  size_t off = 0;
  auto take = [&](size_t bytes) { char* r = ws + off; off += (bytes + 255) & ~(size_t)255; return r; };
  p.WinT = (u16*)take((size_t)NPAD * D * 2);
  p.WbrT = (u16*)take((size_t)3 * D * D * 2);
  p.WoT = (u16*)take((size_t)D * D * 2);
  p.hbuf = (u16*)take((size_t)TG * D * 2);
  p.proj = (u16*)take((size_t)TG * PLD * 2);
  p.obuf = (u16*)take((size_t)2 * TG * 3072 * 2);
  p.mod = (float*)take((size_t)2 * 17 * 3072 * 4);
  p.lb = (float*)take((size_t)2 * D * 4);
  p.silc = (float*)take((size_t)17 * D * 4);
  p.gates = (float*)take((size_t)TG * GLD * 4);
  p.ctxs = (float*)take((size_t)NB * CTX * D * 4);
  if (off > ws_size) { fprintf(stderr, "workspace too small: need %zu have %zu\n", off, ws_size); return; }

  static int grid_blocks = 0;
  if (!grid_blocks) {
    int dev = 0, cus = 0, per_cu = 0;
    hipGetDevice(&dev);
    hipDeviceGetAttribute(&cus, hipDeviceAttributeMultiprocessorCount, dev);
#if COOP
    hipOccupancyMaxActiveBlocksPerMultiprocessor(&per_cu, k_mega, 256, 0);
#else
    hipOccupancyMaxActiveBlocksPerMultiprocessor(&per_cu, k_step, 256, 0);
#endif
    if (per_cu < 1) per_cu = 1;
    if (per_cu > 2) per_cu = 2;
    grid_blocks = cus * per_cu;
  }
#if COOP
  void* args[] = {&p};
  hipError_t e = hipLaunchCooperativeKernel((void*)k_mega, dim3(grid_blocks), dim3(256), args, 0, stream);
  if (e != hipSuccess) fprintf(stderr, "cooperative launch failed: %s (grid %d)\n", hipGetErrorString(e), grid_blocks);
#else
  for (int s = 0; s < NSTEPS; ++s) k_step<<<grid_blocks, 256, 0, stream>>>(p, s);
#endif
}
```

```cpp
#include <hip/hip_runtime.h>
#include <hip/hip_bf16.h>
#include <hip/hip_cooperative_groups.h>
#include <cstdio>
namespace cg = cooperative_groups;

#define REP_PRE 1
#define REP_GIN 1
#define REP_SCAN 1
#define REP_MRG 1
#define REP_SYNC 0
#ifndef COOP
#define COOP 1
#endif

typedef unsigned short u16;
using bf16x8 = __attribute__((ext_vector_type(8))) short;
using f32x4 = __attribute__((ext_vector_type(4))) float;

constexpr int D = 1024;
constexpr int NB = 16;
constexpr int SEQ = 2048;
constexpr int CTX = 256;
constexpr int TPB = SEQ + CTX;
constexpr int GB = 4;
constexpr int NGRP = NB / GB;
constexpr int TG = GB * TPB;
constexpr int IN_DIM = 16432;
constexpr int NPAD = 16512;
constexpr int PLD = 16384;
constexpr int GLD = 64;
constexpr int TC = 32;
constexpr int C_HGQ = 0, C_HGI = 1024, C_HGF = 2048, C_HGZ = 4096;
constexpr int C_GQ = 5120, C_GK = 6144, C_GV = 7168, C_GZ = 8192;
constexpr int C_MQ = 9216, C_MK = 9728, C_MV = 10240, C_MO = 11264, C_MZ = 12288;
constexpr int C_GATE = 13312;

struct Params {
  const float *x, *c, *ctx, *c_ctx, *ada_w, *ada_b, *norm_g, *w_in, *hg_lb, *hg_onorm, *gdn_conv,
      *gdn_a_log, *gdn_dt_bias, *gdn_onorm, *ml_i_bias, *ml_f_bias, *ml_onorm, *w_branch, *w_out, *final_g;
  float* out;
  u16 *WinT, *WbrT, *WoT, *hbuf, *proj, *obuf;
  float *mod, *lb, *silc, *gates, *ctxs;
  unsigned* bar;
};

__device__ __forceinline__ u16 f2bf(float f) {
  unsigned u = __float_as_uint(f);
  u += 0x7fffu + ((u >> 16) & 1u);
  return (u16)(u >> 16);
}
__device__ __forceinline__ float bf2f(u16 h) { return __uint_as_float(((unsigned)h) << 16); }
__device__ __forceinline__ float sigmoidf_(float x) { return 1.f / (1.f + __expf(-x)); }
__device__ __forceinline__ float siluf_(float x) { return x / (1.f + __expf(-x)); }
__device__ __forceinline__ float softplusf_(float y) { return fmaxf(y, 0.f) + log1pf(__expf(-fabsf(y))); }
__device__ __forceinline__ float wave_sum(float v) {
#pragma unroll
  for (int o = 32; o >= 1; o >>= 1) v += __shfl_xor(v, o);
  return v;
}
__device__ __forceinline__ void unpack8(const uint4& u, float* f) {
  f[0] = __uint_as_float(u.x << 16); f[1] = __uint_as_float(u.x & 0xffff0000u);
  f[2] = __uint_as_float(u.y << 16); f[3] = __uint_as_float(u.y & 0xffff0000u);
  f[4] = __uint_as_float(u.z << 16); f[5] = __uint_as_float(u.z & 0xffff0000u);
  f[6] = __uint_as_float(u.w << 16); f[7] = __uint_as_float(u.w & 0xffff0000u);
}
__device__ __forceinline__ unsigned pack2(float a, float b) { return (unsigned)f2bf(a) | ((unsigned)f2bf(b) << 16); }

__device__ __forceinline__ int otid() { int t = threadIdx.x; asm volatile("" : "+v"(t)); return t; }
__device__ __forceinline__ int win_src_col(int np) {
  if (np < 9216) return np;
  if (np < 13312) return np + 32;
  if (np < 16384) return np + 48;
  if (np < 16416) return 9216 + (np - 16384);
  if (np < 16432) return 13344 + (np - 16416);
  return -1;
}

__device__ void ph_convert(const Params& p, int l, char* smem) {
  float (*tile)[65] = (float (*)[65])smem;
  const int tid = otid();
  for (int t = blockIdx.x; t < 5152; t += gridDim.x) {
    const float* src; long sld; u16* dst; int n0, k0, kind;
    if (t < 4128) { kind = 0; n0 = (t / 16) * 64; k0 = (t % 16) * 64; src = p.w_in + (long)l * D * IN_DIM; sld = IN_DIM; dst = p.WinT; }
    else if (t < 4896) { int u = t - 4128; int i = u / 256; u %= 256; kind = 1; n0 = (u / 16) * 64; k0 = (u % 16) * 64;
      src = p.w_branch + ((long)l * 3 + i) * D * D; sld = D; dst = p.WbrT + (long)i * D * D; }
    else { int u = t - 4896; kind = 1; n0 = (u / 16) * 64; k0 = (u % 16) * 64; src = p.w_out + (long)l * D * D; sld = D; dst = p.WoT; }
#pragma unroll 4
    for (int i = 0; i < 16; ++i) {
      int kk = (tid >> 6) + 4 * i, nn = tid & 63;
      int np = n0 + nn;
      int ns = kind == 0 ? win_src_col(np) : np;
      tile[kk][nn] = ns >= 0 ? src[(long)(k0 + kk) * sld + ns] : 0.f;
    }
    __syncthreads();
#pragma unroll 4
    for (int i = 0; i < 16; ++i) {
      int nn = (tid >> 6) + 4 * i, kk = tid & 63;
      dst[(long)(n0 + nn) * D + k0 + kk] = f2bf(tile[kk][nn]);
    }
    __syncthreads();
  }
}

__device__ void ph_prep_small(const Params& p) {
  int gt = blockIdx.x * blockDim.x + otid(), gs = gridDim.x * blockDim.x;
  for (int i = gt; i < 17 * D + 2 * D; i += gs) {
    if (i < 16 * D) p.silc[i] = siluf_(p.c[i]);
    else if (i < 17 * D) p.silc[i] = siluf_(p.c_ctx[i - 16 * D]);
    else {
      int j = i - 17 * D;
      if (j < D) p.lb[j] = 0.f;
      else { int ch = j - D; p.lb[j] = sigmoidf_(p.hg_lb[D + ch] - p.hg_lb[ch]); }
    }
  }
}

__device__ void ph_mod(const Params& p, char* smem) {
  float (*red)[17][64] = (float (*)[17][64])smem;
  const int tid = otid();
  const int kq = __builtin_amdgcn_readfirstlane(tid >> 6), cc = tid & 63;
  for (int u = blockIdx.x; u < 96; u += gridDim.x) {
    int l = u / 48, col = (u % 48) * 64 + cc;
    float acc[17];
#pragma unroll
    for (int r = 0; r < 17; ++r) acc[r] = 0.f;
    const float* w = p.ada_w + (long)l * D * 3072 + col;
    for (int k = kq * 256; k < kq * 256 + 256; ++k) {
      float wv = w[(long)k * 3072];
#pragma unroll
      for (int r = 0; r < 17; ++r) acc[r] += p.silc[r * D + k] * wv;
    }
#pragma unroll
    for (int r = 0; r < 17; ++r) red[kq][r][cc] = acc[r];
    __syncthreads();
    for (int i = tid; i < 17 * 64; i += 256) {
      int r = i / 64, c2 = i % 64;
      int colo = (u % 48) * 64 + c2;
      float s = red[0][r][c2] + red[1][r][c2] + red[2][r][c2] + red[3][r][c2] + p.ada_b[l * 3072 + colo];
      p.mod[((long)l * 17 + r) * 3072 + colo] = s;
    }
    __syncthreads();
  }
}

__device__ void ph_prenorm(const Params& p, int l, int g) {
  const int tid = otid();
  const int lane = tid & 63;
  const int gw = blockIdx.x * 4 + (tid >> 6), nw = gridDim.x * 4;
  for (int row = gw; row < TG; row += nw) {
    int bl = row / TPB, pp = row % TPB, b = g * GB + bl;
    const float* src; int mrow;
    if (pp < CTX) { src = (l == 0 ? p.ctx : p.ctxs) + ((long)b * CTX + pp) * D; mrow = 16; }
    else { src = (l == 0 ? p.x : p.out) + ((long)b * SEQ + (pp - CTX)) * D; mrow = b; }
    const float* md = p.mod + ((long)l * 17 + mrow) * 3072;
    float4 v[4]; float ss = 0.f;
#pragma unroll
    for (int i = 0; i < 4; ++i) {
      v[i] = ((const float4*)src)[lane + 64 * i];
      ss += v[i].x * v[i].x + v[i].y * v[i].y + v[i].z * v[i].z + v[i].w * v[i].w;
    }
    ss = wave_sum(ss);
    float rs = rsqrtf(ss * (1.f / D) + 1e-6f);
#pragma unroll
    for (int i = 0; i < 4; ++i) {
      int idx = (lane + 64 * i) * 4;
      float4 g4 = *(const float4*)(p.norm_g + l * D + idx);
      float4 sh = *(const float4*)(md + idx);
      float4 sc = *(const float4*)(md + D + idx);
      float h0 = v[i].x * rs * g4.x * (1.f + sc.x) + sh.x;
      float h1 = v[i].y * rs * g4.y * (1.f + sc.y) + sh.y;
      float h2 = v[i].z * rs * g4.z * (1.f + sc.z) + sh.z;
      float h3 = v[i].w * rs * g4.w * (1.f + sc.w) + sh.w;
      uint2 o; o.x = pack2(h0, h1); o.y = pack2(h2, h3);
      *(uint2*)(p.hbuf + (long)row * D + idx) = o;
    }
  }
}

template <int NF>
__device__ __forceinline__ void gemm_kloop(const u16* Ag, long lda, const u16* Bg, long ldb, int K, char* smem, f32x4 (&acc)[4][NF]) {
  const int tid = otid();
  const int wid = tid >> 6, lane = tid & 63, wr = wid >> 1, wc = wid & 1, fr = lane & 15, fq = lane >> 4;
  char* SA = smem; char* SB = smem + 8192;
  for (int t = 0; t < K / 32; ++t) {
#pragma unroll
    for (int i = 0; i < 2; ++i) {
      int b = tid * 16 + i * 4096, r = b / 64, c = (b % 64) / 2;
      __builtin_amdgcn_global_load_lds((const unsigned*)(Ag + (long)r * lda + t * 32 + c), (__attribute__((address_space(3))) unsigned*)(SA + b), 16, 0, 0);
      if (NF == 4 || i == 0)
        __builtin_amdgcn_global_load_lds((const unsigned*)(Bg + (long)r * ldb + t * 32 + c), (__attribute__((address_space(3))) unsigned*)(SB + b), 16, 0, 0);
    }
    asm volatile("s_waitcnt vmcnt(0)" ::: "memory");
    __syncthreads();
    bf16x8 At[4], Bl[NF];
#pragma unroll
    for (int m = 0; m < 4; ++m) At[m] = *(const bf16x8*)(SA + (wr * 64 + m * 16 + fr) * 64 + fq * 16);
#pragma unroll
    for (int n = 0; n < NF; ++n) Bl[n] = *(const bf16x8*)(SB + (wc * NF * 16 + n * 16 + fr) * 64 + fq * 16);
#pragma unroll
    for (int m = 0; m < 4; ++m)
#pragma unroll
      for (int n = 0; n < NF; ++n) acc[m][n] = __builtin_amdgcn_mfma_f32_16x16x32_bf16(At[m], Bl[n], acc[m][n], 0, 0, 0);
    __syncthreads();
  }
}

__device__ void ph_gemm_in(const Params& p, char* smem) {
  const int tid = otid();
  const int wid = tid >> 6, lane = tid & 63, wr = wid >> 1, wc = wid & 1, fr = lane & 15, fq = lane >> 4;
  for (int t = blockIdx.x; t < 72 * 129; t += gridDim.x) {
    int nt = t / 72, mt = t % 72;
    f32x4 acc[4][4];
#pragma unroll
    for (int m = 0; m < 4; ++m)
#pragma unroll
      for (int n = 0; n < 4; ++n) acc[m][n] = f32x4{0.f, 0.f, 0.f, 0.f};
    gemm_kloop<4>(p.hbuf + (long)mt * 128 * D, D, p.WinT + (long)nt * 128 * D, D, D, smem, acc);
    if (nt < 128) {
      u16* dbase; long dld; int cb;
      if (nt >= 40 && nt < 64) { dbase = p.obuf + (long)TG * 3072; dld = 3072; cb = (nt - 40) * 128; }
      else { dbase = p.proj; dld = PLD; cb = nt * 128; }
#pragma unroll
      for (int m = 0; m < 4; ++m)
#pragma unroll
        for (int n = 0; n < 4; ++n)
#pragma unroll
          for (int j = 0; j < 4; ++j) {
            int row = mt * 128 + wr * 64 + m * 16 + fq * 4 + j, col = cb + wc * 64 + n * 16 + fr;
            dbase[(long)row * dld + col] = f2bf(acc[m][n][j]);
          }
    } else if (wc == 0) {
#pragma unroll
      for (int m = 0; m < 4; ++m)
#pragma unroll
        for (int n = 0; n < 4; ++n)
#pragma unroll
          for (int j = 0; j < 4; ++j) {
            int row = mt * 128 + wr * 64 + m * 16 + fq * 4 + j, col = n * 16 + fr;
            p.gates[(long)row * GLD + col] = acc[m][n][j];
          }
    }
  }
}

__device__ void ph_conv(const Params& p, int l) {
  const int tid = otid();
  const int lane = tid & 63;
  const int gw = blockIdx.x * 4 + (tid >> 6), nw = gridDim.x * 4;
  const u16* stg = p.obuf + (long)TG * 3072;
  for (int task = gw; task < TG * 8; task += nw) {
    int row = task >> 3, h = task & 7;
    int bl = row / TPB, t = row % TPB;
    int part = lane >> 4, c8 = lane & 15;
    int chn = part * 1024 + h * 128 + c8 * 8;
    float val[8];
#pragma unroll
    for (int e = 0; e < 8; ++e) val[e] = 0.f;
    if (part < 3) {
      const float* cwb = p.gdn_conv + (long)l * 9 * 3072 + chn;
      if (t < CTX) {
#pragma unroll
        for (int jj = 0; jj < 3; ++jj) {
          int tt = t + jj - 1;
          if (tt >= 0 && tt < CTX) {
            uint4 raw = *(const uint4*)(stg + (long)(bl * TPB + tt) * 3072 + chn);
            float xv[8]; unpack8(raw, xv);
            float4 w0 = *(const float4*)(cwb + (3 + jj) * 3072), w1 = *(const float4*)(cwb + (3 + jj) * 3072 + 4);
            val[0] += xv[0] * w0.x; val[1] += xv[1] * w0.y; val[2] += xv[2] * w0.z; val[3] += xv[3] * w0.w;
            val[4] += xv[4] * w1.x; val[5] += xv[5] * w1.y; val[6] += xv[6] * w1.z; val[7] += xv[7] * w1.w;
          }
        }
      } else {
        int lt = t - CTX, rr0 = lt >> 6, cc0 = lt & 63;
#pragma unroll
        for (int ii = 0; ii < 3; ++ii) {
          int rr = rr0 + ii - 1;
          if (rr < 0 || rr >= 32) continue;
#pragma unroll
          for (int jj = 0; jj < 3; ++jj) {
            int cc = cc0 + jj - 1;
            if (cc < 0 || cc >= 64) continue;
            uint4 raw = *(const uint4*)(stg + (long)(bl * TPB + CTX + rr * 64 + cc) * 3072 + chn);
            float xv[8]; unpack8(raw, xv);
            float4 w0 = *(const float4*)(cwb + (ii * 3 + jj) * 3072), w1 = *(const float4*)(cwb + (ii * 3 + jj) * 3072 + 4);
            val[0] += xv[0] * w0.x; val[1] += xv[1] * w0.y; val[2] += xv[2] * w0.z; val[3] += xv[3] * w0.w;
            val[4] += xv[4] * w1.x; val[5] += xv[5] * w1.y; val[6] += xv[6] * w1.z; val[7] += xv[7] * w1.w;
          }
        }
      }
    }
    float ss = 0.f;
#pragma unroll
    for (int e = 0; e < 8; ++e) { val[e] = siluf_(val[e]); ss += val[e] * val[e]; }
    ss += __shfl_xor(ss, 1); ss += __shfl_xor(ss, 2); ss += __shfl_xor(ss, 4); ss += __shfl_xor(ss, 8);
    float scl = 1.f;
    if (part == 0) scl = rsqrtf(ss + 1e-6f) * 0.08838834764831845f;
    else if (part == 1) scl = rsqrtf(ss + 1e-6f);
    if (part < 3) {
      uint4 o;
      o.x = pack2(val[0] * scl, val[1] * scl); o.y = pack2(val[2] * scl, val[3] * scl);
      o.z = pack2(val[4] * scl, val[5] * scl); o.w = pack2(val[6] * scl, val[7] * scl);
      *(uint4*)(p.proj + (long)row * PLD + C_GQ + chn) = o;
    }
  }
}

struct ScanSmem {
  float q[TC][128];
  float k[TC][128];
  float f[TC][128];
  float v[TC][64];
  float sc[TC][4];
};

__device__ __forceinline__ int scan_row(int bl, int dir, int pos) {
  int t;
  if (pos < CTX) t = dir ? (CTX - 1 - pos) : pos;
  else { int u = pos - CTX; t = CTX + (dir ? (SEQ - 1 - u) : u); }
  return bl * TPB + t;
}

__device__ void scan_unit(const Params& p, int l, int g, int u, ScanSmem& sm) {
  const int tid = otid(), lane = tid & 63, w = tid >> 6;
  const int j = lane & 15, gq = lane >> 4;
  const int mixer = u / 128, r = u % 128;
  int bl, h, dir, vs;
  bl = r / 32;
  if (mixer < 2) { h = (r % 32) / 4; dir = (r % 4) / 2; vs = r % 2; }
  else { h = (r % 32) / 8; dir = (r % 8) / 4; vs = r % 4; }
  int cq, ck, cv, ocol;
  if (mixer == 0) { cq = C_HGQ + h * 128; ck = C_HGF + dir * 1024 + h * 128; cv = C_HGI + h * 128 + vs * 64; ocol = h * 128 + vs * 64; }
  else if (mixer == 1) { cq = C_GQ + h * 128; ck = C_GK + h * 128; cv = C_GV + h * 128 + vs * 64; ocol = 1024 + h * 128 + vs * 64; }
  else { cq = C_MQ + h * 128; ck = C_MK + h * 128; cv = C_MV + h * 256 + vs * 64; ocol = 2048 + h * 256 + vs * 64; }

  float S[32];
#pragma unroll
  for (int i = 0; i < 32; ++i) S[i] = 0.f;
  float n0 = 0.f, n1 = 0.f;
  float mstate = 0.f;
  float gA = 0.f, gDt = 0.f, ibias = 0.f, fbias = 0.f;
  if (mixer == 1) { gA = -__expf(p.gdn_a_log[l * 16 + dir * 8 + h]); gDt = p.gdn_dt_bias[l * 16 + dir * 8 + h]; }
  if (mixer == 2) { ibias = p.ml_i_bias[l * 8 + dir * 4 + h]; fbias = p.ml_f_bias[l * 8 + dir * 4 + h]; }

  __syncthreads();
  if (mixer == 1) {
    float* cw = &sm.f[0][0];
    for (int i = tid; i < 9 * 320; i += 256) {
      int tap = i / 320, lc = i % 320;
      int ch = lc < 128 ? (h * 128 + lc) : (lc < 256 ? (1024 + h * 128 + lc - 128) : (2048 + h * 128 + vs * 64 + lc - 256));
      cw[i] = p.gdn_conv[((long)l * 9 + tap) * 3072 + ch];
    }
    __syncthreads();
  }

  for (int ch0 = 0; ch0 < TPB / TC; ++ch0) {
    const int pos0 = ch0 * TC;
    const bool is_ctx = pos0 < CTX;
    __syncthreads();
    for (int idx = tid; idx < TC * 40; idx += 256) {
      int tok = idx / 40, cgp = idx % 40;
      int row = scan_row(bl, dir, pos0 + tok);
      int col, lc;
      if (cgp < 16) { col = cq + cgp * 8; lc = cgp * 8; }
      else if (cgp < 32) { col = ck + (cgp - 16) * 8; lc = 128 + (cgp - 16) * 8; }
      else { col = cv + (cgp - 32) * 8; lc = 256 + (cgp - 32) * 8; }
      float val[8];
      if (mixer != 1) {
        uint4 raw = *(const uint4*)(p.proj + (long)row * PLD + col);
        unpack8(raw, val);
      } else {
        const float* cw = &sm.f[0][0];
#pragma unroll
        for (int e = 0; e < 8; ++e) val[e] = 0.f;
        int t = row - bl * TPB;
        if (is_ctx) {
#pragma unroll
          for (int jj = 0; jj < 3; ++jj) {
            int tt = t + jj - 1;
            if (tt >= 0 && tt < CTX) {
              uint4 raw = *(const uint4*)(p.proj + (long)(bl * TPB + tt) * PLD + col);
              float xv[8]; unpack8(raw, xv);
              const float* wv = cw + (3 + jj) * 320 + lc;
#pragma unroll
              for (int e = 0; e < 8; ++e) val[e] += xv[e] * wv[e];
            }
          }
        } else {
          int lt = t - CTX, rr0 = lt >> 6, cc0 = lt & 63;
#pragma unroll
          for (int ii = 0; ii < 3; ++ii) {
            int rr = rr0 + ii - 1;
            if (rr < 0 || rr >= 32) continue;
#pragma unroll
            for (int jj = 0; jj < 3; ++jj) {
              int cc = cc0 + jj - 1;
              if (cc < 0 || cc >= 64) continue;
              uint4 raw = *(const uint4*)(p.proj + (long)(bl * TPB + CTX + rr * 64 + cc) * PLD + col);
              float xv[8]; unpack8(raw, xv);
              const float* wv = cw + (ii * 3 + jj) * 320 + lc;
#pragma unroll
              for (int e = 0; e < 8; ++e) val[e] += xv[e] * wv[e];
            }
          }
        }
#pragma unroll
        for (int e = 0; e < 8; ++e) val[e] = siluf_(val[e]);
      }
      if (cgp < 16) {
        float scl = (mixer == 2) ? 0.08838834764831845f : 1.f;
#pragma unroll
        for (int e = 0; e < 8; ++e) sm.q[tok][lc + e] = val[e] * scl;
      } else if (cgp < 32) {
        int d0 = lc - 128;
        if (mixer == 0) {
#pragma unroll
          for (int e = 0; e < 8; ++e) {
            float lbv = p.lb[l * D + h * 128 + d0 + e];
            float f = lbv + (1.f - lbv) * sigmoidf_(val[e]);
            sm.f[tok][d0 + e] = f;
            sm.k[tok][d0 + e] = 1.f - f;
          }
        } else {
#pragma unroll
          for (int e = 0; e < 8; ++e) sm.k[tok][d0 + e] = val[e];
        }
      } else {
        int c0 = lc - 256;
#pragma unroll
        for (int e = 0; e < 8; ++e) sm.v[tok][c0 + e] = val[e];
      }
    }
    if (mixer == 2 && tid < TC) {
      int row = scan_row(bl, dir, pos0 + tid);
      float ig = p.gates[(long)row * GLD + 32 + dir * 4 + h] + ibias;
      float fx = p.gates[(long)row * GLD + 40 + dir * 4 + h] + fbias;
      sm.sc[tid][0] = ig;
      sm.sc[tid][1] = -softplusf_(-fx);
    }
    __syncthreads();
    if (mixer == 1) {
      for (int tk = w * 8; tk < w * 8 + 8; ++tk) {
        float q0 = sm.q[tk][lane], q1 = sm.q[tk][lane + 64], k0 = sm.k[tk][lane], k1 = sm.k[tk][lane + 64];
        float sq = wave_sum(q0 * q0 + q1 * q1), sk = wave_sum(k0 * k0 + k1 * k1), qk = wave_sum(q0 * k0 + q1 * k1);
        float rq = rsqrtf(sq + 1e-6f) * 0.08838834764831845f, rk = rsqrtf(sk + 1e-6f);
        sm.q[tk][lane] = q0 * rq; sm.q[tk][lane + 64] = q1 * rq;
        sm.k[tk][lane] = k0 * rk; sm.k[tk][lane + 64] = k1 * rk;
        if (lane == 0) {
          int row = scan_row(bl, dir, pos0 + tk);
          float beta = sigmoidf_(p.gates[(long)row * GLD + dir * 8 + h]);
          float gg = gA * softplusf_(p.gates[(long)row * GLD + 16 + dir * 8 + h] + gDt);
          sm.sc[tk][0] = __expf(gg); sm.sc[tk][1] = beta; sm.sc[tk][2] = qk * rq * rk;
        }
      }
      __syncthreads();
    } else if (mixer == 2) {
      if (tid == 0) {
        float m = mstate;
        for (int tk = 0; tk < TC; ++tk) {
          float ig = sm.sc[tk][0], lf = sm.sc[tk][1];
          float mn = fmaxf(lf + m, ig);
          sm.sc[tk][0] = __expf(lf + m - mn);
          sm.sc[tk][1] = __expf(ig - mn);
          sm.sc[tk][2] = __expf(-mn);
          m = mn;
        }
        mstate = m;
      }
      __syncthreads();
    }
    if (mixer == 0) {
      for (int tk = 0; tk < TC; ++tk) {
        float vj = sm.v[tk][w * 16 + j];
        const float4* qp = (const float4*)&sm.q[tk][gq * 32];
        const float4* kp = (const float4*)&sm.k[tk][gq * 32];
        const float4* fp = (const float4*)&sm.f[tk][gq * 32];
        float acc = 0.f;
#pragma unroll
        for (int i = 0; i < 8; ++i) {
          float4 q4 = qp[i], k4 = kp[i], f4 = fp[i];
          S[4 * i + 0] = f4.x * S[4 * i + 0] + k4.x * vj; acc += q4.x * S[4 * i + 0];
          S[4 * i + 1] = f4.y * S[4 * i + 1] + k4.y * vj; acc += q4.y * S[4 * i + 1];
          S[4 * i + 2] = f4.z * S[4 * i + 2] + k4.z * vj; acc += q4.z * S[4 * i + 2];
          S[4 * i + 3] = f4.w * S[4 * i + 3] + k4.w * vj; acc += q4.w * S[4 * i + 3];
        }
        acc += __shfl_xor(acc, 16); acc += __shfl_xor(acc, 32);
        if (gq == 0) sm.v[tk][w * 16 + j] = acc;
      }
    } else if (mixer == 1) {
      for (int tk = 0; tk < TC; ++tk) {
        float vj = sm.v[tk][w * 16 + j];
        float a = sm.sc[tk][0], beta = sm.sc[tk][1], qk = sm.sc[tk][2];
        const float4* qp = (const float4*)&sm.q[tk][gq * 32];
        const float4* kp = (const float4*)&sm.k[tk][gq * 32];
        float kr[32];
        float rr = 0.f, pq = 0.f;
#pragma unroll
        for (int i = 0; i < 8; ++i) {
          float4 q4 = qp[i], k4 = kp[i];
          kr[4 * i + 0] = k4.x; kr[4 * i + 1] = k4.y; kr[4 * i + 2] = k4.z; kr[4 * i + 3] = k4.w;
          rr += k4.x * S[4 * i + 0]; pq += q4.x * S[4 * i + 0];
          rr += k4.y * S[4 * i + 1]; pq += q4.y * S[4 * i + 1];
          rr += k4.z * S[4 * i + 2]; pq += q4.z * S[4 * i + 2];
          rr += k4.w * S[4 * i + 3]; pq += q4.w * S[4 * i + 3];
        }
        rr += __shfl_xor(rr, 16); pq += __shfl_xor(pq, 16);
        rr += __shfl_xor(rr, 32); pq += __shfl_xor(pq, 32);
        float vn = beta * (vj - a * rr);
        float ov = a * pq + qk * vn;
#pragma unroll
        for (int i = 0; i < 32; ++i) S[i] = a * S[i] + kr[i] * vn;
        if (gq == 0) sm.v[tk][w * 16 + j] = ov;
      }
    } else {
      for (int tk = 0; tk < TC; ++tk) {
        float vj = sm.v[tk][w * 16 + j];
        float fd = sm.sc[tk][0], iw = sm.sc[tk][1], em = sm.sc[tk][2];
        float ivj = iw * vj;
        const float4* qp = (const float4*)&sm.q[tk][gq * 32];
        const float4* kp = (const float4*)&sm.k[tk][gq * 32];
        float acc = 0.f;
#pragma unroll
        for (int i = 0; i < 8; ++i) {
          float4 q4 = qp[i], k4 = kp[i];
          S[4 * i + 0] = fd * S[4 * i + 0] + k4.x * ivj; acc += q4.x * S[4 * i + 0];
          S[4 * i + 1] = fd * S[4 * i + 1] + k4.y * ivj; acc += q4.y * S[4 * i + 1];
          S[4 * i + 2] = fd * S[4 * i + 2] + k4.z * ivj; acc += q4.z * S[4 * i + 2];
          S[4 * i + 3] = fd * S[4 * i + 3] + k4.w * ivj; acc += q4.w * S[4 * i + 3];
        }
        float2 kk = *(const float2*)&sm.k[tk][gq * 32 + 2 * j];
        float2 qq = *(const float2*)&sm.q[tk][gq * 32 + 2 * j];
        n0 = fd * n0 + iw * kk.x; n1 = fd * n1 + iw * kk.y;
        float den = n0 * qq.x + n1 * qq.y;
        den = wave_sum(den);
        acc += __shfl_xor(acc, 16); acc += __shfl_xor(acc, 32);
        if (gq == 0) sm.v[tk][w * 16 + j] = acc / fmaxf(fabsf(den), em);
      }
    }
    __syncthreads();
    {
      int tok = tid >> 3, c8 = tid & 7;
      int row = scan_row(bl, dir, pos0 + tok);
      const float* op = &sm.v[tok][c8 * 8];
      uint4 o;
      o.x = pack2(op[0], op[1]); o.y = pack2(op[2], op[3]); o.z = pack2(op[4], op[5]); o.w = pack2(op[6], op[7]);
      *(uint4*)(p.obuf + ((long)dir * TG + row) * 3072 + ocol + c8 * 8) = o;
    }
  }
}

struct CSmem {
  u16 QA[32][136];
  u16 KA[32][136];
  u16 KDT[128][40];
  u16 XT[64][40];
  u16 ATT[32][40];
  u16 ST[64][136];
  float sc[32][8];
  union {
    struct { u16 QD[32][136]; float dec[128]; float hsum[2][128]; } hg;
    struct { u16 YT[64][40]; u16 TM[32][40]; float NM[32][36]; u16 VF[32][72]; } gd;
    struct { float nvec[128]; } ml;
  } u;
};

__device__ __forceinline__ f32x4 mfma16(bf16x8 a, bf16x8 b, f32x4 c) { return __builtin_amdgcn_mfma_f32_16x16x32_bf16(a, b, c, 0, 0, 0); }
__device__ __forceinline__ bf16x8 ldf(const u16* base, int ld, int row, int k) { return *(const bf16x8*)(base + row * ld + k); }
__device__ __forceinline__ void st4(u16* dst, float a, float b, float c, float d) { uint2 v; v.x = pack2(a, b); v.y = pack2(c, d); *(uint2*)dst = v; }

__device__ void scan_unit_mma(const Params& p, int l, int g, int u, CSmem& sm) {
  const int tid0 = otid();
  const int mixer = u / 128, r = u % 128;
  int bl, h, dir, vs;
  bl = r / 32;
  if (mixer < 2) { h = (r % 32) / 4; dir = (r % 4) / 2; vs = r % 2; }
  else { h = (r % 32) / 8; dir = (r % 8) / 4; vs = r % 4; }
  int cq, ck, cv, ocol;
  if (mixer == 0) { cq = C_HGQ + h * 128; ck = C_HGF + dir * 1024 + h * 128; cv = C_HGI + h * 128 + vs * 64; ocol = h * 128 + vs * 64; }
  else if (mixer == 1) { cq = C_GQ + h * 128; ck = C_GK + h * 128; cv = C_GV + h * 128 + vs * 64; ocol = 1024 + h * 128 + vs * 64; }
  else { cq = C_MQ + h * 128; ck = C_MK + h * 128; cv = C_MV + h * 256 + vs * 64; ocol = 2048 + h * 256 + vs * 64; }
  const float QS = 0.08838834764831845f;

  f32x4 S[2][4];
#pragma unroll
  for (int a = 0; a < 2; ++a)
#pragma unroll
    for (int b = 0; b < 4; ++b) S[a][b] = f32x4{0.f, 0.f, 0.f, 0.f};
  float mcar = 0.f;
  float gA = 0.f, gDt = 0.f, ibias = 0.f, fbias = 0.f;
  if (mixer == 1) { gA = -__expf(p.gdn_a_log[l * 16 + dir * 8 + h]); gDt = p.gdn_dt_bias[l * 16 + dir * 8 + h]; }
  if (mixer == 2) { ibias = p.ml_i_bias[l * 8 + dir * 4 + h]; fbias = p.ml_f_bias[l * 8 + dir * 4 + h]; }

  __syncthreads();
  for (int i = tid0; i < 64 * 136 / 2; i += 256) ((unsigned*)&sm.ST[0][0])[i] = 0u;
  if (mixer == 2 && tid0 < 128) sm.u.ml.nvec[tid0] = 0.f;
  __syncthreads();


  for (int ch0 = 0; ch0 < TPB / 32; ++ch0) {
    const int tid = otid(), lane = tid & 63, w = tid >> 6, fr = lane & 15, fq = lane >> 4;
    const int rt_o = w & 1, cp_o = w >> 1;
    const int pos0 = ch0 * 32;
    const bool is_ctx = pos0 < CTX;
    float mnew = 0.f;
    if (mixer == 0) {
      const int d = tid & 127, hh = tid >> 7;
      const float lbv = p.lb[l * D + h * 128 + d];
      float bb[16], qv[16], kv[16];
      float run = 0.f;
#pragma unroll
      for (int i = 0; i < 16; ++i) {
        int row = scan_row(bl, dir, pos0 + hh * 16 + i);
        const u16* pr = p.proj + (long)row * PLD;
        float fx = bf2f(pr[ck + d]);
        qv[i] = bf2f(pr[cq + d]);
        float f = lbv + (1.f - lbv) * sigmoidf_(fx);
        kv[i] = 1.f - f;
        run += __logf(f);
        bb[i] = run;
      }
      sm.u.hg.hsum[hh][d] = run;
      {
        int t = tid >> 3, c8 = tid & 7;
        int row = scan_row(bl, dir, pos0 + t);
        uint4 raw = *(const uint4*)(p.proj + (long)row * PLD + cv + c8 * 8);
        sm.XT[c8 * 8 + 0][t] = (u16)(raw.x & 0xffffu); sm.XT[c8 * 8 + 1][t] = (u16)(raw.x >> 16);
        sm.XT[c8 * 8 + 2][t] = (u16)(raw.y & 0xffffu); sm.XT[c8 * 8 + 3][t] = (u16)(raw.y >> 16);
        sm.XT[c8 * 8 + 4][t] = (u16)(raw.z & 0xffffu); sm.XT[c8 * 8 + 5][t] = (u16)(raw.z >> 16);
        sm.XT[c8 * 8 + 6][t] = (u16)(raw.w & 0xffffu); sm.XT[c8 * 8 + 7][t] = (u16)(raw.w >> 16);
      }
      __syncthreads();
      float h0 = sm.u.hg.hsum[0][d], h1 = sm.u.hg.hsum[1][d];
      float bref = h0, bend = h0 + h1, off = hh ? h0 : 0.f;
      if (hh == 0) sm.u.hg.dec[d] = __expf(bend);
      unsigned kd2[8];
#pragma unroll
      for (int i = 0; i < 16; ++i) {
        float b = bb[i] + off;
        float qa = qv[i] * __expf(fminf(b - bref, 80.f));
        float ka = kv[i] * __expf(fminf(bref - b, 80.f));
        float qd = qv[i] * __expf(b);
        float kd = kv[i] * __expf(bend - b);
        int t = hh * 16 + i;
        sm.QA[t][d] = f2bf(qa); sm.KA[t][d] = f2bf(ka); sm.u.hg.QD[t][d] = f2bf(qd);
        if (i & 1) kd2[i >> 1] |= ((unsigned)f2bf(kd)) << 16; else kd2[i >> 1] = (unsigned)f2bf(kd);
      }
      *(uint4*)&sm.KDT[d][hh * 16] = uint4{kd2[0], kd2[1], kd2[2], kd2[3]};
      *(uint4*)&sm.KDT[d][hh * 16 + 8] = uint4{kd2[4], kd2[5], kd2[6], kd2[7]};
      __syncthreads();
    } else if (mixer == 1) {
      for (int idx = tid; idx < 32 * 40; idx += 256) {
        int tok = idx / 40, c = idx % 40;
        int row = scan_row(bl, dir, pos0 + tok);
        if (c < 16) *(uint4*)&sm.QA[tok][c * 8] = *(const uint4*)(p.proj + (long)row * PLD + cq + c * 8);
        else if (c < 32) *(uint4*)&sm.KA[tok][(c - 16) * 8] = *(const uint4*)(p.proj + (long)row * PLD + ck + (c - 16) * 8);
        else *(uint4*)&sm.u.gd.VF[tok][(c - 32) * 8] = *(const uint4*)(p.proj + (long)row * PLD + cv + (c - 32) * 8);
      }
      if (w == 0) {
        int tk = lane & 31;
        int row = scan_row(bl, dir, pos0 + tk);
        float beta = sigmoidf_(p.gates[(long)row * GLD + dir * 8 + h]);
        float gg = gA * softplusf_(p.gates[(long)row * GLD + 16 + dir * 8 + h] + gDt);
        float G = gg;
#pragma unroll
        for (int o = 1; o < 32; o <<= 1) { float t2 = __shfl_up(G, o); if (tk >= o) G += t2; }
        if (lane < 32) { sm.sc[tk][0] = G; sm.sc[tk][1] = beta; }
      }
      __syncthreads();
      {
        const int d = tid & 127, hh = tid >> 7;
        float Gend = sm.sc[31][0];
        unsigned kd2[8];
#pragma unroll
        for (int i = 0; i < 16; ++i) {
          int s_ = hh * 16 + i;
          float kd = bf2f(sm.KA[s_][d]) * __expf(Gend - sm.sc[s_][0]);
          if (i & 1) kd2[i >> 1] |= ((unsigned)f2bf(kd)) << 16; else kd2[i >> 1] = (unsigned)f2bf(kd);
        }
        *(uint4*)&sm.KDT[d][hh * 16] = uint4{kd2[0], kd2[1], kd2[2], kd2[3]};
        *(uint4*)&sm.KDT[d][hh * 16 + 8] = uint4{kd2[4], kd2[5], kd2[6], kd2[7]};
      }
      {
        const int ai = w & 1, bi = w >> 1;
        if (ai >= bi) {
          f32x4 acc = f32x4{0.f, 0.f, 0.f, 0.f};
#pragma unroll
          for (int kk = 0; kk < 4; ++kk)
            acc = mfma16(ldf(&sm.KA[0][0], 136, ai * 16 + fr, kk * 32 + fq * 8), ldf(&sm.KA[0][0], 136, bi * 16 + fr, kk * 32 + fq * 8), acc);
          int b = bi * 16 + fr;
          float Gb = sm.sc[b][0];
#pragma unroll
          for (int j = 0; j < 4; ++j) {
            int a = ai * 16 + fq * 4 + j;
            if (a > b) sm.u.gd.NM[a][b] = sm.sc[a][1] * acc[j] * __expf(sm.sc[a][0] - Gb);
          }
        }
      }
      __syncthreads();
    } else {
      for (int idx = tid; idx < 32 * 32; idx += 256) {
        int tok = idx >> 5, c = idx & 31;
        int row = scan_row(bl, dir, pos0 + tok);
        if (c < 16) *(uint4*)&sm.QA[tok][c * 8] = *(const uint4*)(p.proj + (long)row * PLD + cq + c * 8);
        else *(uint4*)&sm.KA[tok][(c - 16) * 8] = *(const uint4*)(p.proj + (long)row * PLD + ck + (c - 16) * 8);
      }
      {
        int t = tid >> 3, c8 = tid & 7;
        int row = scan_row(bl, dir, pos0 + t);
        uint4 raw = *(const uint4*)(p.proj + (long)row * PLD + cv + c8 * 8);
        sm.XT[c8 * 8 + 0][t] = (u16)(raw.x & 0xffffu); sm.XT[c8 * 8 + 1][t] = (u16)(raw.x >> 16);
        sm.XT[c8 * 8 + 2][t] = (u16)(raw.y & 0xffffu); sm.XT[c8 * 8 + 3][t] = (u16)(raw.y >> 16);
        sm.XT[c8 * 8 + 4][t] = (u16)(raw.z & 0xffffu); sm.XT[c8 * 8 + 5][t] = (u16)(raw.z >> 16);
        sm.XT[c8 * 8 + 6][t] = (u16)(raw.w & 0xffffu); sm.XT[c8 * 8 + 7][t] = (u16)(raw.w >> 16);
      }
      if (w == 0) {
        int tk = lane & 31;
        int row = scan_row(bl, dir, pos0 + tk);
        float ig = p.gates[(long)row * GLD + 32 + dir * 4 + h] + ibias;
        float fx = p.gates[(long)row * GLD + 40 + dir * 4 + h] + fbias;
        float F = -softplusf_(-fx);
#pragma unroll
        for (int o = 1; o < 32; o <<= 1) { float t2 = __shfl_up(F, o); if (tk >= o) F += t2; }
        float a = ig - F;
        float pm = a;
#pragma unroll
        for (int o = 1; o < 32; o <<= 1) { float t2 = __shfl_up(pm, o); if (tk >= o) pm = fmaxf(pm, t2); }
        float M = fmaxf(mcar, pm);
        if (lane < 32) { sm.sc[tk][0] = F; sm.sc[tk][1] = a; sm.sc[tk][2] = M; }
      }
      __syncthreads();
      {
        const int d = tid & 127, hh = tid >> 7;
        float Mend = sm.sc[31][2];
        mnew = sm.sc[31][0] + Mend;
        unsigned kd2[8];
#pragma unroll
        for (int i = 0; i < 16; ++i) {
          int s_ = hh * 16 + i;
          float kd = bf2f(sm.KA[s_][d]) * __expf(sm.sc[s_][1] - Mend);
          if (i & 1) kd2[i >> 1] |= ((unsigned)f2bf(kd)) << 16; else kd2[i >> 1] = (unsigned)f2bf(kd);
        }
        *(uint4*)&sm.KDT[d][hh * 16] = uint4{kd2[0], kd2[1], kd2[2], kd2[3]};
        *(uint4*)&sm.KDT[d][hh * 16 + 8] = uint4{kd2[4], kd2[5], kd2[6], kd2[7]};
      }
    }
    if (mixer == 1 && w == 0) {
      if (lane < 32) {
        const int c = lane;
        float Tc[32];
#pragma unroll
        for (int t = 0; t < 32; ++t) {
          float v = (t == c) ? 1.f : 0.f;
#pragma unroll
          for (int s4 = 0; s4 < (t + 3) / 4; ++s4) {
            float4 n4 = *(const float4*)&sm.u.gd.NM[t][s4 * 4];
            if (s4 * 4 + 0 < t) v -= n4.x * Tc[s4 * 4 + 0];
            if (s4 * 4 + 1 < t) v -= n4.y * Tc[s4 * 4 + 1];
            if (s4 * 4 + 2 < t) v -= n4.z * Tc[s4 * 4 + 2];
            if (s4 * 4 + 3 < t) v -= n4.w * Tc[s4 * 4 + 3];
          }
          Tc[t] = v;
          sm.u.gd.TM[t][c] = f2bf(v);
          __builtin_amdgcn_sched_barrier(0);
        }
      }
      { int t = lane >> 2, s4 = (lane & 3) * 4; *(uint2*)&sm.ATT[t][16 + s4] = uint2{0u, 0u}; }
    } else {
      int si, ti; bool doit = true;
      if (mixer == 1) { si = (w == 3) ? 1 : 0; ti = (w == 1) ? 0 : 1; }
      else { si = w & 1; ti = w >> 1; doit = !(si == 1 && ti == 0); }
      if (doit) {
        f32x4 acc = f32x4{0.f, 0.f, 0.f, 0.f};
#pragma unroll
        for (int kk = 0; kk < 4; ++kk)
          acc = mfma16(ldf(&sm.KA[0][0], 136, si * 16 + fr, kk * 32 + fq * 8), ldf(&sm.QA[0][0], 136, ti * 16 + fr, kk * 32 + fq * 8), acc);
        const int t = ti * 16 + fr;
        float o4[4];
        if (mixer == 0) {
#pragma unroll
          for (int j = 0; j < 4; ++j) { int s_ = si * 16 + fq * 4 + j; o4[j] = (s_ <= t) ? acc[j] : 0.f; }
        } else if (mixer == 1) {
          float Gt = sm.sc[t][0];
#pragma unroll
          for (int j = 0; j < 4; ++j) { int s_ = si * 16 + fq * 4 + j; o4[j] = (s_ <= t) ? acc[j] * __expf(Gt - sm.sc[s_][0]) : 0.f; }
        } else {
          float Mt = sm.sc[t][2];
#pragma unroll
          for (int j = 0; j < 4; ++j) { int s_ = si * 16 + fq * 4 + j; o4[j] = (s_ <= t) ? acc[j] * QS * __expf(sm.sc[s_][1] - Mt) : 0.f; }
        }
        st4(&sm.ATT[t][si * 16 + fq * 4], o4[0], o4[1], o4[2], o4[3]);
      } else {
        int t = lane >> 2, s4 = (lane & 3) * 4; *(uint2*)&sm.ATT[t][16 + s4] = uint2{0u, 0u};
      }
    }
    __syncthreads();
    if (mixer == 1) {
      f32x4 acc[2];
      acc[0] = acc[1] = f32x4{0.f, 0.f, 0.f, 0.f};
#pragma unroll
      for (int kk = 0; kk < 4; ++kk) {
        bf16x8 a = ldf(&sm.KA[0][0], 136, rt_o * 16 + fr, kk * 32 + fq * 8);
#pragma unroll
        for (int c = 0; c < 2; ++c) acc[c] = mfma16(a, ldf(&sm.ST[0][0], 136, (cp_o * 2 + c) * 16 + fr, kk * 32 + fq * 8), acc[c]);
      }
#pragma unroll
      for (int c = 0; c < 2; ++c) {
        int v = (cp_o * 2 + c) * 16 + fr;
        float y4[4];
#pragma unroll
        for (int j = 0; j < 4; ++j) {
          int t = rt_o * 16 + fq * 4 + j;
          float kg = __expf(sm.sc[t][0]);
          y4[j] = sm.sc[t][1] * (bf2f(sm.u.gd.VF[t][v]) - kg * acc[c][j]);
        }
        st4(&sm.u.gd.YT[v][rt_o * 16 + fq * 4], y4[0], y4[1], y4[2], y4[3]);
      }
      __syncthreads();
      {
        bf16x8 a = ldf(&sm.u.gd.TM[0][0], 40, rt_o * 16 + fr, fq * 8);
#pragma unroll
        for (int c = 0; c < 2; ++c) {
          int vt = cp_o * 2 + c;
          f32x4 vn = mfma16(a, ldf(&sm.u.gd.YT[0][0], 40, vt * 16 + fr, fq * 8), f32x4{0.f, 0.f, 0.f, 0.f});
          st4(&sm.XT[vt * 16 + fr][rt_o * 16 + fq * 4], vn[0], vn[1], vn[2], vn[3]);
        }
      }
      __syncthreads();
    } else if (mixer == 2) {
      int t = tid >> 3, part = tid & 7;
      float qn = 0.f;
#pragma unroll
      for (int e = 0; e < 16; ++e) qn += bf2f(sm.QA[t][part * 16 + e]) * sm.u.ml.nvec[part * 16 + e];
      float as = 0.f;
#pragma unroll
      for (int e = 0; e < 4; ++e) as += bf2f(sm.ATT[t][part * 4 + e]);
      float Mt = sm.sc[t][2];
      float den = QS * __expf(mcar - Mt) * qn + as;
      den += __shfl_xor(den, 1); den += __shfl_xor(den, 2); den += __shfl_xor(den, 4);
      if (part == 0) sm.sc[t][4] = 1.f / fmaxf(fabsf(den), __expf(-(sm.sc[t][0] + Mt)));
      __syncthreads();
    }
    {
      f32x4 acc[2];
      acc[0] = acc[1] = f32x4{0.f, 0.f, 0.f, 0.f};
      const u16* Qs = (mixer == 0) ? &sm.u.hg.QD[0][0] : &sm.QA[0][0];
#pragma unroll
      for (int kk = 0; kk < 4; ++kk) {
        bf16x8 a = ldf(Qs, 136, rt_o * 16 + fr, kk * 32 + fq * 8);
#pragma unroll
        for (int c = 0; c < 2; ++c) acc[c] = mfma16(a, ldf(&sm.ST[0][0], 136, (cp_o * 2 + c) * 16 + fr, kk * 32 + fq * 8), acc[c]);
      }
      float rs[4], fs[4];
#pragma unroll
      for (int j = 0; j < 4; ++j) {
        int t = rt_o * 16 + fq * 4 + j;
        if (mixer == 0) { rs[j] = 1.f; fs[j] = 1.f; }
        else if (mixer == 1) { rs[j] = __expf(sm.sc[t][0]); fs[j] = 1.f; }
        else { rs[j] = QS * __expf(mcar - sm.sc[t][2]); fs[j] = sm.sc[t][4]; }
      }
#pragma unroll
      for (int c = 0; c < 2; ++c)
#pragma unroll
        for (int j = 0; j < 4; ++j) acc[c][j] *= rs[j];
      {
        bf16x8 a = ldf(&sm.ATT[0][0], 40, rt_o * 16 + fr, fq * 8);
#pragma unroll
        for (int c = 0; c < 2; ++c) acc[c] = mfma16(a, ldf(&sm.XT[0][0], 40, (cp_o * 2 + c) * 16 + fr, fq * 8), acc[c]);
      }
#pragma unroll
      for (int j = 0; j < 4; ++j) {
        int t = rt_o * 16 + fq * 4 + j;
        int row = scan_row(bl, dir, pos0 + t);
        u16* dst = p.obuf + ((long)dir * TG + row) * 3072 + ocol;
#pragma unroll
        for (int c = 0; c < 2; ++c) dst[(cp_o * 2 + c) * 16 + fr] = f2bf(acc[c][j] * fs[j]);
      }
    }
    __syncthreads();
    {
      float dsc = 1.f;
      if (mixer == 1) dsc = __expf(sm.sc[31][0]);
      else if (mixer == 2) dsc = __expf(mcar - sm.sc[31][2]);
#pragma unroll
      for (int rt = 0; rt < 2; ++rt) {
        if (mixer == 0) {
          float4 d4 = *(const float4*)&sm.u.hg.dec[w * 32 + rt * 16 + fq * 4];
#pragma unroll
          for (int ct = 0; ct < 4; ++ct) { S[rt][ct][0] *= d4.x; S[rt][ct][1] *= d4.y; S[rt][ct][2] *= d4.z; S[rt][ct][3] *= d4.w; }
        } else {
#pragma unroll
          for (int ct = 0; ct < 4; ++ct) { S[rt][ct][0] *= dsc; S[rt][ct][1] *= dsc; S[rt][ct][2] *= dsc; S[rt][ct][3] *= dsc; }
        }
        bf16x8 a = ldf(&sm.KDT[0][0], 40, w * 32 + rt * 16 + fr, fq * 8);
#pragma unroll
        for (int ct = 0; ct < 4; ++ct) {
          S[rt][ct] = mfma16(a, ldf(&sm.XT[0][0], 40, ct * 16 + fr, fq * 8), S[rt][ct]);
          st4(&sm.ST[ct * 16 + fr][w * 32 + rt * 16 + fq * 4], S[rt][ct][0], S[rt][ct][1], S[rt][ct][2], S[rt][ct][3]);
        }
      }
      if (mixer == 2) {
        if (tid < 128) {
          float sum = 0.f;
#pragma unroll
          for (int e = 0; e < 32; ++e) sum += bf2f(sm.KDT[tid][e]);
          sm.u.ml.nvec[tid] = dsc * sm.u.ml.nvec[tid] + sum;
        }
        mcar = mnew;
      }
    }
    __syncthreads();
  }
}

#define MMA_MASK 7
__device__ void ph_scan(const Params& p, int l, int g, char* smem) {
  for (int u = blockIdx.x; u < 384; u += gridDim.x) {
    int mixer = u / 128;
#if MMA_MASK == 7
    scan_unit_mma(p, l, g, u, *(CSmem*)smem);
#else
    if ((MMA_MASK >> mixer) & 1) scan_unit_mma(p, l, g, u, *(CSmem*)smem);
    else scan_unit(p, l, g, u, *(ScanSmem*)smem);
#endif
  }
}

__device__ void ph_brfin(const Params& p, int l, int g) {
  const int tid = otid();
  const int lane = tid & 63;
  const int gw = blockIdx.x * 4 + (tid >> 6), nw = gridDim.x * 4;
  for (int wu = gw; wu < TG * 3; wu += nw) {
    int row = wu / 3, mixer = wu % 3;
    int pp = row % TPB;
    if (l == 1 && pp < CTX) continue;
    const u16* of = p.obuf + (long)row * 3072 + mixer * 1024 + lane * 16;
    const u16* ob = p.obuf + ((long)TG + row) * 3072 + mixer * 1024 + lane * 16;
    float o[16], t8[8];
    uint4 a0 = *(const uint4*)of, a1 = *(const uint4*)(of + 8), b0 = *(const uint4*)ob, b1 = *(const uint4*)(ob + 8);
    unpack8(a0, o); unpack8(a1, o + 8);
    unpack8(b0, t8);
#pragma unroll
    for (int e = 0; e < 8; ++e) o[e] += t8[e];
    unpack8(b1, t8);
#pragma unroll
    for (int e = 0; e < 8; ++e) o[8 + e] += t8[e];
    float ss = 0.f;
#pragma unroll
    for (int e = 0; e < 16; ++e) ss += o[e] * o[e];
    ss += __shfl_xor(ss, 1); ss += __shfl_xor(ss, 2); ss += __shfl_xor(ss, 4);
    float hd = 128.f;
    if (mixer == 2) { ss += __shfl_xor(ss, 8); hd = 256.f; }
    float rs = rsqrtf(ss / hd + 1e-6f);
    const float* on = (mixer == 0 ? p.hg_onorm : (mixer == 1 ? p.gdn_onorm : p.ml_onorm)) + l * D + lane * 16;
    int zc = mixer == 0 ? C_HGZ : (mixer == 1 ? C_GZ : C_MZ);
    const u16* zp = p.proj + (long)row * PLD + zc + lane * 16;
    float z[16];
    uint4 z0 = *(const uint4*)zp, z1 = *(const uint4*)(zp + 8);
    unpack8(z0, z); unpack8(z1, z + 8);
    float res[16];
#pragma unroll
    for (int e = 0; e < 16; ++e) res[e] = o[e] * rs * on[e] * siluf_(z[e]);
    if (mixer == 2) {
      const u16* gp = p.proj + (long)row * PLD + C_MO + lane * 16;
      uint4 g0 = *(const uint4*)gp, g1 = *(const uint4*)(gp + 8);
      unpack8(g0, z); unpack8(g1, z + 8);
#pragma unroll
      for (int e = 0; e < 16; ++e) res[e] *= sigmoidf_(z[e]);
    }
    uint4 w0, w1;
    w0.x = pack2(res[0], res[1]); w0.y = pack2(res[2], res[3]); w0.z = pack2(res[4], res[5]); w0.w = pack2(res[6], res[7]);
    w1.x = pack2(res[8], res[9]); w1.y = pack2(res[10], res[11]); w1.z = pack2(res[12], res[13]); w1.w = pack2(res[14], res[15]);
    u16* dst = p.obuf + (long)row * 3072 + mixer * 1024 + lane * 16;
    *(uint4*)dst = w0; *(uint4*)(dst + 8) = w1;
  }
}

__device__ void ph_gemm_merge(const Params& p, int l, char* smem) {
  const int tid = otid();
  const int wid = tid >> 6, lane = tid & 63, wr = wid >> 1, wc = wid & 1, fr = lane & 15, fq = lane >> 4;
  for (int t = blockIdx.x; t < 72 * 16; t += gridDim.x) {
    int nt = t / 72, mt = t % 72;
    if (l == 1 && (mt % 18) < 2) continue;
    f32x4 tot[4][2];
#pragma unroll
    for (int m = 0; m < 4; ++m)
#pragma unroll
      for (int n = 0; n < 2; ++n) tot[m][n] = f32x4{0.f, 0.f, 0.f, 0.f};
    for (int i = 0; i < 3; ++i) {
      f32x4 acc[4][2];
#pragma unroll
      for (int m = 0; m < 4; ++m)
#pragma unroll
        for (int n = 0; n < 2; ++n) acc[m][n] = f32x4{0.f, 0.f, 0.f, 0.f};
      gemm_kloop<2>(p.obuf + (long)mt * 128 * 3072 + i * 1024, 3072, p.WbrT + ((long)i * D + nt * 64) * D, D, D, smem, acc);
#pragma unroll
      for (int m = 0; m < 4; ++m)
#pragma unroll
        for (int n = 0; n < 2; ++n)
#pragma unroll
          for (int j = 0; j < 4; ++j) {
            int row = mt * 128 + wr * 64 + m * 16 + fq * 4 + j, col = nt * 64 + wc * 32 + n * 16 + fr;
            float gv = bf2f(p.proj[(long)row * PLD + C_GATE + i * 1024 + col]);
            tot[m][n][j] += sigmoidf_(gv) * acc[m][n][j];
          }
    }
#pragma unroll
    for (int m = 0; m < 4; ++m)
#pragma unroll
      for (int n = 0; n < 2; ++n)
#pragma unroll
        for (int j = 0; j < 4; ++j) {
          int row = mt * 128 + wr * 64 + m * 16 + fq * 4 + j, col = nt * 64 + wc * 32 + n * 16 + fr;
          p.hbuf[(long)row * D + col] = f2bf(tot[m][n][j]);
        }
  }
}

__device__ void ph_gemm_out(const Params& p, int l, int g, char* smem) {
  const int tid = otid();
  const int wid = tid >> 6, lane = tid & 63, wr = wid >> 1, wc = wid & 1, fr = lane & 15, fq = lane >> 4;
  for (int t = blockIdx.x; t < 72 * 8; t += gridDim.x) {
    int nt = t / 72, mt = t % 72;
    if (l == 1 && (mt % 18) < 2) continue;
    f32x4 acc[4][4];
#pragma unroll
    for (int m = 0; m < 4; ++m)
#pragma unroll
      for (int n = 0; n < 4; ++n) acc[m][n] = f32x4{0.f, 0.f, 0.f, 0.f};
    gemm_kloop<4>(p.hbuf + (long)mt * 128 * D, D, p.WoT + (long)nt * 128 * D, D, D, smem, acc);
#pragma unroll
    for (int m = 0; m < 4; ++m)
#pragma unroll
      for (int j = 0; j < 4; ++j) {
        int row = mt * 128 + wr * 64 + m * 16 + fq * 4 + j;
        int bl = row / TPB, pp = row % TPB, b = g * GB + bl;
        const float* src; float* dst; int mrow;
        if (pp < CTX) { src = p.ctx + ((long)b * CTX + pp) * D; dst = p.ctxs + ((long)b * CTX + pp) * D; mrow = 16; }
        else { long off = ((long)b * SEQ + (pp - CTX)) * D; src = (l == 0 ? p.x : p.out) + off; dst = p.out + off; mrow = b; }
        const float* gt = p.mod + ((long)l * 17 + mrow) * 3072 + 2048;
#pragma unroll
        for (int n = 0; n < 4; ++n) {
          int col = nt * 128 + wc * 64 + n * 16 + fr;
          dst[col] = src[col] + gt[col] * acc[m][n][j];
        }
      }
  }
}

__device__ void ph_final(const Params& p) {
  const int tid = otid();
  const int lane = tid & 63;
  const int gw = blockIdx.x * 4 + (tid >> 6), nw = gridDim.x * 4;
  for (int row = gw; row < NB * SEQ; row += nw) {
    float4* src = (float4*)(p.out + (long)row * D);
    float4 v[4]; float ss = 0.f;
#pragma unroll
    for (int i = 0; i < 4; ++i) {
      v[i] = src[lane + 64 * i];
      ss += v[i].x * v[i].x + v[i].y * v[i].y + v[i].z * v[i].z + v[i].w * v[i].w;
    }
    ss = wave_sum(ss);
    float rs = rsqrtf(ss * (1.f / D) + 1e-6f);
#pragma unroll
    for (int i = 0; i < 4; ++i) {
      float4 g4 = ((const float4*)p.final_g)[lane + 64 * i];
      float4 o; o.x = v[i].x * rs * g4.x; o.y = v[i].y * rs * g4.y; o.z = v[i].z * rs * g4.z; o.w = v[i].w * rs * g4.w;
      src[lane + 64 * i] = o;
    }
  }
}


#define XB_TMO      128
#define XB_XCNT(j)  (256  + 64 * (j))
#define XB_XSUB(j)  (1280 + 64 * (j))
#define XB_XGEN(j)  (2304 + 64 * (j))
#define XB_TOP      3328
#define XB_TOPGEN   3392
#define XCD_BAR_WORDS 3456
#define XB_SPIN_CAP (1u << 22)
#define LAS __attribute__((address_space(3)))
__device__ __forceinline__ unsigned xb_ld(unsigned* p) { return __hip_atomic_load(p, __ATOMIC_RELAXED, __HIP_MEMORY_SCOPE_AGENT); }
__device__ __forceinline__ unsigned xb_add(unsigned* p, unsigned v) { return __hip_atomic_fetch_add(p, v, __ATOMIC_RELAXED, __HIP_MEMORY_SCOPE_AGENT); }
__device__ __forceinline__ unsigned xb_xcc_id() { return (unsigned)__builtin_amdgcn_s_getreg((3 << 11) | 20) & 0xFu; }
#define XB_SPIN(cond, bar) do { unsigned _sp = 0; while (cond) { __builtin_amdgcn_s_sleep(1); \
    if ((++_sp & 255u) == 0u) { if (xb_ld(&(bar)[XB_TMO])) break; if (_sp > XB_SPIN_CAP) { atomicAdd(&(bar)[XB_TMO], 1u); break; } } } } while (0)
struct XcdBarrier { unsigned* bar; unsigned x; volatile LAS unsigned* st; };
__device__ __forceinline__ XcdBarrier xcd_barrier_post(unsigned* bar, volatile LAS unsigned* st) {
  XcdBarrier b; b.bar = bar; b.x = xb_xcc_id(); b.st = st;
  if (threadIdx.x == 0) (void)xb_add(&bar[XB_XCNT(b.x)], 1u);
  return b;
}
__device__ __forceinline__ void xcd_barrier_complete(unsigned* bar, unsigned x, unsigned& nloc, unsigned& nx) {
  const unsigned G = gridDim.x * gridDim.y * gridDim.z;
  unsigned sum, cnt, mine, sp = 0u;
  for (;;) {
    sum = 0u; cnt = 0u; mine = 0u;
#pragma unroll
    for (unsigned j = 0; j < 16; ++j) { const unsigned c = xb_ld(&bar[XB_XCNT(j)]); sum += c; cnt += (c > 0u) ? 1u : 0u; mine = (j == x) ? c : mine; }
    if (sum == G) break;
    __builtin_amdgcn_s_sleep(1);
    if ((++sp & 255u) == 0u) { if (xb_ld(&bar[XB_TMO])) break; if (sp > XB_SPIN_CAP) { atomicAdd(&bar[XB_TMO], 1u); break; } }
  }
  nloc = mine > 0u ? mine : 1u; nx = cnt > 0u ? cnt : 1u;
}
__device__ __forceinline__ void xcd_barrier(const XcdBarrier& b) {
  asm volatile("s_waitcnt vmcnt(0)" ::: "memory");
  __syncthreads();
  if (threadIdx.x == 0) {
    unsigned* bar = b.bar;
    __builtin_amdgcn_s_waitcnt(0);
    unsigned nloc = b.st[0], nx = b.st[1];
    if (nloc == 0u) { xcd_barrier_complete(bar, b.x, nloc, nx); b.st[0] = nloc; b.st[1] = nx; }
    const unsigned old = xb_add(&bar[XB_XSUB(b.x)], 1u);
    const unsigned gen = old / nloc;
    if (old + 1u == (gen + 1u) * nloc) {
      __builtin_amdgcn_fence(__ATOMIC_RELEASE, "agent");
      asm volatile("s_waitcnt vmcnt(0)" ::: "memory");
      const unsigned og = xb_add(&bar[XB_TOP], 1u);
      const unsigned tg = og / nx;
      if (og + 1u == (tg + 1u) * nx) xb_add(&bar[XB_TOPGEN], 1u);
      else XB_SPIN(xb_ld(&bar[XB_TOPGEN]) == tg, bar);
      __builtin_amdgcn_fence(__ATOMIC_ACQUIRE, "agent");
      xb_add(&bar[XB_XGEN(b.x)], 1u);
      asm volatile("s_waitcnt vmcnt(0)" ::: "memory");
    } else {
      XB_SPIN(xb_ld(&bar[XB_XGEN(b.x)]) == gen, bar);
      __builtin_amdgcn_fence(__ATOMIC_ACQUIRE, "agent");
      asm volatile("s_waitcnt vmcnt(0)" ::: "memory");
    }
  }
  __syncthreads();
}

constexpr int NSTEPS = 2 + 24 + 1 + 24 + 1;

__device__ void run_step(const Params& p, int step, char* smem) {
  if (step == 0) { ph_convert(p, 0, smem); ph_prep_small(p); return; }
  if (step == 1) { ph_mod(p, smem); return; }
  if (step == 26) { ph_convert(p, 1, smem); return; }
  if (step == NSTEPS - 1) { ph_final(p); return; }
  int l, s;
  if (step < 26) { l = 0; s = step - 2; } else { l = 1; s = step - 27; }
  int g = s / 6, k = s % 6;
  switch (k) {
    case 0: ph_prenorm(p, l, g); break;
    case 1: ph_gemm_in(p, smem); break;
    case 2: ph_scan(p, l, g, smem); break;
    case 3: ph_brfin(p, l, g); break;
    case 4: ph_gemm_merge(p, l, smem); break;
    case 5: ph_gemm_out(p, l, g, smem); break;
  }
}

#if !COOP
__global__ void __launch_bounds__(256, 2) k_step(Params p, int step) {
  __shared__ __attribute__((aligned(16))) char smem[sizeof(CSmem) > sizeof(ScanSmem) ? sizeof(CSmem) : sizeof(ScanSmem)];
  run_step(p, step, smem);
}
#else
__global__ void __launch_bounds__(256, 2) k_mega(Params p) {
  __shared__ __attribute__((aligned(16))) char smem[sizeof(CSmem) > sizeof(ScanSmem) ? sizeof(CSmem) : sizeof(ScanSmem)];
  __shared__ uint4 xb_words;
  cg::grid_group grid = cg::this_grid();
  if (threadIdx.x == 0) xb_words = make_uint4(0u, 0u, 0u, 0u);
  __syncthreads();
  XcdBarrier xb = xcd_barrier_post(p.bar, (volatile LAS unsigned*)&xb_words);
#define GSYNC() xcd_barrier(xb)
  ph_prep_small(p);
#pragma unroll 1
  for (int l = 0; l < 2; ++l) {
    ph_convert(p, l, smem);
    if (l == 0) { grid.sync(); ph_mod(p, smem); }
    GSYNC();
#pragma unroll 1
    for (int g = 0; g < NGRP; ++g) {
      ph_prenorm(p, l, g); GSYNC();
      ph_gemm_in(p, smem); GSYNC();
      ph_conv(p, l); GSYNC();
      ph_scan(p, l, g, smem); GSYNC();
      ph_brfin(p, l, g); GSYNC();
      ph_gemm_merge(p, l, smem); GSYNC();
      ph_gemm_out(p, l, g, smem); GSYNC();
    }
  }
  ph_final(p);
}
#endif

extern "C" void kernel_launch(void* const* d_in, const int* in_sizes, int n_in, void* d_out, int out_size, void* d_ws,
                              size_t ws_size, hipStream_t stream) {
  Params p{};
  p.x = (const float*)d_in[0]; p.c = (const float*)d_in[1]; p.ctx = (const float*)d_in[2]; p.c_ctx = (const float*)d_in[3];
  p.ada_w = (const float*)d_in[4]; p.ada_b = (const float*)d_in[5]; p.norm_g = (const float*)d_in[6]; p.w_in = (const float*)d_in[7];
  p.hg_lb = (const float*)d_in[8]; p.hg_onorm = (const float*)d_in[9]; p.gdn_conv = (const float*)d_in[10];
  p.gdn_a_log = (const float*)d_in[11]; p.gdn_dt_bias = (const float*)d_in[12]; p.gdn_onorm = (const float*)d_in[13];
  p.ml_i_bias = (const float*)d_in[14]; p.ml_f_bias = (const float*)d_in[15]; p.ml_onorm = (const float*)d_in[16];
  p.w_branch = (const float*)d_in[17]; p.w_out = (const float*)d_in[18]; p.final_g = (const float*)d_in[19];
  p.out = (float*)d_out;
  char* ws = (char*)d_ws;
  size_t off = 0;
  auto take = [&](size_t bytes) { char* r = ws + off; off += (bytes + 255) & ~(size_t)255; return r; };
  p.WinT = (u16*)take((size_t)NPAD * D * 2);
  p.WbrT = (u16*)take((size_t)3 * D * D * 2);
  p.WoT = (u16*)take((size_t)D * D * 2);
  p.hbuf = (u16*)take((size_t)TG * D * 2);
  p.proj = (u16*)take((size_t)TG * PLD * 2);
  p.obuf = (u16*)take((size_t)2 * TG * 3072 * 2);
  p.mod = (float*)take((size_t)2 * 17 * 3072 * 4);
  p.lb = (float*)take((size_t)2 * D * 4);
  p.silc = (float*)take((size_t)17 * D * 4);
  p.gates = (float*)take((size_t)TG * GLD * 4);
  p.ctxs = (float*)take((size_t)NB * CTX * D * 4);
  p.bar = (unsigned*)take((size_t)XCD_BAR_WORDS * 4);
  if (off > ws_size) { fprintf(stderr, "workspace too small: need %zu have %zu\n", off, ws_size); return; }

  static int grid_blocks = 0;
  if (!grid_blocks) {
    int dev = 0, cus = 0, per_cu = 0;
    hipGetDevice(&dev);
    hipDeviceGetAttribute(&cus, hipDeviceAttributeMultiprocessorCount, dev);
#if COOP
    hipOccupancyMaxActiveBlocksPerMultiprocessor(&per_cu, k_mega, 256, 0);
#else
    hipOccupancyMaxActiveBlocksPerMultiprocessor(&per_cu, k_step, 256, 0);
#endif
    if (per_cu < 1) per_cu = 1;
    if (per_cu > 2) per_cu = 2;
    grid_blocks = cus * per_cu;
  }
#if COOP
  hipMemsetAsync(p.bar, 0, (size_t)XCD_BAR_WORDS * 4, stream);
  void* args[] = {&p};
  hipError_t e = hipLaunchCooperativeKernel((void*)k_mega, dim3(grid_blocks), dim3(256), args, 0, stream);
  if (e != hipSuccess) fprintf(stderr, "cooperative launch failed: %s (grid %d)\n", hipGetErrorString(e), grid_blocks);
#else
  for (int s = 0; s < NSTEPS; ++s) k_step<<<grid_blocks, 256, 0, stream>>>(p, s);
#endif
}
```

```cpp
#include <hip/hip_runtime.h>
#include <hip/hip_bf16.h>
#include <hip/hip_cooperative_groups.h>
#include <cstdio>
namespace cg = cooperative_groups;

#define REP_PRE 1
#define REP_GIN 1
#define REP_SCAN 1
#define REP_MRG 1
#define REP_SYNC 0
#ifndef COOP
#define COOP 1
#endif

typedef unsigned short u16;
using bf16x8 = __attribute__((ext_vector_type(8))) short;
using f32x4 = __attribute__((ext_vector_type(4))) float;

constexpr int D = 1024;
constexpr int NB = 16;
constexpr int SEQ = 2048;
constexpr int CTX = 256;
constexpr int TPB = SEQ + CTX;
constexpr int GB = 4;
constexpr int NGRP = NB / GB;
constexpr int TG = GB * TPB;
constexpr int IN_DIM = 16432;
constexpr int NPAD = 16512;
constexpr int PLD = 16384;
constexpr int GLD = 64;
constexpr int TC = 32;
constexpr int C_HGQ = 0, C_HGI = 1024, C_HGF = 2048, C_HGZ = 4096;
constexpr int C_GQ = 5120, C_GK = 6144, C_GV = 7168, C_GZ = 8192;
constexpr int C_MQ = 9216, C_MK = 9728, C_MV = 10240, C_MO = 11264, C_MZ = 12288;
constexpr int C_GATE = 13312;

struct Params {
  const float *x, *c, *ctx, *c_ctx, *ada_w, *ada_b, *norm_g, *w_in, *hg_lb, *hg_onorm, *gdn_conv,
      *gdn_a_log, *gdn_dt_bias, *gdn_onorm, *ml_i_bias, *ml_f_bias, *ml_onorm, *w_branch, *w_out, *final_g;
  float* out;
  u16 *WinT, *WbrT, *WoT, *hbuf, *proj, *obuf;
  float *mod, *lb, *silc, *gates, *ctxs;
  unsigned* bar;
};

__device__ __forceinline__ u16 f2bf(float f) {
  unsigned u = __float_as_uint(f);
  u += 0x7fffu + ((u >> 16) & 1u);
  return (u16)(u >> 16);
}
__device__ __forceinline__ float bf2f(u16 h) { return __uint_as_float(((unsigned)h) << 16); }
__device__ __forceinline__ float sigmoidf_(float x) { return 1.f / (1.f + __expf(-x)); }
__device__ __forceinline__ float siluf_(float x) { return x / (1.f + __expf(-x)); }
__device__ __forceinline__ float softplusf_(float y) { return fmaxf(y, 0.f) + log1pf(__expf(-fabsf(y))); }
__device__ __forceinline__ float wave_sum(float v) {
#pragma unroll
  for (int o = 32; o >= 1; o >>= 1) v += __shfl_xor(v, o);
  return v;
}
__device__ __forceinline__ void unpack8(const uint4& u, float* f) {
  f[0] = __uint_as_float(u.x << 16); f[1] = __uint_as_float(u.x & 0xffff0000u);
  f[2] = __uint_as_float(u.y << 16); f[3] = __uint_as_float(u.y & 0xffff0000u);
  f[4] = __uint_as_float(u.z << 16); f[5] = __uint_as_float(u.z & 0xffff0000u);
  f[6] = __uint_as_float(u.w << 16); f[7] = __uint_as_float(u.w & 0xffff0000u);
}
__device__ __forceinline__ unsigned pack2(float a, float b) { return (unsigned)f2bf(a) | ((unsigned)f2bf(b) << 16); }

__device__ __forceinline__ int otid() { int t = threadIdx.x; asm volatile("" : "+v"(t)); return t; }
__device__ __forceinline__ int win_src_col(int np) {
  if (np < 9216) return np;
  if (np < 13312) return np + 32;
  if (np < 16384) return np + 48;
  if (np < 16416) return 9216 + (np - 16384);
  if (np < 16432) return 13344 + (np - 16416);
  return -1;
}

__device__ void ph_convert(const Params& p, int l, char* smem) {
  float (*tile)[65] = (float (*)[65])smem;
  const int tid = otid();
  for (int t = blockIdx.x; t < 5152; t += gridDim.x) {
    const float* src; long sld; u16* dst; int n0, k0, kind;
    if (t < 4128) { kind = 0; n0 = (t / 16) * 64; k0 = (t % 16) * 64; src = p.w_in + (long)l * D * IN_DIM; sld = IN_DIM; dst = p.WinT; }
    else if (t < 4896) { int u = t - 4128; int i = u / 256; u %= 256; kind = 1; n0 = (u / 16) * 64; k0 = (u % 16) * 64;
      src = p.w_branch + ((long)l * 3 + i) * D * D; sld = D; dst = p.WbrT + (long)i * D * D; }
    else { int u = t - 4896; kind = 1; n0 = (u / 16) * 64; k0 = (u % 16) * 64; src = p.w_out + (long)l * D * D; sld = D; dst = p.WoT; }
#pragma unroll 4
    for (int i = 0; i < 16; ++i) {
      int kk = (tid >> 6) + 4 * i, nn = tid & 63;
      int np = n0 + nn;
      int ns = kind == 0 ? win_src_col(np) : np;
      tile[kk][nn] = ns >= 0 ? src[(long)(k0 + kk) * sld + ns] : 0.f;
    }
    __syncthreads();
#pragma unroll 4
    for (int i = 0; i < 16; ++i) {
      int nn = (tid >> 6) + 4 * i, kk = tid & 63;
      dst[(long)(n0 + nn) * D + k0 + kk] = f2bf(tile[kk][nn]);
    }
    __syncthreads();
  }
}

__device__ void ph_prep_small(const Params& p) {
  int gt = blockIdx.x * blockDim.x + otid(), gs = gridDim.x * blockDim.x;
  for (int i = gt; i < 17 * D + 2 * D; i += gs) {
    if (i < 16 * D) p.silc[i] = siluf_(p.c[i]);
    else if (i < 17 * D) p.silc[i] = siluf_(p.c_ctx[i - 16 * D]);
    else {
      int j = i - 17 * D;
      if (j < D) p.lb[j] = 0.f;
      else { int ch = j - D; p.lb[j] = sigmoidf_(p.hg_lb[D + ch] - p.hg_lb[ch]); }
    }
  }
}

__device__ void ph_mod(const Params& p, char* smem) {
  float (*red)[17][64] = (float (*)[17][64])smem;
  const int tid = otid();
  const int kq = __builtin_amdgcn_readfirstlane(tid >> 6), cc = tid & 63;
  for (int u = blockIdx.x; u < 96; u += gridDim.x) {
    int l = u / 48, col = (u % 48) * 64 + cc;
    float acc[17];
#pragma unroll
    for (int r = 0; r < 17; ++r) acc[r] = 0.f;
    const float* w = p.ada_w + (long)l * D * 3072 + col;
    for (int k = kq * 256; k < kq * 256 + 256; ++k) {
      float wv = w[(long)k * 3072];
#pragma unroll
      for (int r = 0; r < 17; ++r) acc[r] += p.silc[r * D + k] * wv;
    }
#pragma unroll
    for (int r = 0; r < 17; ++r) red[kq][r][cc] = acc[r];
    __syncthreads();
    for (int i = tid; i < 17 * 64; i += 256) {
      int r = i / 64, c2 = i % 64;
      int colo = (u % 48) * 64 + c2;
      float s = red[0][r][c2] + red[1][r][c2] + red[2][r][c2] + red[3][r][c2] + p.ada_b[l * 3072 + colo];
      p.mod[((long)l * 17 + r) * 3072 + colo] = s;
    }
    __syncthreads();
  }
}

__device__ void ph_prenorm(const Params& p, int l, int g) {
  const int tid = otid();
  const int lane = tid & 63;
  const int gw = blockIdx.x * 4 + (tid >> 6), nw = gridDim.x * 4;
  for (int row = gw; row < TG; row += nw) {
    int bl = row / TPB, pp = row % TPB, b = g * GB + bl;
    const float* src; int mrow;
    if (pp < CTX) { src = (l == 0 ? p.ctx : p.ctxs) + ((long)b * CTX + pp) * D; mrow = 16; }
    else { src = (l == 0 ? p.x : p.out) + ((long)b * SEQ + (pp - CTX)) * D; mrow = b; }
    const float* md = p.mod + ((long)l * 17 + mrow) * 3072;
    float4 v[4]; float ss = 0.f;
#pragma unroll
    for (int i = 0; i < 4; ++i) {
      v[i] = ((const float4*)src)[lane + 64 * i];
      ss += v[i].x * v[i].x + v[i].y * v[i].y + v[i].z * v[i].z + v[i].w * v[i].w;
    }
    ss = wave_sum(ss);
    float rs = rsqrtf(ss * (1.f / D) + 1e-6f);
#pragma unroll
    for (int i = 0; i < 4; ++i) {
      int idx = (lane + 64 * i) * 4;
      float4 g4 = *(const float4*)(p.norm_g + l * D + idx);
      float4 sh = *(const float4*)(md + idx);
      float4 sc = *(const float4*)(md + D + idx);
      float h0 = v[i].x * rs * g4.x * (1.f + sc.x) + sh.x;
      float h1 = v[i].y * rs * g4.y * (1.f + sc.y) + sh.y;
      float h2 = v[i].z * rs * g4.z * (1.f + sc.z) + sh.z;
      float h3 = v[i].w * rs * g4.w * (1.f + sc.w) + sh.w;
      uint2 o; o.x = pack2(h0, h1); o.y = pack2(h2, h3);
      *(uint2*)(p.hbuf + (long)row * D + idx) = o;
    }
  }
}

template <int NF>
__device__ __forceinline__ void gemm_kloop(const u16* Ag, long lda, const u16* Bg, long ldb, int K, char* smem, f32x4 (&acc)[4][NF]) {
  const int tid = otid();
  const int wid = tid >> 6, lane = tid & 63, wr = wid >> 1, wc = wid & 1, fr = lane & 15, fq = lane >> 4;
  char* SA = smem; char* SB = smem + 8192;
  for (int t = 0; t < K / 32; ++t) {
#pragma unroll
    for (int i = 0; i < 2; ++i) {
      int b = tid * 16 + i * 4096, r = b / 64, c = (b % 64) / 2;
      __builtin_amdgcn_global_load_lds((const unsigned*)(Ag + (long)r * lda + t * 32 + c), (__attribute__((address_space(3))) unsigned*)(SA + b), 16, 0, 0);
      if (NF == 4 || i == 0)
        __builtin_amdgcn_global_load_lds((const unsigned*)(Bg + (long)r * ldb + t * 32 + c), (__attribute__((address_space(3))) unsigned*)(SB + b), 16, 0, 0);
    }
    asm volatile("s_waitcnt vmcnt(0)" ::: "memory");
    __syncthreads();
    bf16x8 At[4], Bl[NF];
#pragma unroll
    for (int m = 0; m < 4; ++m) At[m] = *(const bf16x8*)(SA + (wr * 64 + m * 16 + fr) * 64 + fq * 16);
#pragma unroll
    for (int n = 0; n < NF; ++n) Bl[n] = *(const bf16x8*)(SB + (wc * NF * 16 + n * 16 + fr) * 64 + fq * 16);
#pragma unroll
    for (int m = 0; m < 4; ++m)
#pragma unroll
      for (int n = 0; n < NF; ++n) acc[m][n] = __builtin_amdgcn_mfma_f32_16x16x32_bf16(At[m], Bl[n], acc[m][n], 0, 0, 0);
    __syncthreads();
  }
}

__device__ void ph_gemm_in(const Params& p, char* smem) {
  const int tid = otid();
  const int wid = tid >> 6, lane = tid & 63, wr = wid >> 1, wc = wid & 1, fr = lane & 15, fq = lane >> 4;
  for (int t = blockIdx.x; t < 72 * 129; t += gridDim.x) {
    int nt = t / 72, mt = t % 72;
    f32x4 acc[4][4];
#pragma unroll
    for (int m = 0; m < 4; ++m)
#pragma unroll
      for (int n = 0; n < 4; ++n) acc[m][n] = f32x4{0.f, 0.f, 0.f, 0.f};
    gemm_kloop<4>(p.hbuf + (long)mt * 128 * D, D, p.WinT + (long)nt * 128 * D, D, D, smem, acc);
    if (nt < 128) {
      u16* dbase; long dld; int cb;
      if (nt >= 40 && nt < 64) { dbase = p.obuf + (long)TG * 3072; dld = 3072; cb = (nt - 40) * 128; }
      else { dbase = p.proj; dld = PLD; cb = nt * 128; }
#pragma unroll
      for (int m = 0; m < 4; ++m)
#pragma unroll
        for (int n = 0; n < 4; ++n)
#pragma unroll
          for (int j = 0; j < 4; ++j) {
            int row = mt * 128 + wr * 64 + m * 16 + fq * 4 + j, col = cb + wc * 64 + n * 16 + fr;
            dbase[(long)row * dld + col] = f2bf(acc[m][n][j]);
          }
    } else if (wc == 0) {
#pragma unroll
      for (int m = 0; m < 4; ++m)
#pragma unroll
        for (int n = 0; n < 4; ++n)
#pragma unroll
          for (int j = 0; j < 4; ++j) {
            int row = mt * 128 + wr * 64 + m * 16 + fq * 4 + j, col = n * 16 + fr;
            p.gates[(long)row * GLD + col] = acc[m][n][j];
          }
    }
  }
}

__device__ void ph_conv(const Params& p, int l) {
  const int tid = otid();
  const int lane = tid & 63;
  const int gw = blockIdx.x * 4 + (tid >> 6), nw = gridDim.x * 4;
  const u16* stg = p.obuf + (long)TG * 3072;
  for (int task = gw; task < TG * 8; task += nw) {
    int row = task >> 3, h = task & 7;
    int bl = row / TPB, t = row % TPB;
    int part = lane >> 4, c8 = lane & 15;
    int chn = part * 1024 + h * 128 + c8 * 8;
    float val[8];
#pragma unroll
    for (int e = 0; e < 8; ++e) val[e] = 0.f;
    if (part < 3) {
      const float* cwb = p.gdn_conv + (long)l * 9 * 3072 + chn;
      if (t < CTX) {
#pragma unroll
        for (int jj = 0; jj < 3; ++jj) {
          int tt = t + jj - 1;
          if (tt >= 0 && tt < CTX) {
            uint4 raw = *(const uint4*)(stg + (long)(bl * TPB + tt) * 3072 + chn);
            float xv[8]; unpack8(raw, xv);
            float4 w0 = *(const float4*)(cwb + (3 + jj) * 3072), w1 = *(const float4*)(cwb + (3 + jj) * 3072 + 4);
            val[0] += xv[0] * w0.x; val[1] += xv[1] * w0.y; val[2] += xv[2] * w0.z; val[3] += xv[3] * w0.w;
            val[4] += xv[4] * w1.x; val[5] += xv[5] * w1.y; val[6] += xv[6] * w1.z; val[7] += xv[7] * w1.w;
          }
        }
      } else {
        int lt = t - CTX, rr0 = lt >> 6, cc0 = lt & 63;
#pragma unroll
        for (int ii = 0; ii < 3; ++ii) {
          int rr = rr0 + ii - 1;
          if (rr < 0 || rr >= 32) continue;
#pragma unroll
          for (int jj = 0; jj < 3; ++jj) {
            int cc = cc0 + jj - 1;
            if (cc < 0 || cc >= 64) continue;
            uint4 raw = *(const uint4*)(stg + (long)(bl * TPB + CTX + rr * 64 + cc) * 3072 + chn);
            float xv[8]; unpack8(raw, xv);
            float4 w0 = *(const float4*)(cwb + (ii * 3 + jj) * 3072), w1 = *(const float4*)(cwb + (ii * 3 + jj) * 3072 + 4);
            val[0] += xv[0] * w0.x; val[1] += xv[1] * w0.y; val[2] += xv[2] * w0.z; val[3] += xv[3] * w0.w;
            val[4] += xv[4] * w1.x; val[5] += xv[5] * w1.y; val[6] += xv[6] * w1.z; val[7] += xv[7] * w1.w;
          }
        }
      }
    }
    float ss = 0.f;
#pragma unroll
    for (int e = 0; e < 8; ++e) { val[e] = siluf_(val[e]); ss += val[e] * val[e]; }
    ss += __shfl_xor(ss, 1); ss += __shfl_xor(ss, 2); ss += __shfl_xor(ss, 4); ss += __shfl_xor(ss, 8);
    float scl = 1.f;
    if (part == 0) scl = rsqrtf(ss + 1e-6f) * 0.08838834764831845f;
    else if (part == 1) scl = rsqrtf(ss + 1e-6f);
    if (part < 3) {
      uint4 o;
      o.x = pack2(val[0] * scl, val[1] * scl); o.y = pack2(val[2] * scl, val[3] * scl);
      o.z = pack2(val[4] * scl, val[5] * scl); o.w = pack2(val[6] * scl, val[7] * scl);
      *(uint4*)(p.proj + (long)row * PLD + C_GQ + chn) = o;
    }
  }
}

struct ScanSmem {
  float q[TC][128];
  float k[TC][128];
  float f[TC][128];
  float v[TC][64];
  float sc[TC][4];
};

__device__ __forceinline__ int scan_row(int bl, int dir, int pos) {
  int t;
  if (pos < CTX) t = dir ? (CTX - 1 - pos) : pos;
  else { int u = pos - CTX; t = CTX + (dir ? (SEQ - 1 - u) : u); }
  return bl * TPB + t;
}

__device__ void scan_unit(const Params& p, int l, int g, int u, ScanSmem& sm) {
  const int tid = otid(), lane = tid & 63, w = tid >> 6;
  const int j = lane & 15, gq = lane >> 4;
  const int mixer = u / 128, r = u % 128;
  int bl, h, dir, vs;
  bl = r / 32;
  if (mixer < 2) { h = (r % 32) / 4; dir = (r % 4) / 2; vs = r % 2; }
  else { h = (r % 32) / 8; dir = (r % 8) / 4; vs = r % 4; }
  int cq, ck, cv, ocol;
  if (mixer == 0) { cq = C_HGQ + h * 128; ck = C_HGF + dir * 1024 + h * 128; cv = C_HGI + h * 128 + vs * 64; ocol = h * 128 + vs * 64; }
  else if (mixer == 1) { cq = C_GQ + h * 128; ck = C_GK + h * 128; cv = C_GV + h * 128 + vs * 64; ocol = 1024 + h * 128 + vs * 64; }
  else { cq = C_MQ + h * 128; ck = C_MK + h * 128; cv = C_MV + h * 256 + vs * 64; ocol = 2048 + h * 256 + vs * 64; }

  float S[32];
#pragma unroll
  for (int i = 0; i < 32; ++i) S[i] = 0.f;
  float n0 = 0.f, n1 = 0.f;
  float mstate = 0.f;
  float gA = 0.f, gDt = 0.f, ibias = 0.f, fbias = 0.f;
  if (mixer == 1) { gA = -__expf(p.gdn_a_log[l * 16 + dir * 8 + h]); gDt = p.gdn_dt_bias[l * 16 + dir * 8 + h]; }
  if (mixer == 2) { ibias = p.ml_i_bias[l * 8 + dir * 4 + h]; fbias = p.ml_f_bias[l * 8 + dir * 4 + h]; }

  __syncthreads();
  if (mixer == 1) {
    float* cw = &sm.f[0][0];
    for (int i = tid; i < 9 * 320; i += 256) {
      int tap = i / 320, lc = i % 320;
      int ch = lc < 128 ? (h * 128 + lc) : (lc < 256 ? (1024 + h * 128 + lc - 128) : (2048 + h * 128 + vs * 64 + lc - 256));
      cw[i] = p.gdn_conv[((long)l * 9 + tap) * 3072 + ch];
    }
    __syncthreads();
  }

  for (int ch0 = 0; ch0 < TPB / TC; ++ch0) {
    const int pos0 = ch0 * TC;
    const bool is_ctx = pos0 < CTX;
    __syncthreads();
    for (int idx = tid; idx < TC * 40; idx += 256) {
      int tok = idx / 40, cgp = idx % 40;
      int row = scan_row(bl, dir, pos0 + tok);
      int col, lc;
      if (cgp < 16) { col = cq + cgp * 8; lc = cgp * 8; }
      else if (cgp < 32) { col = ck + (cgp - 16) * 8; lc = 128 + (cgp - 16) * 8; }
      else { col = cv + (cgp - 32) * 8; lc = 256 + (cgp - 32) * 8; }
      float val[8];
      if (mixer != 1) {
        uint4 raw = *(const uint4*)(p.proj + (long)row * PLD + col);
        unpack8(raw, val);
      } else {
        const float* cw = &sm.f[0][0];
#pragma unroll
        for (int e = 0; e < 8; ++e) val[e] = 0.f;
        int t = row - bl * TPB;
        if (is_ctx) {
#pragma unroll
          for (int jj = 0; jj < 3; ++jj) {
            int tt = t + jj - 1;
            if (tt >= 0 && tt < CTX) {
              uint4 raw = *(const uint4*)(p.proj + (long)(bl * TPB + tt) * PLD + col);
              float xv[8]; unpack8(raw, xv);
              const float* wv = cw + (3 + jj) * 320 + lc;
#pragma unroll
              for (int e = 0; e < 8; ++e) val[e] += xv[e] * wv[e];
            }
          }
        } else {
          int lt = t - CTX, rr0 = lt >> 6, cc0 = lt & 63;
#pragma unroll
          for (int ii = 0; ii < 3; ++ii) {
            int rr = rr0 + ii - 1;
            if (rr < 0 || rr >= 32) continue;
#pragma unroll
            for (int jj = 0; jj < 3; ++jj) {
              int cc = cc0 + jj - 1;
              if (cc < 0 || cc >= 64) continue;
              uint4 raw = *(const uint4*)(p.proj + (long)(bl * TPB + CTX + rr * 64 + cc) * PLD + col);
              float xv[8]; unpack8(raw, xv);
              const float* wv = cw + (ii * 3 + jj) * 320 + lc;
#pragma unroll
              for (int e = 0; e < 8; ++e) val[e] += xv[e] * wv[e];
            }
          }
        }
#pragma unroll
        for (int e = 0; e < 8; ++e) val[e] = siluf_(val[e]);
      }
      if (cgp < 16) {
        float scl = (mixer == 2) ? 0.08838834764831845f : 1.f;
#pragma unroll
        for (int e = 0; e < 8; ++e) sm.q[tok][lc + e] = val[e] * scl;
      } else if (cgp < 32) {
        int d0 = lc - 128;
        if (mixer == 0) {
#pragma unroll
          for (int e = 0; e < 8; ++e) {
            float lbv = p.lb[l * D + h * 128 + d0 + e];
            float f = lbv + (1.f - lbv) * sigmoidf_(val[e]);
            sm.f[tok][d0 + e] = f;
            sm.k[tok][d0 + e] = 1.f - f;
          }
        } else {
#pragma unroll
          for (int e = 0; e < 8; ++e) sm.k[tok][d0 + e] = val[e];
        }
      } else {
        int c0 = lc - 256;
#pragma unroll
        for (int e = 0; e < 8; ++e) sm.v[tok][c0 + e] = val[e];
      }
    }
    if (mixer == 2 && tid < TC) {
      int row = scan_row(bl, dir, pos0 + tid);
      float ig = p.gates[(long)row * GLD + 32 + dir * 4 + h] + ibias;
      float fx = p.gates[(long)row * GLD + 40 + dir * 4 + h] + fbias;
      sm.sc[tid][0] = ig;
      sm.sc[tid][1] = -softplusf_(-fx);
    }
    __syncthreads();
    if (mixer == 1) {
      for (int tk = w * 8; tk < w * 8 + 8; ++tk) {
        float q0 = sm.q[tk][lane], q1 = sm.q[tk][lane + 64], k0 = sm.k[tk][lane], k1 = sm.k[tk][lane + 64];
        float sq = wave_sum(q0 * q0 + q1 * q1), sk = wave_sum(k0 * k0 + k1 * k1), qk = wave_sum(q0 * k0 + q1 * k1);
        float rq = rsqrtf(sq + 1e-6f) * 0.08838834764831845f, rk = rsqrtf(sk + 1e-6f);
        sm.q[tk][lane] = q0 * rq; sm.q[tk][lane + 64] = q1 * rq;
        sm.k[tk][lane] = k0 * rk; sm.k[tk][lane + 64] = k1 * rk;
        if (lane == 0) {
          int row = scan_row(bl, dir, pos0 + tk);
          float beta = sigmoidf_(p.gates[(long)row * GLD + dir * 8 + h]);
          float gg = gA * softplusf_(p.gates[(long)row * GLD + 16 + dir * 8 + h] + gDt);
          sm.sc[tk][0] = __expf(gg); sm.sc[tk][1] = beta; sm.sc[tk][2] = qk * rq * rk;
        }
      }
      __syncthreads();
    } else if (mixer == 2) {
      if (tid == 0) {
        float m = mstate;
        for (int tk = 0; tk < TC; ++tk) {
          float ig = sm.sc[tk][0], lf = sm.sc[tk][1];
          float mn = fmaxf(lf + m, ig);
          sm.sc[tk][0] = __expf(lf + m - mn);
          sm.sc[tk][1] = __expf(ig - mn);
          sm.sc[tk][2] = __expf(-mn);
          m = mn;
        }
        mstate = m;
      }
      __syncthreads();
    }
    if (mixer == 0) {
      for (int tk = 0; tk < TC; ++tk) {
        float vj = sm.v[tk][w * 16 + j];
        const float4* qp = (const float4*)&sm.q[tk][gq * 32];
        const float4* kp = (const float4*)&sm.k[tk][gq * 32];
        const float4* fp = (const float4*)&sm.f[tk][gq * 32];
        float acc = 0.f;
#pragma unroll
        for (int i = 0; i < 8; ++i) {
          float4 q4 = qp[i], k4 = kp[i], f4 = fp[i];
          S[4 * i + 0] = f4.x * S[4 * i + 0] + k4.x * vj; acc += q4.x * S[4 * i + 0];
          S[4 * i + 1] = f4.y * S[4 * i + 1] + k4.y * vj; acc += q4.y * S[4 * i + 1];
          S[4 * i + 2] = f4.z * S[4 * i + 2] + k4.z * vj; acc += q4.z * S[4 * i + 2];
          S[4 * i + 3] = f4.w * S[4 * i + 3] + k4.w * vj; acc += q4.w * S[4 * i + 3];
        }
        acc += __shfl_xor(acc, 16); acc += __shfl_xor(acc, 32);
        if (gq == 0) sm.v[tk][w * 16 + j] = acc;
      }
    } else if (mixer == 1) {
      for (int tk = 0; tk < TC; ++tk) {
        float vj = sm.v[tk][w * 16 + j];
        float a = sm.sc[tk][0], beta = sm.sc[tk][1], qk = sm.sc[tk][2];
        const float4* qp = (const float4*)&sm.q[tk][gq * 32];
        const float4* kp = (const float4*)&sm.k[tk][gq * 32];
        float kr[32];
        float rr = 0.f, pq = 0.f;
#pragma unroll
        for (int i = 0; i < 8; ++i) {
          float4 q4 = qp[i], k4 = kp[i];
          kr[4 * i + 0] = k4.x; kr[4 * i + 1] = k4.y; kr[4 * i + 2] = k4.z; kr[4 * i + 3] = k4.w;
          rr += k4.x * S[4 * i + 0]; pq += q4.x * S[4 * i + 0];
          rr += k4.y * S[4 * i + 1]; pq += q4.y * S[4 * i + 1];
          rr += k4.z * S[4 * i + 2]; pq += q4.z * S[4 * i + 2];
          rr += k4.w * S[4 * i + 3]; pq += q4.w * S[4 * i + 3];
        }
        rr += __shfl_xor(rr, 16); pq += __shfl_xor(pq, 16);
        rr += __shfl_xor(rr, 32); pq += __shfl_xor(pq, 32);
        float vn = beta * (vj - a * rr);
        float ov = a * pq + qk * vn;
#pragma unroll
        for (int i = 0; i < 32; ++i) S[i] = a * S[i] + kr[i] * vn;
        if (gq == 0) sm.v[tk][w * 16 + j] = ov;
      }
    } else {
      for (int tk = 0; tk < TC; ++tk) {
        float vj = sm.v[tk][w * 16 + j];
        float fd = sm.sc[tk][0], iw = sm.sc[tk][1], em = sm.sc[tk][2];
        float ivj = iw * vj;
        const float4* qp = (const float4*)&sm.q[tk][gq * 32];
        const float4* kp = (const float4*)&sm.k[tk][gq * 32];
        float acc = 0.f;
#pragma unroll
        for (int i = 0; i < 8; ++i) {
          float4 q4 = qp[i], k4 = kp[i];
          S[4 * i + 0] = fd * S[4 * i + 0] + k4.x * ivj; acc += q4.x * S[4 * i + 0];
          S[4 * i + 1] = fd * S[4 * i + 1] + k4.y * ivj; acc += q4.y * S[4 * i + 1];
          S[4 * i + 2] = fd * S[4 * i + 2] + k4.z * ivj; acc += q4.z * S[4 * i + 2];
          S[4 * i + 3] = fd * S[4 * i + 3] + k4.w * ivj; acc += q4.w * S[4 * i + 3];
        }
        float2 kk = *(const float2*)&sm.k[tk][gq * 32 + 2 * j];
        float2 qq = *(const float2*)&sm.q[tk][gq * 32 + 2 * j];
        n0 = fd * n0 + iw * kk.x; n1 = fd * n1 + iw * kk.y;
        float den = n0 * qq.x + n1 * qq.y;
        den = wave_sum(den);
        acc += __shfl_xor(acc, 16); acc += __shfl_xor(acc, 32);
        if (gq == 0) sm.v[tk][w * 16 + j] = acc / fmaxf(fabsf(den), em);
      }
    }
    __syncthreads();
    {
      int tok = tid >> 3, c8 = tid & 7;
      int row = scan_row(bl, dir, pos0 + tok);
      const float* op = &sm.v[tok][c8 * 8];
      uint4 o;
      o.x = pack2(op[0], op[1]); o.y = pack2(op[2], op[3]); o.z = pack2(op[4], op[5]); o.w = pack2(op[6], op[7]);
      *(uint4*)(p.obuf + ((long)dir * TG + row) * 3072 + ocol + c8 * 8) = o;
    }
  }
}

struct CSmem {
  u16 QA[32][136];
  u16 KA[32][136];
  u16 KDT[128][40];
  u16 XT[64][40];
  u16 ATT[32][40];
  u16 ST[64][136];
  float sc[32][8];
  union {
    struct { u16 QD[32][136]; float dec[128]; float hsum[2][128]; } hg;
    struct { u16 YT[64][40]; u16 TM[32][40]; float NM[32][36]; u16 VF[32][72]; } gd;
    struct { float nvec[128]; } ml;
  } u;
};

__device__ __forceinline__ f32x4 mfma16(bf16x8 a, bf16x8 b, f32x4 c) { return __builtin_amdgcn_mfma_f32_16x16x32_bf16(a, b, c, 0, 0, 0); }
__device__ __forceinline__ bf16x8 ldf(const u16* base, int ld, int row, int k) { return *(const bf16x8*)(base + row * ld + k); }
__device__ __forceinline__ void st4(u16* dst, float a, float b, float c, float d) { uint2 v; v.x = pack2(a, b); v.y = pack2(c, d); *(uint2*)dst = v; }

__device__ void scan_unit_mma(const Params& p, int l, int g, int u, CSmem& sm) {
  const int tid0 = otid();
  const int mixer = u / 128, r = u % 128;
  int bl, h, dir, vs;
  bl = r / 32;
  if (mixer < 2) { h = (r % 32) / 4; dir = (r % 4) / 2; vs = r % 2; }
  else { h = (r % 32) / 8; dir = (r % 8) / 4; vs = r % 4; }
  int cq, ck, cv, ocol;
  if (mixer == 0) { cq = C_HGQ + h * 128; ck = C_HGF + dir * 1024 + h * 128; cv = C_HGI + h * 128 + vs * 64; ocol = h * 128 + vs * 64; }
  else if (mixer == 1) { cq = C_GQ + h * 128; ck = C_GK + h * 128; cv = C_GV + h * 128 + vs * 64; ocol = 1024 + h * 128 + vs * 64; }
  else { cq = C_MQ + h * 128; ck = C_MK + h * 128; cv = C_MV + h * 256 + vs * 64; ocol = 2048 + h * 256 + vs * 64; }
  const float QS = 0.08838834764831845f;

  f32x4 S[2][4];
#pragma unroll
  for (int a = 0; a < 2; ++a)
#pragma unroll
    for (int b = 0; b < 4; ++b) S[a][b] = f32x4{0.f, 0.f, 0.f, 0.f};
  float mcar = 0.f;
  float gA = 0.f, gDt = 0.f, ibias = 0.f, fbias = 0.f;
  if (mixer == 1) { gA = -__expf(p.gdn_a_log[l * 16 + dir * 8 + h]); gDt = p.gdn_dt_bias[l * 16 + dir * 8 + h]; }
  if (mixer == 2) { ibias = p.ml_i_bias[l * 8 + dir * 4 + h]; fbias = p.ml_f_bias[l * 8 + dir * 4 + h]; }

  __syncthreads();
  for (int i = tid0; i < 64 * 136 / 2; i += 256) ((unsigned*)&sm.ST[0][0])[i] = 0u;
  if (mixer == 2 && tid0 < 128) sm.u.ml.nvec[tid0] = 0.f;
  __syncthreads();


  uint4 pq0, pq1, pk0, pk1, pv;
  float pg0 = 0.f, pg1 = 0.f;
  const int gc0 = (mixer == 1) ? (dir * 8 + h) : (32 + dir * 4 + h);
  const int gc1 = (mixer == 1) ? (16 + dir * 8 + h) : (40 + dir * 4 + h);
  const float lbv = (mixer == 0) ? p.lb[l * D + h * 128 + (tid0 & 127)] : 0.f;
#define ISSUE_LOADS(CH, TID)                                                                          \
  {                                                                                                   \
    const int _pos = (CH) * 32;                                                                       \
    {                                                                                                 \
      int _idx = (TID), _tok = _idx >> 4, _c = _idx & 15;                                             \
      const u16* _pr = p.proj + (long)scan_row(bl, dir, _pos + _tok) * PLD;                           \
      pq0 = *(const uint4*)(_pr + cq + _c * 8);                                                       \
      pk0 = *(const uint4*)(_pr + ck + _c * 8);                                                       \
    }                                                                                                 \
    {                                                                                                 \
      int _idx = (TID) + 256, _tok = _idx >> 4, _c = _idx & 15;                                       \
      const u16* _pr = p.proj + (long)scan_row(bl, dir, _pos + _tok) * PLD;                           \
      pq1 = *(const uint4*)(_pr + cq + _c * 8);                                                       \
      pk1 = *(const uint4*)(_pr + ck + _c * 8);                                                       \
    }                                                                                                 \
    {                                                                                                 \
      int _tok = (TID) >> 3, _c8 = (TID) & 7;                                                         \
      pv = *(const uint4*)(p.proj + (long)scan_row(bl, dir, _pos + _tok) * PLD + cv + _c8 * 8);       \
    }                                                                                                 \
    if (mixer != 0 && (TID) < 64) {                                                                   \
      const float* _gp = p.gates + (long)scan_row(bl, dir, _pos + ((TID) & 31)) * GLD;                \
      pg0 = _gp[gc0]; pg1 = _gp[gc1];                                                                 \
    }                                                                                                 \
  }
  ISSUE_LOADS(0, tid0)

  for (int ch0 = 0; ch0 < TPB / 32; ++ch0) {
    const int tid = otid(), lane = tid & 63, w = tid >> 6, fr = lane & 15, fq = lane >> 4;
    const int rt_o = w & 1, cp_o = w >> 1;
    const int pos0 = ch0 * 32;
    float mnew = 0.f;
    {
      int tok = tid >> 4, c = tid & 15;
      *(uint4*)&sm.QA[tok][c * 8] = pq0; *(uint4*)&sm.KA[tok][c * 8] = pk0;
      *(uint4*)&sm.QA[tok + 16][c * 8] = pq1; *(uint4*)&sm.KA[tok + 16][c * 8] = pk1;
    }
    {
      int t = tid >> 3, c8 = tid & 7;
      if (mixer == 1) *(uint4*)&sm.u.gd.VF[t][c8 * 8] = pv;
      else {
        sm.XT[c8 * 8 + 0][t] = (u16)(pv.x & 0xffffu); sm.XT[c8 * 8 + 1][t] = (u16)(pv.x >> 16);
        sm.XT[c8 * 8 + 2][t] = (u16)(pv.y & 0xffffu); sm.XT[c8 * 8 + 3][t] = (u16)(pv.y >> 16);
        sm.XT[c8 * 8 + 4][t] = (u16)(pv.z & 0xffffu); sm.XT[c8 * 8 + 5][t] = (u16)(pv.z >> 16);
        sm.XT[c8 * 8 + 6][t] = (u16)(pv.w & 0xffffu); sm.XT[c8 * 8 + 7][t] = (u16)(pv.w >> 16);
      }
    }
    const float g0 = pg0, g1 = pg1;
    if (ch0 + 1 < TPB / 32) ISSUE_LOADS(ch0 + 1, tid)
    if (mixer == 0) {
      __syncthreads();
      const int d = tid & 127, hh = tid >> 7;
      float bb[16], qv[16], kv[16];
      float run = 0.f;
#pragma unroll
      for (int i = 0; i < 16; ++i) {
        int t = hh * 16 + i;
        float fx = bf2f(sm.KA[t][d]);
        qv[i] = bf2f(sm.QA[t][d]);
        float f = lbv + (1.f - lbv) * sigmoidf_(fx);
        kv[i] = 1.f - f;
        run += __logf(f);
        bb[i] = run;
      }
      sm.u.hg.hsum[hh][d] = run;
      __syncthreads();
      float h0 = sm.u.hg.hsum[0][d], h1 = sm.u.hg.hsum[1][d];
      float bref = h0, bend = h0 + h1, off = hh ? h0 : 0.f;
      if (hh == 0) sm.u.hg.dec[d] = __expf(bend);
      unsigned kd2[8];
#pragma unroll
      for (int i = 0; i < 16; ++i) {
        float b = bb[i] + off;
        float qa = qv[i] * __expf(fminf(b - bref, 80.f));
        float ka = kv[i] * __expf(fminf(bref - b, 80.f));
        float qd = qv[i] * __expf(b);
        float kd = kv[i] * __expf(bend - b);
        int t = hh * 16 + i;
        sm.QA[t][d] = f2bf(qa); sm.KA[t][d] = f2bf(ka); sm.u.hg.QD[t][d] = f2bf(qd);
        if (i & 1) kd2[i >> 1] |= ((unsigned)f2bf(kd)) << 16; else kd2[i >> 1] = (unsigned)f2bf(kd);
      }
      *(uint4*)&sm.KDT[d][hh * 16] = uint4{kd2[0], kd2[1], kd2[2], kd2[3]};
      *(uint4*)&sm.KDT[d][hh * 16 + 8] = uint4{kd2[4], kd2[5], kd2[6], kd2[7]};
      __syncthreads();
    } else if (mixer == 1) {
      if (w == 0) {
        int tk = lane & 31;
        float beta = sigmoidf_(g0);
        float G = gA * softplusf_(g1 + gDt);
#pragma unroll
        for (int o = 1; o < 32; o <<= 1) { float t2 = __shfl_up(G, o); if (tk >= o) G += t2; }
        if (lane < 32) { sm.sc[tk][0] = G; sm.sc[tk][1] = beta; }
      }
      __syncthreads();
      {
        const int d = tid & 127, hh = tid >> 7;
        float Gend = sm.sc[31][0];
        unsigned kd2[8];
#pragma unroll
        for (int i = 0; i < 16; ++i) {
          int s_ = hh * 16 + i;
          float kd = bf2f(sm.KA[s_][d]) * __expf(Gend - sm.sc[s_][0]);
          if (i & 1) kd2[i >> 1] |= ((unsigned)f2bf(kd)) << 16; else kd2[i >> 1] = (unsigned)f2bf(kd);
        }
        *(uint4*)&sm.KDT[d][hh * 16] = uint4{kd2[0], kd2[1], kd2[2], kd2[3]};
        *(uint4*)&sm.KDT[d][hh * 16 + 8] = uint4{kd2[4], kd2[5], kd2[6], kd2[7]};
      }
      {
        const int ai = w & 1, bi = w >> 1;
        if (ai >= bi) {
          f32x4 acc = f32x4{0.f, 0.f, 0.f, 0.f};
#pragma unroll
          for (int kk = 0; kk < 4; ++kk)
            acc = mfma16(ldf(&sm.KA[0][0], 136, ai * 16 + fr, kk * 32 + fq * 8), ldf(&sm.KA[0][0], 136, bi * 16 + fr, kk * 32 + fq * 8), acc);
          int b = bi * 16 + fr;
          float Gb = sm.sc[b][0];
#pragma unroll
          for (int j = 0; j < 4; ++j) {
            int a = ai * 16 + fq * 4 + j;
            if (a > b) sm.u.gd.NM[a][b] = sm.sc[a][1] * acc[j] * __expf(sm.sc[a][0] - Gb);
          }
        }
      }
      __syncthreads();
    } else {
      if (w == 0) {
        int tk = lane & 31;
        float ig = g0 + ibias;
        float F = -softplusf_(-(g1 + fbias));
#pragma unroll
        for (int o = 1; o < 32; o <<= 1) { float t2 = __shfl_up(F, o); if (tk >= o) F += t2; }
        float a = ig - F;
        float pm = a;
#pragma unroll
        for (int o = 1; o < 32; o <<= 1) { float t2 = __shfl_up(pm, o); if (tk >= o) pm = fmaxf(pm, t2); }
        float M = fmaxf(mcar, pm);
        if (lane < 32) { sm.sc[tk][0] = F; sm.sc[tk][1] = a; sm.sc[tk][2] = M; }
      }
      __syncthreads();
      {
        const int d = tid & 127, hh = tid >> 7;
        float Mend = sm.sc[31][2];
        mnew = sm.sc[31][0] + Mend;
        unsigned kd2[8];
#pragma unroll
        for (int i = 0; i < 16; ++i) {
          int s_ = hh * 16 + i;
          float kd = bf2f(sm.KA[s_][d]) * __expf(sm.sc[s_][1] - Mend);
          if (i & 1) kd2[i >> 1] |= ((unsigned)f2bf(kd)) << 16; else kd2[i >> 1] = (unsigned)f2bf(kd);
        }
        *(uint4*)&sm.KDT[d][hh * 16] = uint4{kd2[0], kd2[1], kd2[2], kd2[3]};
        *(uint4*)&sm.KDT[d][hh * 16 + 8] = uint4{kd2[4], kd2[5], kd2[6], kd2[7]};
      }
    }
    if (mixer == 1 && w == 0) {
      if (lane < 32) {
        const int c = lane;
        float Tc[32];
#pragma unroll
        for (int t = 0; t < 32; ++t) {
          float v = (t == c) ? 1.f : 0.f;
#pragma unroll
          for (int s4 = 0; s4 < (t + 3) / 4; ++s4) {
            float4 n4 = *(const float4*)&sm.u.gd.NM[t][s4 * 4];
            if (s4 * 4 + 0 < t) v -= n4.x * Tc[s4 * 4 + 0];
            if (s4 * 4 + 1 < t) v -= n4.y * Tc[s4 * 4 + 1];
            if (s4 * 4 + 2 < t) v -= n4.z * Tc[s4 * 4 + 2];
            if (s4 * 4 + 3 < t) v -= n4.w * Tc[s4 * 4 + 3];
          }
          Tc[t] = v;
          sm.u.gd.TM[t][c] = f2bf(v);
          __builtin_amdgcn_sched_barrier(0);
        }
      }
      { int t = lane >> 2, s4 = (lane & 3) * 4; *(uint2*)&sm.ATT[t][16 + s4] = uint2{0u, 0u}; }
    } else {
      int si, ti; bool doit = true;
      if (mixer == 1) { si = (w == 3) ? 1 : 0; ti = (w == 1) ? 0 : 1; }
      else { si = w & 1; ti = w >> 1; doit = !(si == 1 && ti == 0); }
      if (doit) {
        f32x4 acc = f32x4{0.f, 0.f, 0.f, 0.f};
#pragma unroll
        for (int kk = 0; kk < 4; ++kk)
          acc = mfma16(ldf(&sm.KA[0][0], 136, si * 16 + fr, kk * 32 + fq * 8), ldf(&sm.QA[0][0], 136, ti * 16 + fr, kk * 32 + fq * 8), acc);
        const int t = ti * 16 + fr;
        float o4[4];
        if (mixer == 0) {
#pragma unroll
          for (int j = 0; j < 4; ++j) { int s_ = si * 16 + fq * 4 + j; o4[j] = (s_ <= t) ? acc[j] : 0.f; }
        } else if (mixer == 1) {
          float Gt = sm.sc[t][0];
#pragma unroll
          for (int j = 0; j < 4; ++j) { int s_ = si * 16 + fq * 4 + j; o4[j] = (s_ <= t) ? acc[j] * __expf(Gt - sm.sc[s_][0]) : 0.f; }
        } else {
          float Mt = sm.sc[t][2];
#pragma unroll
          for (int j = 0; j < 4; ++j) { int s_ = si * 16 + fq * 4 + j; o4[j] = (s_ <= t) ? acc[j] * QS * __expf(sm.sc[s_][1] - Mt) : 0.f; }
        }
        st4(&sm.ATT[t][si * 16 + fq * 4], o4[0], o4[1], o4[2], o4[3]);
      } else {
        int t = lane >> 2, s4 = (lane & 3) * 4; *(uint2*)&sm.ATT[t][16 + s4] = uint2{0u, 0u};
      }
    }
    __syncthreads();
    if (mixer == 1) {
      f32x4 acc[2];
      acc[0] = acc[1] = f32x4{0.f, 0.f, 0.f, 0.f};
#pragma unroll
      for (int kk = 0; kk < 4; ++kk) {
        bf16x8 a = ldf(&sm.KA[0][0], 136, rt_o * 16 + fr, kk * 32 + fq * 8);
#pragma unroll
        for (int c = 0; c < 2; ++c) acc[c] = mfma16(a, ldf(&sm.ST[0][0], 136, (cp_o * 2 + c) * 16 + fr, kk * 32 + fq * 8), acc[c]);
      }
#pragma unroll
      for (int c = 0; c < 2; ++c) {
        int v = (cp_o * 2 + c) * 16 + fr;
        float y4[4];
#pragma unroll
        for (int j = 0; j < 4; ++j) {
          int t = rt_o * 16 + fq * 4 + j;
          float kg = __expf(sm.sc[t][0]);
          y4[j] = sm.sc[t][1] * (bf2f(sm.u.gd.VF[t][v]) - kg * acc[c][j]);
        }
        st4(&sm.u.gd.YT[v][rt_o * 16 + fq * 4], y4[0], y4[1], y4[2], y4[3]);
      }
      __syncthreads();
      {
        bf16x8 a = ldf(&sm.u.gd.TM[0][0], 40, rt_o * 16 + fr, fq * 8);
#pragma unroll
        for (int c = 0; c < 2; ++c) {
          int vt = cp_o * 2 + c;
          f32x4 vn = mfma16(a, ldf(&sm.u.gd.YT[0][0], 40, vt * 16 + fr, fq * 8), f32x4{0.f, 0.f, 0.f, 0.f});
          st4(&sm.XT[vt * 16 + fr][rt_o * 16 + fq * 4], vn[0], vn[1], vn[2], vn[3]);
        }
      }
      __syncthreads();
    } else if (mixer == 2) {
      int t = tid >> 3, part = tid & 7;
      float qn = 0.f;
#pragma unroll
      for (int e = 0; e < 16; ++e) qn += bf2f(sm.QA[t][part * 16 + e]) * sm.u.ml.nvec[part * 16 + e];
      float as = 0.f;
#pragma unroll
      for (int e = 0; e < 4; ++e) as += bf2f(sm.ATT[t][part * 4 + e]);
      float Mt = sm.sc[t][2];
      float den = QS * __expf(mcar - Mt) * qn + as;
      den += __shfl_xor(den, 1); den += __shfl_xor(den, 2); den += __shfl_xor(den, 4);
      if (part == 0) sm.sc[t][4] = 1.f / fmaxf(fabsf(den), __expf(-(sm.sc[t][0] + Mt)));
      __syncthreads();
    }
    {
      f32x4 acc[2];
      acc[0] = acc[1] = f32x4{0.f, 0.f, 0.f, 0.f};
      const u16* Qs = (mixer == 0) ? &sm.u.hg.QD[0][0] : &sm.QA[0][0];
#pragma unroll
      for (int kk = 0; kk < 4; ++kk) {
        bf16x8 a = ldf(Qs, 136, rt_o * 16 + fr, kk * 32 + fq * 8);
#pragma unroll
        for (int c = 0; c < 2; ++c) acc[c] = mfma16(a, ldf(&sm.ST[0][0], 136, (cp_o * 2 + c) * 16 + fr, kk * 32 + fq * 8), acc[c]);
      }
      float rs[4], fs[4];
#pragma unroll
      for (int j = 0; j < 4; ++j) {
        int t = rt_o * 16 + fq * 4 + j;
        if (mixer == 0) { rs[j] = 1.f; fs[j] = 1.f; }
        else if (mixer == 1) { rs[j] = __expf(sm.sc[t][0]); fs[j] = 1.f; }
        else { rs[j] = QS * __expf(mcar - sm.sc[t][2]); fs[j] = sm.sc[t][4]; }
      }
#pragma unroll
      for (int c = 0; c < 2; ++c)
#pragma unroll
        for (int j = 0; j < 4; ++j) acc[c][j] *= rs[j];
      {
        bf16x8 a = ldf(&sm.ATT[0][0], 40, rt_o * 16 + fr, fq * 8);
#pragma unroll
        for (int c = 0; c < 2; ++c) acc[c] = mfma16(a, ldf(&sm.XT[0][0], 40, (cp_o * 2 + c) * 16 + fr, fq * 8), acc[c]);
      }
#pragma unroll
      for (int j = 0; j < 4; ++j) {
        int t = rt_o * 16 + fq * 4 + j;
        int row = scan_row(bl, dir, pos0 + t);
        u16* dst = p.obuf + ((long)dir * TG + row) * 3072 + ocol;
#pragma unroll
        for (int c = 0; c < 2; ++c) dst[(cp_o * 2 + c) * 16 + fr] = f2bf(acc[c][j] * fs[j]);
      }
    }
    __syncthreads();
    {
      float dsc = 1.f;
      if (mixer == 1) dsc = __expf(sm.sc[31][0]);
      else if (mixer == 2) dsc = __expf(mcar - sm.sc[31][2]);
#pragma unroll
      for (int rt = 0; rt < 2; ++rt) {
        if (mixer == 0) {
          float4 d4 = *(const float4*)&sm.u.hg.dec[w * 32 + rt * 16 + fq * 4];
#pragma unroll
          for (int ct = 0; ct < 4; ++ct) { S[rt][ct][0] *= d4.x; S[rt][ct][1] *= d4.y; S[rt][ct][2] *= d4.z; S[rt][ct][3] *= d4.w; }
        } else {
#pragma unroll
          for (int ct = 0; ct < 4; ++ct) { S[rt][ct][0] *= dsc; S[rt][ct][1] *= dsc; S[rt][ct][2] *= dsc; S[rt][ct][3] *= dsc; }
        }
        bf16x8 a = ldf(&sm.KDT[0][0], 40, w * 32 + rt * 16 + fr, fq * 8);
#pragma unroll
        for (int ct = 0; ct < 4; ++ct) {
          S[rt][ct] = mfma16(a, ldf(&sm.XT[0][0], 40, ct * 16 + fr, fq * 8), S[rt][ct]);
          st4(&sm.ST[ct * 16 + fr][w * 32 + rt * 16 + fq * 4], S[rt][ct][0], S[rt][ct][1], S[rt][ct][2], S[rt][ct][3]);
        }
      }
      if (mixer == 2) {
        if (tid < 128) {
          float sum = 0.f;
#pragma unroll
          for (int e = 0; e < 32; ++e) sum += bf2f(sm.KDT[tid][e]);
          sm.u.ml.nvec[tid] = dsc * sm.u.ml.nvec[tid] + sum;
        }
        mcar = mnew;
      }
    }
    __syncthreads();
  }
}

#define MMA_MASK 7
__device__ void ph_scan(const Params& p, int l, int g, char* smem) {
  for (int u = blockIdx.x; u < 384; u += gridDim.x) {
    int mixer = u / 128;
#if MMA_MASK == 7
    scan_unit_mma(p, l, g, u, *(CSmem*)smem);
#else
    if ((MMA_MASK >> mixer) & 1) scan_unit_mma(p, l, g, u, *(CSmem*)smem);
    else scan_unit(p, l, g, u, *(ScanSmem*)smem);
#endif
  }
}

__device__ void ph_brfin(const Params& p, int l, int g) {
  const int tid = otid();
  const int lane = tid & 63;
  const int gw = blockIdx.x * 4 + (tid >> 6), nw = gridDim.x * 4;
  for (int wu = gw; wu < TG * 3; wu += nw) {
    int row = wu / 3, mixer = wu % 3;
    int pp = row % TPB;
    if (l == 1 && pp < CTX) continue;
    const u16* of = p.obuf + (long)row * 3072 + mixer * 1024 + lane * 16;
    const u16* ob = p.obuf + ((long)TG + row) * 3072 + mixer * 1024 + lane * 16;
    float o[16], t8[8];
    uint4 a0 = *(const uint4*)of, a1 = *(const uint4*)(of + 8), b0 = *(const uint4*)ob, b1 = *(const uint4*)(ob + 8);
    unpack8(a0, o); unpack8(a1, o + 8);
    unpack8(b0, t8);
#pragma unroll
    for (int e = 0; e < 8; ++e) o[e] += t8[e];
    unpack8(b1, t8);
#pragma unroll
    for (int e = 0; e < 8; ++e) o[8 + e] += t8[e];
    float ss = 0.f;
#pragma unroll
    for (int e = 0; e < 16; ++e) ss += o[e] * o[e];
    ss += __shfl_xor(ss, 1); ss += __shfl_xor(ss, 2); ss += __shfl_xor(ss, 4);
    float hd = 128.f;
    if (mixer == 2) { ss += __shfl_xor(ss, 8); hd = 256.f; }
    float rs = rsqrtf(ss / hd + 1e-6f);
    const float* on = (mixer == 0 ? p.hg_onorm : (mixer == 1 ? p.gdn_onorm : p.ml_onorm)) + l * D + lane * 16;
    int zc = mixer == 0 ? C_HGZ : (mixer == 1 ? C_GZ : C_MZ);
    const u16* zp = p.proj + (long)row * PLD + zc + lane * 16;
    float z[16];
    uint4 z0 = *(const uint4*)zp, z1 = *(const uint4*)(zp + 8);
    unpack8(z0, z); unpack8(z1, z + 8);
    float res[16];
#pragma unroll
    for (int e = 0; e < 16; ++e) res[e] = o[e] * rs * on[e] * siluf_(z[e]);
    if (mixer == 2) {
      const u16* gp = p.proj + (long)row * PLD + C_MO + lane * 16;
      uint4 g0 = *(const uint4*)gp, g1 = *(const uint4*)(gp + 8);
      unpack8(g0, z); unpack8(g1, z + 8);
#pragma unroll
      for (int e = 0; e < 16; ++e) res[e] *= sigmoidf_(z[e]);
    }
    uint4 w0, w1;
    w0.x = pack2(res[0], res[1]); w0.y = pack2(res[2], res[3]); w0.z = pack2(res[4], res[5]); w0.w = pack2(res[6], res[7]);
    w1.x = pack2(res[8], res[9]); w1.y = pack2(res[10], res[11]); w1.z = pack2(res[12], res[13]); w1.w = pack2(res[14], res[15]);
    u16* dst = p.obuf + (long)row * 3072 + mixer * 1024 + lane * 16;
    *(uint4*)dst = w0; *(uint4*)(dst + 8) = w1;
  }
}

__device__ void ph_gemm_merge(const Params& p, int l, char* smem) {
  const int tid = otid();
  const int wid = tid >> 6, lane = tid & 63, wr = wid >> 1, wc = wid & 1, fr = lane & 15, fq = lane >> 4;
  for (int t = blockIdx.x; t < 72 * 16; t += gridDim.x) {
    int nt = t / 72, mt = t % 72;
    if (l == 1 && (mt % 18) < 2) continue;
    f32x4 tot[4][2];
#pragma unroll
    for (int m = 0; m < 4; ++m)
#pragma unroll
      for (int n = 0; n < 2; ++n) tot[m][n] = f32x4{0.f, 0.f, 0.f, 0.f};
    for (int i = 0; i < 3; ++i) {
      f32x4 acc[4][2];
#pragma unroll
      for (int m = 0; m < 4; ++m)
#pragma unroll
        for (int n = 0; n < 2; ++n) acc[m][n] = f32x4{0.f, 0.f, 0.f, 0.f};
      gemm_kloop<2>(p.obuf + (long)mt * 128 * 3072 + i * 1024, 3072, p.WbrT + ((long)i * D + nt * 64) * D, D, D, smem, acc);
#pragma unroll
      for (int m = 0; m < 4; ++m)
#pragma unroll
        for (int n = 0; n < 2; ++n)
#pragma unroll
          for (int j = 0; j < 4; ++j) {
            int row = mt * 128 + wr * 64 + m * 16 + fq * 4 + j, col = nt * 64 + wc * 32 + n * 16 + fr;
            float gv = bf2f(p.proj[(long)row * PLD + C_GATE + i * 1024 + col]);
            tot[m][n][j] += sigmoidf_(gv) * acc[m][n][j];
          }
    }
#pragma unroll
    for (int m = 0; m < 4; ++m)
#pragma unroll
      for (int n = 0; n < 2; ++n)
#pragma unroll
        for (int j = 0; j < 4; ++j) {
          int row = mt * 128 + wr * 64 + m * 16 + fq * 4 + j, col = nt * 64 + wc * 32 + n * 16 + fr;
          p.hbuf[(long)row * D + col] = f2bf(tot[m][n][j]);
        }
  }
}

__device__ void ph_gemm_out(const Params& p, int l, int g, char* smem) {
  const int tid = otid();
  const int wid = tid >> 6, lane = tid & 63, wr = wid >> 1, wc = wid & 1, fr = lane & 15, fq = lane >> 4;
  for (int t = blockIdx.x; t < 72 * 8; t += gridDim.x) {
    int nt = t / 72, mt = t % 72;
    if (l == 1 && (mt % 18) < 2) continue;
    f32x4 acc[4][4];
#pragma unroll
    for (int m = 0; m < 4; ++m)
#pragma unroll
      for (int n = 0; n < 4; ++n) acc[m][n] = f32x4{0.f, 0.f, 0.f, 0.f};
    gemm_kloop<4>(p.hbuf + (long)mt * 128 * D, D, p.WoT + (long)nt * 128 * D, D, D, smem, acc);
#pragma unroll
    for (int m = 0; m < 4; ++m)
#pragma unroll
      for (int j = 0; j < 4; ++j) {
        int row = mt * 128 + wr * 64 + m * 16 + fq * 4 + j;
        int bl = row / TPB, pp = row % TPB, b = g * GB + bl;
        const float* src; float* dst; int mrow;
        if (pp < CTX) { src = p.ctx + ((long)b * CTX + pp) * D; dst = p.ctxs + ((long)b * CTX + pp) * D; mrow = 16; }
        else { long off = ((long)b * SEQ + (pp - CTX)) * D; src = (l == 0 ? p.x : p.out) + off; dst = p.out + off; mrow = b; }
        const float* gt = p.mod + ((long)l * 17 + mrow) * 3072 + 2048;
#pragma unroll
        for (int n = 0; n < 4; ++n) {
          int col = nt * 128 + wc * 64 + n * 16 + fr;
          dst[col] = src[col] + gt[col] * acc[m][n][j];
        }
      }
  }
}

__device__ void ph_final(const Params& p) {
  const int tid = otid();
  const int lane = tid & 63;
  const int gw = blockIdx.x * 4 + (tid >> 6), nw = gridDim.x * 4;
  for (int row = gw; row < NB * SEQ; row += nw) {
    float4* src = (float4*)(p.out + (long)row * D);
    float4 v[4]; float ss = 0.f;
#pragma unroll
    for (int i = 0; i < 4; ++i) {
      v[i] = src[lane + 64 * i];
      ss += v[i].x * v[i].x + v[i].y * v[i].y + v[i].z * v[i].z + v[i].w * v[i].w;
    }
    ss = wave_sum(ss);
    float rs = rsqrtf(ss * (1.f / D) + 1e-6f);
#pragma unroll
    for (int i = 0; i < 4; ++i) {
      float4 g4 = ((const float4*)p.final_g)[lane + 64 * i];
      float4 o; o.x = v[i].x * rs * g4.x; o.y = v[i].y * rs * g4.y; o.z = v[i].z * rs * g4.z; o.w = v[i].w * rs * g4.w;
      src[lane + 64 * i] = o;
    }
  }
}


#define XB_TMO      128
#define XB_XCNT(j)  (256  + 64 * (j))
#define XB_XSUB(j)  (1280 + 64 * (j))
#define XB_XGEN(j)  (2304 + 64 * (j))
#define XB_TOP      3328
#define XB_TOPGEN   3392
#define XCD_BAR_WORDS 3456
#define XB_SPIN_CAP (1u << 22)
#define LAS __attribute__((address_space(3)))
__device__ __forceinline__ unsigned xb_ld(unsigned* p) { return __hip_atomic_load(p, __ATOMIC_RELAXED, __HIP_MEMORY_SCOPE_AGENT); }
__device__ __forceinline__ unsigned xb_add(unsigned* p, unsigned v) { return __hip_atomic_fetch_add(p, v, __ATOMIC_RELAXED, __HIP_MEMORY_SCOPE_AGENT); }
__device__ __forceinline__ unsigned xb_xcc_id() { return (unsigned)__builtin_amdgcn_s_getreg((3 << 11) | 20) & 0xFu; }
#define XB_SPIN(cond, bar) do { unsigned _sp = 0; while (cond) { __builtin_amdgcn_s_sleep(1); \
    if ((++_sp & 255u) == 0u) { if (xb_ld(&(bar)[XB_TMO])) break; if (_sp > XB_SPIN_CAP) { atomicAdd(&(bar)[XB_TMO], 1u); break; } } } } while (0)
struct XcdBarrier { unsigned* bar; unsigned x; volatile LAS unsigned* st; };
__device__ __forceinline__ XcdBarrier xcd_barrier_post(unsigned* bar, volatile LAS unsigned* st) {
  XcdBarrier b; b.bar = bar; b.x = xb_xcc_id(); b.st = st;
  if (threadIdx.x == 0) (void)xb_add(&bar[XB_XCNT(b.x)], 1u);
  return b;
}
__device__ __forceinline__ void xcd_barrier_complete(unsigned* bar, unsigned x, unsigned& nloc, unsigned& nx) {
  const unsigned G = gridDim.x * gridDim.y * gridDim.z;
  unsigned sum, cnt, mine, sp = 0u;
  for (;;) {
    sum = 0u; cnt = 0u; mine = 0u;
#pragma unroll
    for (unsigned j = 0; j < 16; ++j) { const unsigned c = xb_ld(&bar[XB_XCNT(j)]); sum += c; cnt += (c > 0u) ? 1u : 0u; mine = (j == x) ? c : mine; }
    if (sum == G) break;
    __builtin_amdgcn_s_sleep(1);
    if ((++sp & 255u) == 0u) { if (xb_ld(&bar[XB_TMO])) break; if (sp > XB_SPIN_CAP) { atomicAdd(&bar[XB_TMO], 1u); break; } }
  }
  nloc = mine > 0u ? mine : 1u; nx = cnt > 0u ? cnt : 1u;
}
__device__ __forceinline__ void xcd_barrier(const XcdBarrier& b) {
  asm volatile("s_waitcnt vmcnt(0)" ::: "memory");
  __syncthreads();
  if (threadIdx.x == 0) {
    unsigned* bar = b.bar;
    __builtin_amdgcn_s_waitcnt(0);
    unsigned nloc = b.st[0], nx = b.st[1];
    if (nloc == 0u) { xcd_barrier_complete(bar, b.x, nloc, nx); b.st[0] = nloc; b.st[1] = nx; }
    const unsigned old = xb_add(&bar[XB_XSUB(b.x)], 1u);
    const unsigned gen = old / nloc;
    if (old + 1u == (gen + 1u) * nloc) {
      __builtin_amdgcn_fence(__ATOMIC_RELEASE, "agent");
      asm volatile("s_waitcnt vmcnt(0)" ::: "memory");
      const unsigned og = xb_add(&bar[XB_TOP], 1u);
      const unsigned tg = og / nx;
      if (og + 1u == (tg + 1u) * nx) xb_add(&bar[XB_TOPGEN], 1u);
      else XB_SPIN(xb_ld(&bar[XB_TOPGEN]) == tg, bar);
      __builtin_amdgcn_fence(__ATOMIC_ACQUIRE, "agent");
      xb_add(&bar[XB_XGEN(b.x)], 1u);
      asm volatile("s_waitcnt vmcnt(0)" ::: "memory");
    } else {
      XB_SPIN(xb_ld(&bar[XB_XGEN(b.x)]) == gen, bar);
      __builtin_amdgcn_fence(__ATOMIC_ACQUIRE, "agent");
      asm volatile("s_waitcnt vmcnt(0)" ::: "memory");
    }
  }
  __syncthreads();
}

constexpr int NSTEPS = 2 + 24 + 1 + 24 + 1;

__device__ void run_step(const Params& p, int step, char* smem) {
  if (step == 0) { ph_convert(p, 0, smem); ph_prep_small(p); return; }
  if (step == 1) { ph_mod(p, smem); return; }
  if (step == 26) { ph_convert(p, 1, smem); return; }
  if (step == NSTEPS - 1) { ph_final(p); return; }
  int l, s;
  if (step < 26) { l = 0; s = step - 2; } else { l = 1; s = step - 27; }
  int g = s / 6, k = s % 6;
  switch (k) {
    case 0: ph_prenorm(p, l, g); break;
    case 1: ph_gemm_in(p, smem); break;
    case 2: ph_scan(p, l, g, smem); break;
    case 3: ph_brfin(p, l, g); break;
    case 4: ph_gemm_merge(p, l, smem); break;
    case 5: ph_gemm_out(p, l, g, smem); break;
  }
}

#if !COOP
__global__ void __launch_bounds__(256, 2) k_step(Params p, int step) {
  __shared__ __attribute__((aligned(16))) char smem[sizeof(CSmem) > sizeof(ScanSmem) ? sizeof(CSmem) : sizeof(ScanSmem)];
  run_step(p, step, smem);
}
#else
__global__ void __launch_bounds__(256, 2) k_mega(Params p) {
  __shared__ __attribute__((aligned(16))) char smem[sizeof(CSmem) > sizeof(ScanSmem) ? sizeof(CSmem) : sizeof(ScanSmem)];
  __shared__ uint4 xb_words;
  cg::grid_group grid = cg::this_grid();
  if (threadIdx.x == 0) xb_words = make_uint4(0u, 0u, 0u, 0u);
  __syncthreads();
  XcdBarrier xb = xcd_barrier_post(p.bar, (volatile LAS unsigned*)&xb_words);
#define GSYNC() xcd_barrier(xb)
  ph_prep_small(p);
#pragma unroll 1
  for (int l = 0; l < 2; ++l) {
    ph_convert(p, l, smem);
    if (l == 0) { grid.sync(); ph_mod(p, smem); }
    GSYNC();
#pragma unroll 1
    for (int g = 0; g < NGRP; ++g) {
      ph_prenorm(p, l, g); GSYNC();
      ph_gemm_in(p, smem); GSYNC();
      ph_conv(p, l); GSYNC();
      ph_scan(p, l, g, smem); GSYNC();
      ph_brfin(p, l, g); GSYNC();
      ph_gemm_merge(p, l, smem); GSYNC();
      ph_gemm_out(p, l, g, smem); GSYNC();
    }
  }
  ph_final(p);
}
#endif

extern "C" void kernel_launch(void* const* d_in, const int* in_sizes, int n_in, void* d_out, int out_size, void* d_ws,
                              size_t ws_size, hipStream_t stream) {
  Params p{};
  p.x = (const float*)d_in[0]; p.c = (const float*)d_in[1]; p.ctx = (const float*)d_in[2]; p.c_ctx = (const float*)d_in[3];
  p.ada_w = (const float*)d_in[4]; p.ada_b = (const float*)d_in[5]; p.norm_g = (const float*)d_in[6]; p.w_in = (const float*)d_in[7];
  p.hg_lb = (const float*)d_in[8]; p.hg_onorm = (const float*)d_in[9]; p.gdn_conv = (const float*)d_in[10];
  p.gdn_a_log = (const float*)d_in[11]; p.gdn_dt_bias = (const float*)d_in[12]; p.gdn_onorm = (const float*)d_in[13];
  p.ml_i_bias = (const float*)d_in[14]; p.ml_f_bias = (const float*)d_in[15]; p.ml_onorm = (const float*)d_in[16];
  p.w_branch = (const float*)d_in[17]; p.w_out = (const float*)d_in[18]; p.final_g = (const float*)d_in[19];
  p.out = (float*)d_out;
  char* ws = (char*)d_ws;
  size_t off = 0;
  auto take = [&](size_t bytes) { char* r = ws + off; off += (bytes + 255) & ~(size_t)255; return r; };
  p.WinT = (u16*)take((size_t)NPAD * D * 2);
  p.WbrT = (u16*)take((size_t)3 * D * D * 2);
  p.WoT = (u16*)take((size_t)D * D * 2);
  p.hbuf = (u16*)take((size_t)TG * D * 2);
  p.proj = (u16*)take((size_t)TG * PLD * 2);
  p.obuf = (u16*)take((size_t)2 * TG * 3072 * 2);
  p.mod = (float*)take((size_t)2 * 17 * 3072 * 4);
  p.lb = (float*)take((size_t)2 * D * 4);
  p.silc = (float*)take((size_t)17 * D * 4);
  p.gates = (float*)take((size_t)TG * GLD * 4);
  p.ctxs = (float*)take((size_t)NB * CTX * D * 4);
  p.bar = (unsigned*)take((size_t)XCD_BAR_WORDS * 4);
  if (off > ws_size) { fprintf(stderr, "workspace too small: need %zu have %zu\n", off, ws_size); return; }

  static int grid_blocks = 0;
  if (!grid_blocks) {
    int dev = 0, cus = 0, per_cu = 0;
    hipGetDevice(&dev);
    hipDeviceGetAttribute(&cus, hipDeviceAttributeMultiprocessorCount, dev);
#if COOP
    hipOccupancyMaxActiveBlocksPerMultiprocessor(&per_cu, k_mega, 256, 0);
#else
    hipOccupancyMaxActiveBlocksPerMultiprocessor(&per_cu, k_step, 256, 0);
#endif
    if (per_cu < 1) per_cu = 1;
    if (per_cu > 2) per_cu = 2;
    grid_blocks = cus * per_cu;
  }
#if COOP
  hipMemsetAsync(p.bar, 0, (size_t)XCD_BAR_WORDS * 4, stream);
  void* args[] = {&p};
  hipError_t e = hipLaunchCooperativeKernel((void*)k_mega, dim3(grid_blocks), dim3(256), args, 0, stream);
  if (e != hipSuccess) fprintf(stderr, "cooperative launch failed: %s (grid %d)\n", hipGetErrorString(e), grid_blocks);
#else
  for (int s = 0; s < NSTEPS; ++s) k_step<<<grid_blocks, 256, 0, stream>>>(p, s);
#endif
}
```

```cpp
#include <hip/hip_runtime.h>
#include <hip/hip_bf16.h>
#include <hip/hip_cooperative_groups.h>
#include <cstdio>
namespace cg = cooperative_groups;

#define REP_PRE 1
#define REP_GIN 1
#define REP_SCAN 1
#define REP_MRG 1
#define REP_SYNC 0
#ifndef COOP
#define COOP 1
#endif

typedef unsigned short u16;
using bf16x8 = __attribute__((ext_vector_type(8))) short;
using f32x4 = __attribute__((ext_vector_type(4))) float;

constexpr int D = 1024;
constexpr int NB = 16;
constexpr int SEQ = 2048;
constexpr int CTX = 256;
constexpr int TPB = SEQ + CTX;
constexpr int GB = 4;
constexpr int NGRP = NB / GB;
constexpr int TG = GB * TPB;
constexpr int IN_DIM = 16432;
constexpr int NPAD = 16512;
constexpr int PLD = 16384;
constexpr int GLD = 64;
constexpr int TC = 32;
constexpr int C_HGQ = 0, C_HGI = 1024, C_HGF = 2048, C_HGZ = 4096;
constexpr int C_GQ = 5120, C_GK = 6144, C_GV = 7168, C_GZ = 8192;
constexpr int C_MQ = 9216, C_MK = 9728, C_MV = 10240, C_MO = 11264, C_MZ = 12288;
constexpr int C_GATE = 13312;

struct Params {
  const float *x, *c, *ctx, *c_ctx, *ada_w, *ada_b, *norm_g, *w_in, *hg_lb, *hg_onorm, *gdn_conv,
      *gdn_a_log, *gdn_dt_bias, *gdn_onorm, *ml_i_bias, *ml_f_bias, *ml_onorm, *w_branch, *w_out, *final_g;
  float* out;
  u16 *WinT, *WbrT, *WoT, *hbuf, *proj, *obuf;
  float *mod, *lb, *silc, *gates, *ctxs;
  unsigned* bar;
};

typedef __bf16 bf16v2 __attribute__((ext_vector_type(2)));
typedef float f32v2 __attribute__((ext_vector_type(2)));
__device__ __forceinline__ unsigned pack2(float a, float b) {
  f32v2 v = {a, b};
  return __builtin_bit_cast(unsigned, __builtin_convertvector(v, bf16v2));
}
__device__ __forceinline__ u16 f2bf(float f) { return (u16)(pack2(f, 0.f) & 0xffffu); }
__device__ __forceinline__ float bf2f(u16 h) { return __uint_as_float(((unsigned)h) << 16); }
__device__ __forceinline__ float sigmoidf_(float x) { return 1.f / (1.f + __expf(-x)); }
__device__ __forceinline__ float siluf_(float x) { return x / (1.f + __expf(-x)); }
__device__ __forceinline__ float softplusf_(float y) { return fmaxf(y, 0.f) + log1pf(__expf(-fabsf(y))); }
__device__ __forceinline__ float wave_sum(float v) {
#pragma unroll
  for (int o = 32; o >= 1; o >>= 1) v += __shfl_xor(v, o);
  return v;
}
__device__ __forceinline__ void unpack8(const uint4& u, float* f) {
  f[0] = __uint_as_float(u.x << 16); f[1] = __uint_as_float(u.x & 0xffff0000u);
  f[2] = __uint_as_float(u.y << 16); f[3] = __uint_as_float(u.y & 0xffff0000u);
  f[4] = __uint_as_float(u.z << 16); f[5] = __uint_as_float(u.z & 0xffff0000u);
  f[6] = __uint_as_float(u.w << 16); f[7] = __uint_as_float(u.w & 0xffff0000u);
}

__device__ __forceinline__ int otid() { int t = threadIdx.x; asm volatile("" : "+v"(t)); return t; }
__device__ __forceinline__ int win_src_col(int np) {
  if (np < 9216) return np;
  if (np < 13312) return np + 32;
  if (np < 16384) return np + 48;
  if (np < 16416) return 9216 + (np - 16384);
  if (np < 16432) return 13344 + (np - 16416);
  return -1;
}

__device__ void ph_convert(const Params& p, int l, char* smem) {
  float (*tile)[65] = (float (*)[65])smem;
  const int tid = otid();
  for (int t = blockIdx.x; t < 5152; t += gridDim.x) {
    const float* src; long sld; u16* dst; int n0, k0, kind;
    if (t < 4128) { kind = 0; n0 = (t / 16) * 64; k0 = (t % 16) * 64; src = p.w_in + (long)l * D * IN_DIM; sld = IN_DIM; dst = p.WinT; }
    else if (t < 4896) { int u = t - 4128; int i = u / 256; u %= 256; kind = 1; n0 = (u / 16) * 64; k0 = (u % 16) * 64;
      src = p.w_branch + ((long)l * 3 + i) * D * D; sld = D; dst = p.WbrT + (long)i * D * D; }
    else { int u = t - 4896; kind = 1; n0 = (u / 16) * 64; k0 = (u % 16) * 64; src = p.w_out + (long)l * D * D; sld = D; dst = p.WoT; }
#pragma unroll 4
    for (int i = 0; i < 16; ++i) {
      int kk = (tid >> 6) + 4 * i, nn = tid & 63;
      int np = n0 + nn;
      int ns = kind == 0 ? win_src_col(np) : np;
      tile[kk][nn] = ns >= 0 ? src[(long)(k0 + kk) * sld + ns] : 0.f;
    }
    __syncthreads();
#pragma unroll 4
    for (int i = 0; i < 16; ++i) {
      int nn = (tid >> 6) + 4 * i, kk = tid & 63;
      dst[(long)(n0 + nn) * D + k0 + kk] = f2bf(tile[kk][nn]);
    }
    __syncthreads();
  }
}

__device__ void ph_prep_small(const Params& p) {
  int gt = blockIdx.x * blockDim.x + otid(), gs = gridDim.x * blockDim.x;
  for (int i = gt; i < 17 * D + 2 * D; i += gs) {
    if (i < 16 * D) p.silc[i] = siluf_(p.c[i]);
    else if (i < 17 * D) p.silc[i] = siluf_(p.c_ctx[i - 16 * D]);
    else {
      int j = i - 17 * D;
      if (j < D) p.lb[j] = 0.f;
      else { int ch = j - D; p.lb[j] = sigmoidf_(p.hg_lb[D + ch] - p.hg_lb[ch]); }
    }
  }
}

__device__ void ph_mod(const Params& p, char* smem) {
  float (*red)[17][64] = (float (*)[17][64])smem;
  const int tid = otid();
  const int kq = __builtin_amdgcn_readfirstlane(tid >> 6), cc = tid & 63;
  for (int u = blockIdx.x; u < 96; u += gridDim.x) {
    int l = u / 48, col = (u % 48) * 64 + cc;
    float acc[17];
#pragma unroll
    for (int r = 0; r < 17; ++r) acc[r] = 0.f;
    const float* w = p.ada_w + (long)l * D * 3072 + col;
    for (int k = kq * 256; k < kq * 256 + 256; ++k) {
      float wv = w[(long)k * 3072];
#pragma unroll
      for (int r = 0; r < 17; ++r) acc[r] += p.silc[r * D + k] * wv;
    }
#pragma unroll
    for (int r = 0; r < 17; ++r) red[kq][r][cc] = acc[r];
    __syncthreads();
    for (int i = tid; i < 17 * 64; i += 256) {
      int r = i / 64, c2 = i % 64;
      int colo = (u % 48) * 64 + c2;
      float s = red[0][r][c2] + red[1][r][c2] + red[2][r][c2] + red[3][r][c2] + p.ada_b[l * 3072 + colo];
      p.mod[((long)l * 17 + r) * 3072 + colo] = s;
    }
    __syncthreads();
  }
}

__device__ void ph_prenorm(const Params& p, int l, int g) {
  const int tid = otid();
  const int lane = tid & 63;
  const int gw = blockIdx.x * 4 + (tid >> 6), nw = gridDim.x * 4;
  for (int row = gw; row < TG; row += nw) {
    int bl = row / TPB, pp = row % TPB, b = g * GB + bl;
    const float* src; int mrow;
    if (pp < CTX) { src = (l == 0 ? p.ctx : p.ctxs) + ((long)b * CTX + pp) * D; mrow = 16; }
    else { src = (l == 0 ? p.x : p.out) + ((long)b * SEQ + (pp - CTX)) * D; mrow = b; }
    const float* md = p.mod + ((long)l * 17 + mrow) * 3072;
    float4 v[4]; float ss = 0.f;
#pragma unroll
    for (int i = 0; i < 4; ++i) {
      v[i] = ((const float4*)src)[lane + 64 * i];
      ss += v[i].x * v[i].x + v[i].y * v[i].y + v[i].z * v[i].z + v[i].w * v[i].w;
    }
    ss = wave_sum(ss);
    float rs = rsqrtf(ss * (1.f / D) + 1e-6f);
#pragma unroll
    for (int i = 0; i < 4; ++i) {
      int idx = (lane + 64 * i) * 4;
      float4 g4 = *(const float4*)(p.norm_g + l * D + idx);
      float4 sh = *(const float4*)(md + idx);
      float4 sc = *(const float4*)(md + D + idx);
      float h0 = v[i].x * rs * g4.x * (1.f + sc.x) + sh.x;
      float h1 = v[i].y * rs * g4.y * (1.f + sc.y) + sh.y;
      float h2 = v[i].z * rs * g4.z * (1.f + sc.z) + sh.z;
      float h3 = v[i].w * rs * g4.w * (1.f + sc.w) + sh.w;
      uint2 o; o.x = pack2(h0, h1); o.y = pack2(h2, h3);
      *(uint2*)(p.hbuf + (long)row * D + idx) = o;
    }
  }
}

template <int NF>
__device__ __forceinline__ void gemm_kloop(const u16* Ag, long lda, const u16* Bg, long ldb, int K, char* smem, f32x4 (&acc)[4][NF]) {
  const int tid = otid();
  const int wid = tid >> 6, lane = tid & 63, wr = wid >> 1, wc = wid & 1, fr = lane & 15, fq = lane >> 4;
  constexpr int ASZ = 128 * 128;
  constexpr int BSZ = NF * 32 * 128;
  const int lrow = tid >> 3, cs = tid & 7;
  const int cg_ = cs ^ ((lrow >> 1) & 7);
  const u16* Ap = Ag + (long)lrow * lda + cg_ * 8;
  const u16* Bp = Bg + (long)lrow * ldb + cg_ * 8;
  const int nt = K / 64;
#define GK_ISSUE(T, S)                                                                                                   \
  {                                                                                                                      \
    char* _SA = smem + (S) * (ASZ + BSZ); char* _SB = _SA + ASZ;                                                         \
    _Pragma("unroll") for (int _i = 0; _i < 4; ++_i)                                                                     \
      __builtin_amdgcn_global_load_lds((const unsigned*)(Ap + (long)_i * 32 * lda + (T) * 64),                           \
                                       (__attribute__((address_space(3))) unsigned*)(_SA + _i * 4096 + tid * 16), 16, 0, 0); \
    _Pragma("unroll") for (int _i = 0; _i < NF; ++_i)                                                                    \
      __builtin_amdgcn_global_load_lds((const unsigned*)(Bp + (long)_i * 32 * ldb + (T) * 64),                           \
                                       (__attribute__((address_space(3))) unsigned*)(_SB + _i * 4096 + tid * 16), 16, 0, 0); \
  }
  GK_ISSUE(0, 0)
  const int swz = (fr >> 1) & 7;
  for (int t = 0; t < nt; ++t) {
    asm volatile("s_waitcnt vmcnt(0)" ::: "memory");
    __syncthreads();
    if (t + 1 < nt) GK_ISSUE(t + 1, (t + 1) & 1)
    const char* SA = smem + (t & 1) * (ASZ + BSZ); const char* SB = SA + ASZ;
#pragma unroll
    for (int kk = 0; kk < 2; ++kk) {
      bf16x8 At[4], Bl[NF];
      const int co = ((kk * 4 + fq) ^ swz) * 16;
#pragma unroll
      for (int m = 0; m < 4; ++m) At[m] = *(const bf16x8*)(SA + (wr * 64 + m * 16 + fr) * 128 + co);
#pragma unroll
      for (int n = 0; n < NF; ++n) Bl[n] = *(const bf16x8*)(SB + (wc * NF * 16 + n * 16 + fr) * 128 + co);
#pragma unroll
      for (int m = 0; m < 4; ++m)
#pragma unroll
        for (int n = 0; n < NF; ++n) acc[m][n] = __builtin_amdgcn_mfma_f32_16x16x32_bf16(Bl[n], At[m], acc[m][n], 0, 0, 0);
    }
  }
#undef GK_ISSUE
}

__device__ void ph_gemm_in(const Params& p, char* smem) {
  const int tid = otid();
  const int wid = tid >> 6, lane = tid & 63, wr = wid >> 1, wc = wid & 1, fr = lane & 15, fq = lane >> 4;
  for (int t = blockIdx.x; t < 72 * 129; t += gridDim.x) {
    int nt = t / 72, mt = t % 72;
    f32x4 acc[4][4];
#pragma unroll
    for (int m = 0; m < 4; ++m)
#pragma unroll
      for (int n = 0; n < 4; ++n) acc[m][n] = f32x4{0.f, 0.f, 0.f, 0.f};
    gemm_kloop<4>(p.hbuf + (long)mt * 128 * D, D, p.WinT + (long)nt * 128 * D, D, D, smem, acc);
    if (nt < 128) {
      u16* dbase; long dld; int cb;
      if (nt >= 40 && nt < 64) { dbase = p.obuf + (long)TG * 3072; dld = 3072; cb = (nt - 40) * 128; }
      else { dbase = p.proj; dld = PLD; cb = nt * 128; }
#pragma unroll
      for (int m = 0; m < 4; ++m) {
        int row = mt * 128 + wr * 64 + m * 16 + fr;
#pragma unroll
        for (int n = 0; n < 4; ++n) {
          int col = cb + wc * 64 + n * 16 + fq * 4;
          uint2 o; o.x = pack2(acc[m][n][0], acc[m][n][1]); o.y = pack2(acc[m][n][2], acc[m][n][3]);
          *(uint2*)(dbase + (long)row * dld + col) = o;
        }
      }
    } else if (wc == 0) {
#pragma unroll
      for (int m = 0; m < 4; ++m) {
        int row = mt * 128 + wr * 64 + m * 16 + fr;
#pragma unroll
        for (int n = 0; n < 4; ++n) {
          int col = n * 16 + fq * 4;
          *(float4*)(p.gates + (long)row * GLD + col) = float4{acc[m][n][0], acc[m][n][1], acc[m][n][2], acc[m][n][3]};
        }
      }
    }
  }
}

__device__ void ph_conv(const Params& p, int l) {
  const int tid = otid();
  const int lane = tid & 63;
  const int gw = blockIdx.x * 4 + (tid >> 6), nw = gridDim.x * 4;
  const u16* stg = p.obuf + (long)TG * 3072;
  for (int task = gw; task < TG * 8; task += nw) {
    int row = task >> 3, h = task & 7;
    int bl = row / TPB, t = row % TPB;
    int part = lane >> 4, c8 = lane & 15;
    int chn = part * 1024 + h * 128 + c8 * 8;
    float val[8];
#pragma unroll
    for (int e = 0; e < 8; ++e) val[e] = 0.f;
    if (part < 3) {
      const float* cwb = p.gdn_conv + (long)l * 9 * 3072 + chn;
      if (t < CTX) {
#pragma unroll
        for (int jj = 0; jj < 3; ++jj) {
          int tt = t + jj - 1;
          if (tt >= 0 && tt < CTX) {
            uint4 raw = *(const uint4*)(stg + (long)(bl * TPB + tt) * 3072 + chn);
            float xv[8]; unpack8(raw, xv);
            float4 w0 = *(const float4*)(cwb + (3 + jj) * 3072), w1 = *(const float4*)(cwb + (3 + jj) * 3072 + 4);
            val[0] += xv[0] * w0.x; val[1] += xv[1] * w0.y; val[2] += xv[2] * w0.z; val[3] += xv[3] * w0.w;
            val[4] += xv[4] * w1.x; val[5] += xv[5] * w1.y; val[6] += xv[6] * w1.z; val[7] += xv[7] * w1.w;
          }
        }
      } else {
        int lt = t - CTX, rr0 = lt >> 6, cc0 = lt & 63;
#pragma unroll
        for (int ii = 0; ii < 3; ++ii) {
          int rr = rr0 + ii - 1;
          if (rr < 0 || rr >= 32) continue;
#pragma unroll
          for (int jj = 0; jj < 3; ++jj) {
            int cc = cc0 + jj - 1;
            if (cc < 0 || cc >= 64) continue;
            uint4 raw = *(const uint4*)(stg + (long)(bl * TPB + CTX + rr * 64 + cc) * 3072 + chn);
            float xv[8]; unpack8(raw, xv);
            float4 w0 = *(const float4*)(cwb + (ii * 3 + jj) * 3072), w1 = *(const float4*)(cwb + (ii * 3 + jj) * 3072 + 4);
            val[0] += xv[0] * w0.x; val[1] += xv[1] * w0.y; val[2] += xv[2] * w0.z; val[3] += xv[3] * w0.w;
            val[4] += xv[4] * w1.x; val[5] += xv[5] * w1.y; val[6] += xv[6] * w1.z; val[7] += xv[7] * w1.w;
          }
        }
      }
    }
    float ss = 0.f;
#pragma unroll
    for (int e = 0; e < 8; ++e) { val[e] = siluf_(val[e]); ss += val[e] * val[e]; }
    ss += __shfl_xor(ss, 1); ss += __shfl_xor(ss, 2); ss += __shfl_xor(ss, 4); ss += __shfl_xor(ss, 8);
    float scl = 1.f;
    if (part == 0) scl = rsqrtf(ss + 1e-6f) * 0.08838834764831845f;
    else if (part == 1) scl = rsqrtf(ss + 1e-6f);
    if (part < 3) {
      uint4 o;
      o.x = pack2(val[0] * scl, val[1] * scl); o.y = pack2(val[2] * scl, val[3] * scl);
      o.z = pack2(val[4] * scl, val[5] * scl); o.w = pack2(val[6] * scl, val[7] * scl);
      *(uint4*)(p.proj + (long)row * PLD + C_GQ + chn) = o;
    }
  }
}

struct ScanSmem {
  float q[TC][128];
  float k[TC][128];
  float f[TC][128];
  float v[TC][64];
  float sc[TC][4];
};

__device__ __forceinline__ int scan_row(int bl, int dir, int pos) {
  int t;
  if (pos < CTX) t = dir ? (CTX - 1 - pos) : pos;
  else { int u = pos - CTX; t = CTX + (dir ? (SEQ - 1 - u) : u); }
  return bl * TPB + t;
}

__device__ void scan_unit(const Params& p, int l, int g, int u, ScanSmem& sm) {
  const int tid = otid(), lane = tid & 63, w = tid >> 6;
  const int j = lane & 15, gq = lane >> 4;
  const int mixer = u / 128, r = u % 128;
  int bl, h, dir, vs;
  bl = r / 32;
  if (mixer < 2) { h = (r % 32) / 4; dir = (r % 4) / 2; vs = r % 2; }
  else { h = (r % 32) / 8; dir = (r % 8) / 4; vs = r % 4; }
  int cq, ck, cv, ocol;
  if (mixer == 0) { cq = C_HGQ + h * 128; ck = C_HGF + dir * 1024 + h * 128; cv = C_HGI + h * 128 + vs * 64; ocol = h * 128 + vs * 64; }
  else if (mixer == 1) { cq = C_GQ + h * 128; ck = C_GK + h * 128; cv = C_GV + h * 128 + vs * 64; ocol = 1024 + h * 128 + vs * 64; }
  else { cq = C_MQ + h * 128; ck = C_MK + h * 128; cv = C_MV + h * 256 + vs * 64; ocol = 2048 + h * 256 + vs * 64; }

  float S[32];
#pragma unroll
  for (int i = 0; i < 32; ++i) S[i] = 0.f;
  float n0 = 0.f, n1 = 0.f;
  float mstate = 0.f;
  float gA = 0.f, gDt = 0.f, ibias = 0.f, fbias = 0.f;
  if (mixer == 1) { gA = -__expf(p.gdn_a_log[l * 16 + dir * 8 + h]); gDt = p.gdn_dt_bias[l * 16 + dir * 8 + h]; }
  if (mixer == 2) { ibias = p.ml_i_bias[l * 8 + dir * 4 + h]; fbias = p.ml_f_bias[l * 8 + dir * 4 + h]; }

  __syncthreads();
  if (mixer == 1) {
    float* cw = &sm.f[0][0];
    for (int i = tid; i < 9 * 320; i += 256) {
      int tap = i / 320, lc = i % 320;
      int ch = lc < 128 ? (h * 128 + lc) : (lc < 256 ? (1024 + h * 128 + lc - 128) : (2048 + h * 128 + vs * 64 + lc - 256));
      cw[i] = p.gdn_conv[((long)l * 9 + tap) * 3072 + ch];
    }
    __syncthreads();
  }

  for (int ch0 = 0; ch0 < TPB / TC; ++ch0) {
    const int pos0 = ch0 * TC;
    const bool is_ctx = pos0 < CTX;
    __syncthreads();
    for (int idx = tid; idx < TC * 40; idx += 256) {
      int tok = idx / 40, cgp = idx % 40;
      int row = scan_row(bl, dir, pos0 + tok);
      int col, lc;
      if (cgp < 16) { col = cq + cgp * 8; lc = cgp * 8; }
      else if (cgp < 32) { col = ck + (cgp - 16) * 8; lc = 128 + (cgp - 16) * 8; }
      else { col = cv + (cgp - 32) * 8; lc = 256 + (cgp - 32) * 8; }
      float val[8];
      if (mixer != 1) {
        uint4 raw = *(const uint4*)(p.proj + (long)row * PLD + col);
        unpack8(raw, val);
      } else {
        const float* cw = &sm.f[0][0];
#pragma unroll
        for (int e = 0; e < 8; ++e) val[e] = 0.f;
        int t = row - bl * TPB;
        if (is_ctx) {
#pragma unroll
          for (int jj = 0; jj < 3; ++jj) {
            int tt = t + jj - 1;
            if (tt >= 0 && tt < CTX) {
              uint4 raw = *(const uint4*)(p.proj + (long)(bl * TPB + tt) * PLD + col);
              float xv[8]; unpack8(raw, xv);
              const float* wv = cw + (3 + jj) * 320 + lc;
#pragma unroll
              for (int e = 0; e < 8; ++e) val[e] += xv[e] * wv[e];
            }
          }
        } else {
          int lt = t - CTX, rr0 = lt >> 6, cc0 = lt & 63;
#pragma unroll
          for (int ii = 0; ii < 3; ++ii) {
            int rr = rr0 + ii - 1;
            if (rr < 0 || rr >= 32) continue;
#pragma unroll
            for (int jj = 0; jj < 3; ++jj) {
              int cc = cc0 + jj - 1;
              if (cc < 0 || cc >= 64) continue;
              uint4 raw = *(const uint4*)(p.proj + (long)(bl * TPB + CTX + rr * 64 + cc) * PLD + col);
              float xv[8]; unpack8(raw, xv);
              const float* wv = cw + (ii * 3 + jj) * 320 + lc;
#pragma unroll
              for (int e = 0; e < 8; ++e) val[e] += xv[e] * wv[e];
            }
          }
        }
#pragma unroll
        for (int e = 0; e < 8; ++e) val[e] = siluf_(val[e]);
      }
      if (cgp < 16) {
        float scl = (mixer == 2) ? 0.08838834764831845f : 1.f;
#pragma unroll
        for (int e = 0; e < 8; ++e) sm.q[tok][lc + e] = val[e] * scl;
      } else if (cgp < 32) {
        int d0 = lc - 128;
        if (mixer == 0) {
#pragma unroll
          for (int e = 0; e < 8; ++e) {
            float lbv = p.lb[l * D + h * 128 + d0 + e];
            float f = lbv + (1.f - lbv) * sigmoidf_(val[e]);
            sm.f[tok][d0 + e] = f;
            sm.k[tok][d0 + e] = 1.f - f;
          }
        } else {
#pragma unroll
          for (int e = 0; e < 8; ++e) sm.k[tok][d0 + e] = val[e];
        }
      } else {
        int c0 = lc - 256;
#pragma unroll
        for (int e = 0; e < 8; ++e) sm.v[tok][c0 + e] = val[e];
      }
    }
    if (mixer == 2 && tid < TC) {
      int row = scan_row(bl, dir, pos0 + tid);
      float ig = p.gates[(long)row * GLD + 32 + dir * 4 + h] + ibias;
      float fx = p.gates[(long)row * GLD + 40 + dir * 4 + h] + fbias;
      sm.sc[tid][0] = ig;
      sm.sc[tid][1] = -softplusf_(-fx);
    }
    __syncthreads();
    if (mixer == 1) {
      for (int tk = w * 8; tk < w * 8 + 8; ++tk) {
        float q0 = sm.q[tk][lane], q1 = sm.q[tk][lane + 64], k0 = sm.k[tk][lane], k1 = sm.k[tk][lane + 64];
        float sq = wave_sum(q0 * q0 + q1 * q1), sk = wave_sum(k0 * k0 + k1 * k1), qk = wave_sum(q0 * k0 + q1 * k1);
        float rq = rsqrtf(sq + 1e-6f) * 0.08838834764831845f, rk = rsqrtf(sk + 1e-6f);
        sm.q[tk][lane] = q0 * rq; sm.q[tk][lane + 64] = q1 * rq;
        sm.k[tk][lane] = k0 * rk; sm.k[tk][lane + 64] = k1 * rk;
        if (lane == 0) {
          int row = scan_row(bl, dir, pos0 + tk);
          float beta = sigmoidf_(p.gates[(long)row * GLD + dir * 8 + h]);
          float gg = gA * softplusf_(p.gates[(long)row * GLD + 16 + dir * 8 + h] + gDt);
          sm.sc[tk][0] = __expf(gg); sm.sc[tk][1] = beta; sm.sc[tk][2] = qk * rq * rk;
        }
      }
      __syncthreads();
    } else if (mixer == 2) {
      if (tid == 0) {
        float m = mstate;
        for (int tk = 0; tk < TC; ++tk) {
          float ig = sm.sc[tk][0], lf = sm.sc[tk][1];
          float mn = fmaxf(lf + m, ig);
          sm.sc[tk][0] = __expf(lf + m - mn);
          sm.sc[tk][1] = __expf(ig - mn);
          sm.sc[tk][2] = __expf(-mn);
          m = mn;
        }
        mstate = m;
      }
      __syncthreads();
    }
    if (mixer == 0) {
      for (int tk = 0; tk < TC; ++tk) {
        float vj = sm.v[tk][w * 16 + j];
        const float4* qp = (const float4*)&sm.q[tk][gq * 32];
        const float4* kp = (const float4*)&sm.k[tk][gq * 32];
        const float4* fp = (const float4*)&sm.f[tk][gq * 32];
        float acc = 0.f;
#pragma unroll
        for (int i = 0; i < 8; ++i) {
          float4 q4 = qp[i], k4 = kp[i], f4 = fp[i];
          S[4 * i + 0] = f4.x * S[4 * i + 0] + k4.x * vj; acc += q4.x * S[4 * i + 0];
          S[4 * i + 1] = f4.y * S[4 * i + 1] + k4.y * vj; acc += q4.y * S[4 * i + 1];
          S[4 * i + 2] = f4.z * S[4 * i + 2] + k4.z * vj; acc += q4.z * S[4 * i + 2];
          S[4 * i + 3] = f4.w * S[4 * i + 3] + k4.w * vj; acc += q4.w * S[4 * i + 3];
        }
        acc += __shfl_xor(acc, 16); acc += __shfl_xor(acc, 32);
        if (gq == 0) sm.v[tk][w * 16 + j] = acc;
      }
    } else if (mixer == 1) {
      for (int tk = 0; tk < TC; ++tk) {
        float vj = sm.v[tk][w * 16 + j];
        float a = sm.sc[tk][0], beta = sm.sc[tk][1], qk = sm.sc[tk][2];
        const float4* qp = (const float4*)&sm.q[tk][gq * 32];
        const float4* kp = (const float4*)&sm.k[tk][gq * 32];
        float kr[32];
        float rr = 0.f, pq = 0.f;
#pragma unroll
        for (int i = 0; i < 8; ++i) {
          float4 q4 = qp[i], k4 = kp[i];
          kr[4 * i + 0] = k4.x; kr[4 * i + 1] = k4.y; kr[4 * i + 2] = k4.z; kr[4 * i + 3] = k4.w;
          rr += k4.x * S[4 * i + 0]; pq += q4.x * S[4 * i + 0];
          rr += k4.y * S[4 * i + 1]; pq += q4.y * S[4 * i + 1];
          rr += k4.z * S[4 * i + 2]; pq += q4.z * S[4 * i + 2];
          rr += k4.w * S[4 * i + 3]; pq += q4.w * S[4 * i + 3];
        }
        rr += __shfl_xor(rr, 16); pq += __shfl_xor(pq, 16);
        rr += __shfl_xor(rr, 32); pq += __shfl_xor(pq, 32);
        float vn = beta * (vj - a * rr);
        float ov = a * pq + qk * vn;
#pragma unroll
        for (int i = 0; i < 32; ++i) S[i] = a * S[i] + kr[i] * vn;
        if (gq == 0) sm.v[tk][w * 16 + j] = ov;
      }
    } else {
      for (int tk = 0; tk < TC; ++tk) {
        float vj = sm.v[tk][w * 16 + j];
        float fd = sm.sc[tk][0], iw = sm.sc[tk][1], em = sm.sc[tk][2];
        float ivj = iw * vj;
        const float4* qp = (const float4*)&sm.q[tk][gq * 32];
        const float4* kp = (const float4*)&sm.k[tk][gq * 32];
        float acc = 0.f;
#pragma unroll
        for (int i = 0; i < 8; ++i) {
          float4 q4 = qp[i], k4 = kp[i];
          S[4 * i + 0] = fd * S[4 * i + 0] + k4.x * ivj; acc += q4.x * S[4 * i + 0];
          S[4 * i + 1] = fd * S[4 * i + 1] + k4.y * ivj; acc += q4.y * S[4 * i + 1];
          S[4 * i + 2] = fd * S[4 * i + 2] + k4.z * ivj; acc += q4.z * S[4 * i + 2];
          S[4 * i + 3] = fd * S[4 * i + 3] + k4.w * ivj; acc += q4.w * S[4 * i + 3];
        }
        float2 kk = *(const float2*)&sm.k[tk][gq * 32 + 2 * j];
        float2 qq = *(const float2*)&sm.q[tk][gq * 32 + 2 * j];
        n0 = fd * n0 + iw * kk.x; n1 = fd * n1 + iw * kk.y;
        float den = n0 * qq.x + n1 * qq.y;
        den = wave_sum(den);
        acc += __shfl_xor(acc, 16); acc += __shfl_xor(acc, 32);
        if (gq == 0) sm.v[tk][w * 16 + j] = acc / fmaxf(fabsf(den), em);
      }
    }
    __syncthreads();
    {
      int tok = tid >> 3, c8 = tid & 7;
      int row = scan_row(bl, dir, pos0 + tok);
      const float* op = &sm.v[tok][c8 * 8];
      uint4 o;
      o.x = pack2(op[0], op[1]); o.y = pack2(op[2], op[3]); o.z = pack2(op[4], op[5]); o.w = pack2(op[6], op[7]);
      *(uint4*)(p.obuf + ((long)dir * TG + row) * 3072 + ocol + c8 * 8) = o;
    }
  }
}

struct CSmem {
  u16 QA[32][136];
  u16 KA[32][136];
  u16 KDT[128][40];
  u16 XT[64][40];
  u16 ATT[32][40];
  u16 ST[64][136];
  float sc[32][8];
  union {
    struct { u16 QD[32][136]; float dec[128]; float hsum[2][128]; } hg;
    struct { u16 YT[64][40]; u16 TM[32][40]; float NM[32][36]; u16 VF[32][72]; } gd;
    struct { float nvec[128]; } ml;
  } u;
};

__device__ __forceinline__ f32x4 mfma16(bf16x8 a, bf16x8 b, f32x4 c) { return __builtin_amdgcn_mfma_f32_16x16x32_bf16(a, b, c, 0, 0, 0); }
__device__ __forceinline__ bf16x8 ldf(const u16* base, int ld, int row, int k) { return *(const bf16x8*)(base + row * ld + k); }
__device__ __forceinline__ void st4(u16* dst, float a, float b, float c, float d) { uint2 v; v.x = pack2(a, b); v.y = pack2(c, d); *(uint2*)dst = v; }

__device__ void scan_unit_mma(const Params& p, int l, int g, int u, CSmem& sm) {
  const int tid0 = otid();
  const int mixer = u / 128, r = u % 128;
  int bl, h, dir, vs;
  bl = r / 32;
  if (mixer < 2) { h = (r % 32) / 4; dir = (r % 4) / 2; vs = r % 2; }
  else { h = (r % 32) / 8; dir = (r % 8) / 4; vs = r % 4; }
  int cq, ck, cv, ocol;
  if (mixer == 0) { cq = C_HGQ + h * 128; ck = C_HGF + dir * 1024 + h * 128; cv = C_HGI + h * 128 + vs * 64; ocol = h * 128 + vs * 64; }
  else if (mixer == 1) { cq = C_GQ + h * 128; ck = C_GK + h * 128; cv = C_GV + h * 128 + vs * 64; ocol = 1024 + h * 128 + vs * 64; }
  else { cq = C_MQ + h * 128; ck = C_MK + h * 128; cv = C_MV + h * 256 + vs * 64; ocol = 2048 + h * 256 + vs * 64; }
  const float QS = 0.08838834764831845f;

  f32x4 S[2][4];
#pragma unroll
  for (int a = 0; a < 2; ++a)
#pragma unroll
    for (int b = 0; b < 4; ++b) S[a][b] = f32x4{0.f, 0.f, 0.f, 0.f};
  float mcar = 0.f;
  float gA = 0.f, gDt = 0.f, ibias = 0.f, fbias = 0.f;
  if (mixer == 1) { gA = -__expf(p.gdn_a_log[l * 16 + dir * 8 + h]); gDt = p.gdn_dt_bias[l * 16 + dir * 8 + h]; }
  if (mixer == 2) { ibias = p.ml_i_bias[l * 8 + dir * 4 + h]; fbias = p.ml_f_bias[l * 8 + dir * 4 + h]; }

  __syncthreads();
  for (int i = tid0; i < 64 * 136 / 2; i += 256) ((unsigned*)&sm.ST[0][0])[i] = 0u;
  if (mixer == 2 && tid0 < 128) sm.u.ml.nvec[tid0] = 0.f;
  __syncthreads();


  uint4 pq0, pq1, pk0, pk1, pv;
  float pg0 = 0.f, pg1 = 0.f;
  const int gc0 = (mixer == 1) ? (dir * 8 + h) : (32 + dir * 4 + h);
  const int gc1 = (mixer == 1) ? (16 + dir * 8 + h) : (40 + dir * 4 + h);
  const float lbv = (mixer == 0) ? p.lb[l * D + h * 128 + (tid0 & 127)] : 0.f;
#define ISSUE_LOADS(CH, TID)                                                                          \
  {                                                                                                   \
    const int _pos = (CH) * 32;                                                                       \
    {                                                                                                 \
      int _idx = (TID), _tok = _idx >> 4, _c = _idx & 15;                                             \
      const u16* _pr = p.proj + (long)scan_row(bl, dir, _pos + _tok) * PLD;                           \
      pq0 = *(const uint4*)(_pr + cq + _c * 8);                                                       \
      pk0 = *(const uint4*)(_pr + ck + _c * 8);                                                       \
    }                                                                                                 \
    {                                                                                                 \
      int _idx = (TID) + 256, _tok = _idx >> 4, _c = _idx & 15;                                       \
      const u16* _pr = p.proj + (long)scan_row(bl, dir, _pos + _tok) * PLD;                           \
      pq1 = *(const uint4*)(_pr + cq + _c * 8);                                                       \
      pk1 = *(const uint4*)(_pr + ck + _c * 8);                                                       \
    }                                                                                                 \
    {                                                                                                 \
      int _tok = (TID) >> 3, _c8 = (TID) & 7;                                                         \
      pv = *(const uint4*)(p.proj + (long)scan_row(bl, dir, _pos + _tok) * PLD + cv + _c8 * 8);       \
    }                                                                                                 \
    if (mixer != 0 && (TID) < 64) {                                                                   \
      const float* _gp = p.gates + (long)scan_row(bl, dir, _pos + ((TID) & 31)) * GLD;                \
      pg0 = _gp[gc0]; pg1 = _gp[gc1];                                                                 \
    }                                                                                                 \
  }
  ISSUE_LOADS(0, tid0)

  for (int ch0 = 0; ch0 < TPB / 32; ++ch0) {
    const int tid = otid(), lane = tid & 63, w = tid >> 6, fr = lane & 15, fq = lane >> 4;
    const int rt_o = w & 1, cp_o = w >> 1;
    const int pos0 = ch0 * 32;
    float mnew = 0.f;
    {
      int tok = tid >> 4, c = tid & 15;
      *(uint4*)&sm.QA[tok][c * 8] = pq0; *(uint4*)&sm.KA[tok][c * 8] = pk0;
      *(uint4*)&sm.QA[tok + 16][c * 8] = pq1; *(uint4*)&sm.KA[tok + 16][c * 8] = pk1;
    }
    {
      int t = tid >> 3, c8 = tid & 7;
      if (mixer == 1) *(uint4*)&sm.u.gd.VF[t][c8 * 8] = pv;
      else {
        sm.XT[c8 * 8 + 0][t] = (u16)(pv.x & 0xffffu); sm.XT[c8 * 8 + 1][t] = (u16)(pv.x >> 16);
        sm.XT[c8 * 8 + 2][t] = (u16)(pv.y & 0xffffu); sm.XT[c8 * 8 + 3][t] = (u16)(pv.y >> 16);
        sm.XT[c8 * 8 + 4][t] = (u16)(pv.z & 0xffffu); sm.XT[c8 * 8 + 5][t] = (u16)(pv.z >> 16);
        sm.XT[c8 * 8 + 6][t] = (u16)(pv.w & 0xffffu); sm.XT[c8 * 8 + 7][t] = (u16)(pv.w >> 16);
      }
    }
    const float g0 = pg0, g1 = pg1;
    if (ch0 + 1 < TPB / 32) ISSUE_LOADS(ch0 + 1, tid)
    if (mixer == 0) {
      __syncthreads();
      const int d = tid & 127, hh = tid >> 7;
      float bb[16], qv[16], kv[16];
      float run = 0.f;
#pragma unroll
      for (int i = 0; i < 16; ++i) {
        int t = hh * 16 + i;
        float fx = bf2f(sm.KA[t][d]);
        qv[i] = bf2f(sm.QA[t][d]);
        float f = lbv + (1.f - lbv) * sigmoidf_(fx);
        kv[i] = 1.f - f;
        run += __logf(f);
        bb[i] = run;
      }
      sm.u.hg.hsum[hh][d] = run;
      __syncthreads();
      float h0 = sm.u.hg.hsum[0][d], h1 = sm.u.hg.hsum[1][d];
      float bref = h0, bend = h0 + h1, off = hh ? h0 : 0.f;
      if (hh == 0) sm.u.hg.dec[d] = __expf(bend);
      unsigned kd2[8];
#pragma unroll
      for (int i = 0; i < 16; ++i) {
        float b = bb[i] + off;
        float qa = qv[i] * __expf(fminf(b - bref, 80.f));
        float ka = kv[i] * __expf(fminf(bref - b, 80.f));
        float qd = qv[i] * __expf(b);
        float kd = kv[i] * __expf(bend - b);
        int t = hh * 16 + i;
        sm.QA[t][d] = f2bf(qa); sm.KA[t][d] = f2bf(ka); sm.u.hg.QD[t][d] = f2bf(qd);
        if (i & 1) kd2[i >> 1] |= ((unsigned)f2bf(kd)) << 16; else kd2[i >> 1] = (unsigned)f2bf(kd);
      }
      *(uint4*)&sm.KDT[d][hh * 16] = uint4{kd2[0], kd2[1], kd2[2], kd2[3]};
      *(uint4*)&sm.KDT[d][hh * 16 + 8] = uint4{kd2[4], kd2[5], kd2[6], kd2[7]};
      __syncthreads();
    } else if (mixer == 1) {
      if (w == 0) {
        int tk = lane & 31;
        float beta = sigmoidf_(g0);
        float G = gA * softplusf_(g1 + gDt);
#pragma unroll
        for (int o = 1; o < 32; o <<= 1) { float t2 = __shfl_up(G, o); if (tk >= o) G += t2; }
        if (lane < 32) { sm.sc[tk][0] = G; sm.sc[tk][1] = beta; }
      }
      __syncthreads();
      {
        const int d = tid & 127, hh = tid >> 7;
        float Gend = sm.sc[31][0];
        unsigned kd2[8];
#pragma unroll
        for (int i = 0; i < 16; ++i) {
          int s_ = hh * 16 + i;
          float kd = bf2f(sm.KA[s_][d]) * __expf(Gend - sm.sc[s_][0]);
          if (i & 1) kd2[i >> 1] |= ((unsigned)f2bf(kd)) << 16; else kd2[i >> 1] = (unsigned)f2bf(kd);
        }
        *(uint4*)&sm.KDT[d][hh * 16] = uint4{kd2[0], kd2[1], kd2[2], kd2[3]};
        *(uint4*)&sm.KDT[d][hh * 16 + 8] = uint4{kd2[4], kd2[5], kd2[6], kd2[7]};
      }
      {
        const int ai = w & 1, bi = w >> 1;
        if (ai >= bi) {
          f32x4 acc = f32x4{0.f, 0.f, 0.f, 0.f};
#pragma unroll
          for (int kk = 0; kk < 4; ++kk)
            acc = mfma16(ldf(&sm.KA[0][0], 136, ai * 16 + fr, kk * 32 + fq * 8), ldf(&sm.KA[0][0], 136, bi * 16 + fr, kk * 32 + fq * 8), acc);
          int b = bi * 16 + fr;
          float Gb = sm.sc[b][0];
#pragma unroll
          for (int j = 0; j < 4; ++j) {
            int a = ai * 16 + fq * 4 + j;
            if (a > b) sm.u.gd.NM[a][b] = sm.sc[a][1] * acc[j] * __expf(sm.sc[a][0] - Gb);
          }
        }
      }
      __syncthreads();
    } else {
      if (w == 0) {
        int tk = lane & 31;
        float ig = g0 + ibias;
        float F = -softplusf_(-(g1 + fbias));
#pragma unroll
        for (int o = 1; o < 32; o <<= 1) { float t2 = __shfl_up(F, o); if (tk >= o) F += t2; }
        float a = ig - F;
        float pm = a;
#pragma unroll
        for (int o = 1; o < 32; o <<= 1) { float t2 = __shfl_up(pm, o); if (tk >= o) pm = fmaxf(pm, t2); }
        float M = fmaxf(mcar, pm);
        if (lane < 32) { sm.sc[tk][0] = F; sm.sc[tk][1] = a; sm.sc[tk][2] = M; }
      }
      __syncthreads();
      {
        const int d = tid & 127, hh = tid >> 7;
        float Mend = sm.sc[31][2];
        mnew = sm.sc[31][0] + Mend;
        unsigned kd2[8];
#pragma unroll
        for (int i = 0; i < 16; ++i) {
          int s_ = hh * 16 + i;
          float kd = bf2f(sm.KA[s_][d]) * __expf(sm.sc[s_][1] - Mend);
          if (i & 1) kd2[i >> 1] |= ((unsigned)f2bf(kd)) << 16; else kd2[i >> 1] = (unsigned)f2bf(kd);
        }
        *(uint4*)&sm.KDT[d][hh * 16] = uint4{kd2[0], kd2[1], kd2[2], kd2[3]};
        *(uint4*)&sm.KDT[d][hh * 16 + 8] = uint4{kd2[4], kd2[5], kd2[6], kd2[7]};
      }
    }
    if (mixer == 1 && w == 0) {
      if (lane < 32) {
        const int c = lane;
        float Tc[32];
#pragma unroll
        for (int t = 0; t < 32; ++t) {
          float v = (t == c) ? 1.f : 0.f;
#pragma unroll
          for (int s4 = 0; s4 < (t + 3) / 4; ++s4) {
            float4 n4 = *(const float4*)&sm.u.gd.NM[t][s4 * 4];
            if (s4 * 4 + 0 < t) v -= n4.x * Tc[s4 * 4 + 0];
            if (s4 * 4 + 1 < t) v -= n4.y * Tc[s4 * 4 + 1];
            if (s4 * 4 + 2 < t) v -= n4.z * Tc[s4 * 4 + 2];
            if (s4 * 4 + 3 < t) v -= n4.w * Tc[s4 * 4 + 3];
          }
          Tc[t] = v;
          sm.u.gd.TM[t][c] = f2bf(v);
          __builtin_amdgcn_sched_barrier(0);
        }
      }
      { int t = lane >> 2, s4 = (lane & 3) * 4; *(uint2*)&sm.ATT[t][16 + s4] = uint2{0u, 0u}; }
    } else {
      int si, ti; bool doit = true;
      if (mixer == 1) { si = (w == 3) ? 1 : 0; ti = (w == 1) ? 0 : 1; }
      else { si = w & 1; ti = w >> 1; doit = !(si == 1 && ti == 0); }
      if (doit) {
        f32x4 acc = f32x4{0.f, 0.f, 0.f, 0.f};
#pragma unroll
        for (int kk = 0; kk < 4; ++kk)
          acc = mfma16(ldf(&sm.KA[0][0], 136, si * 16 + fr, kk * 32 + fq * 8), ldf(&sm.QA[0][0], 136, ti * 16 + fr, kk * 32 + fq * 8), acc);
        const int t = ti * 16 + fr;
        float o4[4];
        if (mixer == 0) {
#pragma unroll
          for (int j = 0; j < 4; ++j) { int s_ = si * 16 + fq * 4 + j; o4[j] = (s_ <= t) ? acc[j] : 0.f; }
        } else if (mixer == 1) {
          float Gt = sm.sc[t][0];
#pragma unroll
          for (int j = 0; j < 4; ++j) { int s_ = si * 16 + fq * 4 + j; o4[j] = (s_ <= t) ? acc[j] * __expf(Gt - sm.sc[s_][0]) : 0.f; }
        } else {
          float Mt = sm.sc[t][2];
#pragma unroll
          for (int j = 0; j < 4; ++j) { int s_ = si * 16 + fq * 4 + j; o4[j] = (s_ <= t) ? acc[j] * QS * __expf(sm.sc[s_][1] - Mt) : 0.f; }
        }
        st4(&sm.ATT[t][si * 16 + fq * 4], o4[0], o4[1], o4[2], o4[3]);
      } else {
        int t = lane >> 2, s4 = (lane & 3) * 4; *(uint2*)&sm.ATT[t][16 + s4] = uint2{0u, 0u};
      }
    }
    __syncthreads();
    if (mixer == 1) {
      f32x4 acc[2];
      acc[0] = acc[1] = f32x4{0.f, 0.f, 0.f, 0.f};
#pragma unroll
      for (int kk = 0; kk < 4; ++kk) {
        bf16x8 a = ldf(&sm.KA[0][0], 136, rt_o * 16 + fr, kk * 32 + fq * 8);
#pragma unroll
        for (int c = 0; c < 2; ++c) acc[c] = mfma16(a, ldf(&sm.ST[0][0], 136, (cp_o * 2 + c) * 16 + fr, kk * 32 + fq * 8), acc[c]);
      }
#pragma unroll
      for (int c = 0; c < 2; ++c) {
        int v = (cp_o * 2 + c) * 16 + fr;
        float y4[4];
#pragma unroll
        for (int j = 0; j < 4; ++j) {
          int t = rt_o * 16 + fq * 4 + j;
          float kg = __expf(sm.sc[t][0]);
          y4[j] = sm.sc[t][1] * (bf2f(sm.u.gd.VF[t][v]) - kg * acc[c][j]);
        }
        st4(&sm.u.gd.YT[v][rt_o * 16 + fq * 4], y4[0], y4[1], y4[2], y4[3]);
      }
      __syncthreads();
      {
        bf16x8 a = ldf(&sm.u.gd.TM[0][0], 40, rt_o * 16 + fr, fq * 8);
#pragma unroll
        for (int c = 0; c < 2; ++c) {
          int vt = cp_o * 2 + c;
          f32x4 vn = mfma16(a, ldf(&sm.u.gd.YT[0][0], 40, vt * 16 + fr, fq * 8), f32x4{0.f, 0.f, 0.f, 0.f});
          st4(&sm.XT[vt * 16 + fr][rt_o * 16 + fq * 4], vn[0], vn[1], vn[2], vn[3]);
        }
      }
      __syncthreads();
    } else if (mixer == 2) {
      int t = tid >> 3, part = tid & 7;
      float qn = 0.f;
#pragma unroll
      for (int e = 0; e < 16; ++e) qn += bf2f(sm.QA[t][part * 16 + e]) * sm.u.ml.nvec[part * 16 + e];
      float as = 0.f;
#pragma unroll
      for (int e = 0; e < 4; ++e) as += bf2f(sm.ATT[t][part * 4 + e]);
      float Mt = sm.sc[t][2];
      float den = QS * __expf(mcar - Mt) * qn + as;
      den += __shfl_xor(den, 1); den += __shfl_xor(den, 2); den += __shfl_xor(den, 4);
      if (part == 0) sm.sc[t][4] = 1.f / fmaxf(fabsf(den), __expf(-(sm.sc[t][0] + Mt)));
      __syncthreads();
    }
    {
      f32x4 acc[2];
      acc[0] = acc[1] = f32x4{0.f, 0.f, 0.f, 0.f};
      const u16* Qs = (mixer == 0) ? &sm.u.hg.QD[0][0] : &sm.QA[0][0];
#pragma unroll
      for (int kk = 0; kk < 4; ++kk) {
        bf16x8 a = ldf(Qs, 136, rt_o * 16 + fr, kk * 32 + fq * 8);
#pragma unroll
        for (int c = 0; c < 2; ++c) acc[c] = mfma16(a, ldf(&sm.ST[0][0], 136, (cp_o * 2 + c) * 16 + fr, kk * 32 + fq * 8), acc[c]);
      }
      float rs[4], fs[4];
#pragma unroll
      for (int j = 0; j < 4; ++j) {
        int t = rt_o * 16 + fq * 4 + j;
        if (mixer == 0) { rs[j] = 1.f; fs[j] = 1.f; }
        else if (mixer == 1) { rs[j] = __expf(sm.sc[t][0]); fs[j] = 1.f; }
        else { rs[j] = QS * __expf(mcar - sm.sc[t][2]); fs[j] = sm.sc[t][4]; }
      }
#pragma unroll
      for (int c = 0; c < 2; ++c)
#pragma unroll
        for (int j = 0; j < 4; ++j) acc[c][j] *= rs[j];
      {
        bf16x8 a = ldf(&sm.ATT[0][0], 40, rt_o * 16 + fr, fq * 8);
#pragma unroll
        for (int c = 0; c < 2; ++c) acc[c] = mfma16(a, ldf(&sm.XT[0][0], 40, (cp_o * 2 + c) * 16 + fr, fq * 8), acc[c]);
      }
#pragma unroll
      for (int j = 0; j < 4; ++j) {
        int t = rt_o * 16 + fq * 4 + j;
        int row = scan_row(bl, dir, pos0 + t);
        u16* dst = p.obuf + ((long)dir * TG + row) * 3072 + ocol;
#pragma unroll
        for (int c = 0; c < 2; ++c) dst[(cp_o * 2 + c) * 16 + fr] = f2bf(acc[c][j] * fs[j]);
      }
    }
    __syncthreads();
    {
      float dsc = 1.f;
      if (mixer == 1) dsc = __expf(sm.sc[31][0]);
      else if (mixer == 2) dsc = __expf(mcar - sm.sc[31][2]);
#pragma unroll
      for (int rt = 0; rt < 2; ++rt) {
        if (mixer == 0) {
          float4 d4 = *(const float4*)&sm.u.hg.dec[w * 32 + rt * 16 + fq * 4];
#pragma unroll
          for (int ct = 0; ct < 4; ++ct) { S[rt][ct][0] *= d4.x; S[rt][ct][1] *= d4.y; S[rt][ct][2] *= d4.z; S[rt][ct][3] *= d4.w; }
        } else {
#pragma unroll
          for (int ct = 0; ct < 4; ++ct) { S[rt][ct][0] *= dsc; S[rt][ct][1] *= dsc; S[rt][ct][2] *= dsc; S[rt][ct][3] *= dsc; }
        }
        bf16x8 a = ldf(&sm.KDT[0][0], 40, w * 32 + rt * 16 + fr, fq * 8);
#pragma unroll
        for (int ct = 0; ct < 4; ++ct) {
          S[rt][ct] = mfma16(a, ldf(&sm.XT[0][0], 40, ct * 16 + fr, fq * 8), S[rt][ct]);
          st4(&sm.ST[ct * 16 + fr][w * 32 + rt * 16 + fq * 4], S[rt][ct][0], S[rt][ct][1], S[rt][ct][2], S[rt][ct][3]);
        }
      }
      if (mixer == 2) {
        if (tid < 128) {
          float sum = 0.f;
#pragma unroll
          for (int e = 0; e < 32; ++e) sum += bf2f(sm.KDT[tid][e]);
          sm.u.ml.nvec[tid] = dsc * sm.u.ml.nvec[tid] + sum;
        }
        mcar = mnew;
      }
    }
    __syncthreads();
  }
}

#define MMA_MASK 7
__device__ void ph_scan(const Params& p, int l, int g, char* smem) {
  for (int u = blockIdx.x; u < 384; u += gridDim.x) {
    int mixer = u / 128;
#if MMA_MASK == 7
    scan_unit_mma(p, l, g, u, *(CSmem*)smem);
#else
    if ((MMA_MASK >> mixer) & 1) scan_unit_mma(p, l, g, u, *(CSmem*)smem);
    else scan_unit(p, l, g, u, *(ScanSmem*)smem);
#endif
  }
}

__device__ void ph_brfin(const Params& p, int l, int g) {
  const int tid = otid();
  const int lane = tid & 63;
  const int gw = blockIdx.x * 4 + (tid >> 6), nw = gridDim.x * 4;
  for (int wu = gw; wu < TG * 3; wu += nw) {
    int row = wu / 3, mixer = wu % 3;
    int pp = row % TPB;
    if (l == 1 && pp < CTX) continue;
    const u16* of = p.obuf + (long)row * 3072 + mixer * 1024 + lane * 16;
    const u16* ob = p.obuf + ((long)TG + row) * 3072 + mixer * 1024 + lane * 16;
    float o[16], t8[8];
    uint4 a0 = *(const uint4*)of, a1 = *(const uint4*)(of + 8), b0 = *(const uint4*)ob, b1 = *(const uint4*)(ob + 8);
    unpack8(a0, o); unpack8(a1, o + 8);
    unpack8(b0, t8);
#pragma unroll
    for (int e = 0; e < 8; ++e) o[e] += t8[e];
    unpack8(b1, t8);
#pragma unroll
    for (int e = 0; e < 8; ++e) o[8 + e] += t8[e];
    float ss = 0.f;
#pragma unroll
    for (int e = 0; e < 16; ++e) ss += o[e] * o[e];
    ss += __shfl_xor(ss, 1); ss += __shfl_xor(ss, 2); ss += __shfl_xor(ss, 4);
    float hd = 128.f;
    if (mixer == 2) { ss += __shfl_xor(ss, 8); hd = 256.f; }
    float rs = rsqrtf(ss / hd + 1e-6f);
    const float* on = (mixer == 0 ? p.hg_onorm : (mixer == 1 ? p.gdn_onorm : p.ml_onorm)) + l * D + lane * 16;
    int zc = mixer == 0 ? C_HGZ : (mixer == 1 ? C_GZ : C_MZ);
    const u16* zp = p.proj + (long)row * PLD + zc + lane * 16;
    float z[16];
    uint4 z0 = *(const uint4*)zp, z1 = *(const uint4*)(zp + 8);
    unpack8(z0, z); unpack8(z1, z + 8);
    float res[16];
#pragma unroll
    for (int e = 0; e < 16; ++e) res[e] = o[e] * rs * on[e] * siluf_(z[e]);
    if (mixer == 2) {
      const u16* gp = p.proj + (long)row * PLD + C_MO + lane * 16;
      uint4 g0 = *(const uint4*)gp, g1 = *(const uint4*)(gp + 8);
      unpack8(g0, z); unpack8(g1, z + 8);
#pragma unroll
      for (int e = 0; e < 16; ++e) res[e] *= sigmoidf_(z[e]);
    }
    uint4 w0, w1;
    w0.x = pack2(res[0], res[1]); w0.y = pack2(res[2], res[3]); w0.z = pack2(res[4], res[5]); w0.w = pack2(res[6], res[7]);
    w1.x = pack2(res[8], res[9]); w1.y = pack2(res[10], res[11]); w1.z = pack2(res[12], res[13]); w1.w = pack2(res[14], res[15]);
    u16* dst = p.obuf + (long)row * 3072 + mixer * 1024 + lane * 16;
    *(uint4*)dst = w0; *(uint4*)(dst + 8) = w1;
  }
}

__device__ void ph_gemm_merge(const Params& p, int l, char* smem) {
  const int tid = otid();
  const int wid = tid >> 6, lane = tid & 63, wr = wid >> 1, wc = wid & 1, fr = lane & 15, fq = lane >> 4;
  for (int t = blockIdx.x; t < 72 * 16; t += gridDim.x) {
    int nt = t / 72, mt = t % 72;
    if (l == 1 && (mt % 18) < 2) continue;
    f32x4 tot[4][2];
#pragma unroll
    for (int m = 0; m < 4; ++m)
#pragma unroll
      for (int n = 0; n < 2; ++n) tot[m][n] = f32x4{0.f, 0.f, 0.f, 0.f};
    for (int i = 0; i < 3; ++i) {
      f32x4 acc[4][2];
#pragma unroll
      for (int m = 0; m < 4; ++m)
#pragma unroll
        for (int n = 0; n < 2; ++n) acc[m][n] = f32x4{0.f, 0.f, 0.f, 0.f};
      gemm_kloop<2>(p.obuf + (long)mt * 128 * 3072 + i * 1024, 3072, p.WbrT + ((long)i * D + nt * 64) * D, D, D, smem, acc);
#pragma unroll
      for (int m = 0; m < 4; ++m) {
        int row = mt * 128 + wr * 64 + m * 16 + fr;
#pragma unroll
        for (int n = 0; n < 2; ++n) {
          int col = nt * 64 + wc * 32 + n * 16 + fq * 4;
          uint2 gr = *(const uint2*)(p.proj + (long)row * PLD + C_GATE + i * 1024 + col);
          tot[m][n][0] += sigmoidf_(__uint_as_float(gr.x << 16)) * acc[m][n][0];
          tot[m][n][1] += sigmoidf_(__uint_as_float(gr.x & 0xffff0000u)) * acc[m][n][1];
          tot[m][n][2] += sigmoidf_(__uint_as_float(gr.y << 16)) * acc[m][n][2];
          tot[m][n][3] += sigmoidf_(__uint_as_float(gr.y & 0xffff0000u)) * acc[m][n][3];
        }
      }
    }
#pragma unroll
    for (int m = 0; m < 4; ++m) {
      int row = mt * 128 + wr * 64 + m * 16 + fr;
#pragma unroll
      for (int n = 0; n < 2; ++n) {
        int col = nt * 64 + wc * 32 + n * 16 + fq * 4;
        uint2 o; o.x = pack2(tot[m][n][0], tot[m][n][1]); o.y = pack2(tot[m][n][2], tot[m][n][3]);
        *(uint2*)(p.hbuf + (long)row * D + col) = o;
      }
    }
  }
}

__device__ void ph_gemm_out(const Params& p, int l, int g, char* smem) {
  const int tid = otid();
  const int wid = tid >> 6, lane = tid & 63, wr = wid >> 1, wc = wid & 1, fr = lane & 15, fq = lane >> 4;
  for (int t = blockIdx.x; t < 72 * 8; t += gridDim.x) {
    int nt = t / 72, mt = t % 72;
    if (l == 1 && (mt % 18) < 2) continue;
    f32x4 acc[4][4];
#pragma unroll
    for (int m = 0; m < 4; ++m)
#pragma unroll
      for (int n = 0; n < 4; ++n) acc[m][n] = f32x4{0.f, 0.f, 0.f, 0.f};
    gemm_kloop<4>(p.hbuf + (long)mt * 128 * D, D, p.WoT + (long)nt * 128 * D, D, D, smem, acc);
#pragma unroll
    for (int m = 0; m < 4; ++m) {
      int row = mt * 128 + wr * 64 + m * 16 + fr;
      int bl = row / TPB, pp = row % TPB, b = g * GB + bl;
      const float* src; float* dst; int mrow;
      if (pp < CTX) { src = p.ctx + ((long)b * CTX + pp) * D; dst = p.ctxs + ((long)b * CTX + pp) * D; mrow = 16; }
      else { long off = ((long)b * SEQ + (pp - CTX)) * D; src = (l == 0 ? p.x : p.out) + off; dst = p.out + off; mrow = b; }
      const float* gt = p.mod + ((long)l * 17 + mrow) * 3072 + 2048;
#pragma unroll
      for (int n = 0; n < 4; ++n) {
        int col = nt * 128 + wc * 64 + n * 16 + fq * 4;
        float4 xv = *(const float4*)(src + col), gv = *(const float4*)(gt + col);
        float4 o;
        o.x = xv.x + gv.x * acc[m][n][0]; o.y = xv.y + gv.y * acc[m][n][1];
        o.z = xv.z + gv.z * acc[m][n][2]; o.w = xv.w + gv.w * acc[m][n][3];
        *(float4*)(dst + col) = o;
      }
    }
  }
}

__device__ void ph_final(const Params& p) {
  const int tid = otid();
  const int lane = tid & 63;
  const int gw = blockIdx.x * 4 + (tid >> 6), nw = gridDim.x * 4;
  for (int row = gw; row < NB * SEQ; row += nw) {
    float4* src = (float4*)(p.out + (long)row * D);
    float4 v[4]; float ss = 0.f;
#pragma unroll
    for (int i = 0; i < 4; ++i) {
      v[i] = src[lane + 64 * i];
      ss += v[i].x * v[i].x + v[i].y * v[i].y + v[i].z * v[i].z + v[i].w * v[i].w;
    }
    ss = wave_sum(ss);
    float rs = rsqrtf(ss * (1.f / D) + 1e-6f);
#pragma unroll
    for (int i = 0; i < 4; ++i) {
      float4 g4 = ((const float4*)p.final_g)[lane + 64 * i];
      float4 o; o.x = v[i].x * rs * g4.x; o.y = v[i].y * rs * g4.y; o.z = v[i].z * rs * g4.z; o.w = v[i].w * rs * g4.w;
      src[lane + 64 * i] = o;
    }
  }
}


#define XB_TMO      128
#define XB_XCNT(j)  (256  + 64 * (j))
#define XB_XSUB(j)  (1280 + 64 * (j))
#define XB_XGEN(j)  (2304 + 64 * (j))
#define XB_TOP      3328
#define XB_TOPGEN   3392
#define XCD_BAR_WORDS 3456
#define XB_SPIN_CAP (1u << 22)
#define LAS __attribute__((address_space(3)))
__device__ __forceinline__ unsigned xb_ld(unsigned* p) { return __hip_atomic_load(p, __ATOMIC_RELAXED, __HIP_MEMORY_SCOPE_AGENT); }
__device__ __forceinline__ unsigned xb_add(unsigned* p, unsigned v) { return __hip_atomic_fetch_add(p, v, __ATOMIC_RELAXED, __HIP_MEMORY_SCOPE_AGENT); }
__device__ __forceinline__ unsigned xb_xcc_id() { return (unsigned)__builtin_amdgcn_s_getreg((3 << 11) | 20) & 0xFu; }
#define XB_SPIN(cond, bar) do { unsigned _sp = 0; while (cond) { __builtin_amdgcn_s_sleep(1); \
    if ((++_sp & 255u) == 0u) { if (xb_ld(&(bar)[XB_TMO])) break; if (_sp > XB_SPIN_CAP) { atomicAdd(&(bar)[XB_TMO], 1u); break; } } } } while (0)
struct XcdBarrier { unsigned* bar; unsigned x; volatile LAS unsigned* st; };
__device__ __forceinline__ XcdBarrier xcd_barrier_post(unsigned* bar, volatile LAS unsigned* st) {
  XcdBarrier b; b.bar = bar; b.x = xb_xcc_id(); b.st = st;
  if (threadIdx.x == 0) (void)xb_add(&bar[XB_XCNT(b.x)], 1u);
  return b;
}
__device__ __forceinline__ void xcd_barrier_complete(unsigned* bar, unsigned x, unsigned& nloc, unsigned& nx) {
  const unsigned G = gridDim.x * gridDim.y * gridDim.z;
  unsigned sum, cnt, mine, sp = 0u;
  for (;;) {
    sum = 0u; cnt = 0u; mine = 0u;
#pragma unroll
    for (unsigned j = 0; j < 16; ++j) { const unsigned c = xb_ld(&bar[XB_XCNT(j)]); sum += c; cnt += (c > 0u) ? 1u : 0u; mine = (j == x) ? c : mine; }
    if (sum == G) break;
    __builtin_amdgcn_s_sleep(1);
    if ((++sp & 255u) == 0u) { if (xb_ld(&bar[XB_TMO])) break; if (sp > XB_SPIN_CAP) { atomicAdd(&bar[XB_TMO], 1u); break; } }
  }
  nloc = mine > 0u ? mine : 1u; nx = cnt > 0u ? cnt : 1u;
}
__device__ __forceinline__ void xcd_barrier(const XcdBarrier& b) {
  asm volatile("s_waitcnt vmcnt(0)" ::: "memory");
  __syncthreads();
  if (threadIdx.x == 0) {
    unsigned* bar = b.bar;
    __builtin_amdgcn_s_waitcnt(0);
    unsigned nloc = b.st[0], nx = b.st[1];
    if (nloc == 0u) { xcd_barrier_complete(bar, b.x, nloc, nx); b.st[0] = nloc; b.st[1] = nx; }
    const unsigned old = xb_add(&bar[XB_XSUB(b.x)], 1u);
    const unsigned gen = old / nloc;
    if (old + 1u == (gen + 1u) * nloc) {
      __builtin_amdgcn_fence(__ATOMIC_RELEASE, "agent");
      asm volatile("s_waitcnt vmcnt(0)" ::: "memory");
      const unsigned og = xb_add(&bar[XB_TOP], 1u);
      const unsigned tg = og / nx;
      if (og + 1u == (tg + 1u) * nx) xb_add(&bar[XB_TOPGEN], 1u);
      else XB_SPIN(xb_ld(&bar[XB_TOPGEN]) == tg, bar);
      __builtin_amdgcn_fence(__ATOMIC_ACQUIRE, "agent");
      xb_add(&bar[XB_XGEN(b.x)], 1u);
      asm volatile("s_waitcnt vmcnt(0)" ::: "memory");
    } else {
      XB_SPIN(xb_ld(&bar[XB_XGEN(b.x)]) == gen, bar);
      __builtin_amdgcn_fence(__ATOMIC_ACQUIRE, "agent");
      asm volatile("s_waitcnt vmcnt(0)" ::: "memory");
    }
  }
  __syncthreads();
}

constexpr int NSTEPS = 2 + 24 + 1 + 24 + 1;

__device__ void run_step(const Params& p, int step, char* smem) {
  if (step == 0) { ph_convert(p, 0, smem); ph_prep_small(p); return; }
  if (step == 1) { ph_mod(p, smem); return; }
  if (step == 26) { ph_convert(p, 1, smem); return; }
  if (step == NSTEPS - 1) { ph_final(p); return; }
  int l, s;
  if (step < 26) { l = 0; s = step - 2; } else { l = 1; s = step - 27; }
  int g = s / 6, k = s % 6;
  switch (k) {
    case 0: ph_prenorm(p, l, g); break;
    case 1: ph_gemm_in(p, smem); break;
    case 2: ph_scan(p, l, g, smem); break;
    case 3: ph_brfin(p, l, g); break;
    case 4: ph_gemm_merge(p, l, smem); break;
    case 5: ph_gemm_out(p, l, g, smem); break;
  }
}

#if !COOP
__global__ void __launch_bounds__(256, 2) k_step(Params p, int step) {
  __shared__ __attribute__((aligned(16))) char smem[sizeof(CSmem) > sizeof(ScanSmem) ? sizeof(CSmem) : sizeof(ScanSmem)];
  run_step(p, step, smem);
}
#else
__global__ void __launch_bounds__(256, 2) k_mega(Params p) {
  __shared__ __attribute__((aligned(16))) char smem[sizeof(CSmem) > sizeof(ScanSmem) ? sizeof(CSmem) : sizeof(ScanSmem)];
  __shared__ uint4 xb_words;
  cg::grid_group grid = cg::this_grid();
  if (threadIdx.x == 0) xb_words = make_uint4(0u, 0u, 0u, 0u);
  __syncthreads();
  XcdBarrier xb = xcd_barrier_post(p.bar, (volatile LAS unsigned*)&xb_words);
#define GSYNC() xcd_barrier(xb)
  ph_prep_small(p);
#pragma unroll 1
  for (int l = 0; l < 2; ++l) {
    ph_convert(p, l, smem);
    if (l == 0) { grid.sync(); ph_mod(p, smem); }
    GSYNC();
#pragma unroll 1
    for (int g = 0; g < NGRP; ++g) {
      ph_prenorm(p, l, g); GSYNC();
      ph_gemm_in(p, smem); GSYNC();
      ph_conv(p, l); GSYNC();
      ph_scan(p, l, g, smem); GSYNC();
      ph_brfin(p, l, g); GSYNC();
      ph_gemm_merge(p, l, smem); GSYNC();
      ph_gemm_out(p, l, g, smem); GSYNC();
    }
  }
  ph_final(p);
}
#endif

extern "C" void kernel_launch(void* const* d_in, const int* in_sizes, int n_in, void* d_out, int out_size, void* d_ws,
                              size_t ws_size, hipStream_t stream) {
  Params p{};
  p.x = (const float*)d_in[0]; p.c = (const float*)d_in[1]; p.ctx = (const float*)d_in[2]; p.c_ctx = (const float*)d_in[3];
  p.ada_w = (const float*)d_in[4]; p.ada_b = (const float*)d_in[5]; p.norm_g = (const float*)d_in[6]; p.w_in = (const float*)d_in[7];
  p.hg_lb = (const float*)d_in[8]; p.hg_onorm = (const float*)d_in[9]; p.gdn_conv = (const float*)d_in[10];
  p.gdn_a_log = (const float*)d_in[11]; p.gdn_dt_bias = (const float*)d_in[12]; p.gdn_onorm = (const float*)d_in[13];
  p.ml_i_bias = (const float*)d_in[14]; p.ml_f_bias = (const float*)d_in[15]; p.ml_onorm = (const float*)d_in[16];
  p.w_branch = (const float*)d_in[17]; p.w_out = (const float*)d_in[18]; p.final_g = (const float*)d_in[19];
  p.out = (float*)d_out;
  char* ws = (char*)d_ws;
  size_t off = 0;
  auto take = [&](size_t bytes) { char* r = ws + off; off += (bytes + 255) & ~(size_t)255; return r; };
  p.WinT = (u16*)take((size_t)NPAD * D * 2);
  p.WbrT = (u16*)take((size_t)3 * D * D * 2);
  p.WoT = (u16*)take((size_t)D * D * 2);
  p.hbuf = (u16*)take((size_t)TG * D * 2);
  p.proj = (u16*)take((size_t)TG * PLD * 2);
  p.obuf = (u16*)take((size_t)2 * TG * 3072 * 2);
  p.mod = (float*)take((size_t)2 * 17 * 3072 * 4);
  p.lb = (float*)take((size_t)2 * D * 4);
  p.silc = (float*)take((size_t)17 * D * 4);
  p.gates = (float*)take((size_t)TG * GLD * 4);
  p.ctxs = (float*)take((size_t)NB * CTX * D * 4);
  p.bar = (unsigned*)take((size_t)XCD_BAR_WORDS * 4);
  if (off > ws_size) { fprintf(stderr, "workspace too small: need %zu have %zu\n", off, ws_size); return; }

  static int grid_blocks = 0;
  if (!grid_blocks) {
    int dev = 0, cus = 0, per_cu = 0;
    hipGetDevice(&dev);
    hipDeviceGetAttribute(&cus, hipDeviceAttributeMultiprocessorCount, dev);
#if COOP
    hipOccupancyMaxActiveBlocksPerMultiprocessor(&per_cu, k_mega, 256, 0);
#else
    hipOccupancyMaxActiveBlocksPerMultiprocessor(&per_cu, k_step, 256, 0);
#endif
    if (per_cu < 1) per_cu = 1;
    if (per_cu > 2) per_cu = 2;
    grid_blocks = cus * per_cu;
  }
#if COOP
  hipMemsetAsync(p.bar, 0, (size_t)XCD_BAR_WORDS * 4, stream);
  void* args[] = {&p};
  hipError_t e = hipLaunchCooperativeKernel((void*)k_mega, dim3(grid_blocks), dim3(256), args, 0, stream);
  if (e != hipSuccess) fprintf(stderr, "cooperative launch failed: %s (grid %d)\n", hipGetErrorString(e), grid_blocks);
#else
  for (int s = 0; s < NSTEPS; ++s) k_step<<<grid_blocks, 256, 0, stream>>>(p, s);
#endif
}
```

```cpp
#include <hip/hip_runtime.h>
#include <hip/hip_bf16.h>
#include <hip/hip_cooperative_groups.h>
#include <cstdio>
namespace cg = cooperative_groups;

#define REP_PRE 1
#define REP_GIN 1
#define REP_SCAN 1
#define REP_MRG 1
#define REP_SYNC 0
#ifndef COOP
#define COOP 1
#endif

typedef unsigned short u16;
using bf16x8 = __attribute__((ext_vector_type(8))) short;
using f32x4 = __attribute__((ext_vector_type(4))) float;

constexpr int D = 1024;
constexpr int NB = 16;
constexpr int SEQ = 2048;
constexpr int CTX = 256;
constexpr int TPB = SEQ + CTX;
constexpr int GB = 4;
constexpr int NGRP = NB / GB;
constexpr int TG = GB * TPB;
constexpr int IN_DIM = 16432;
constexpr int NPAD = 16512;
constexpr int PLD = 16384;
constexpr int GLD = 64;
constexpr int TC = 32;
constexpr int C_HGQ = 0, C_HGI = 1024, C_HGF = 2048, C_HGZ = 4096;
constexpr int C_GQ = 5120, C_GK = 6144, C_GV = 7168, C_GZ = 8192;
constexpr int C_MQ = 9216, C_MK = 9728, C_MV = 10240, C_MO = 11264, C_MZ = 12288;
constexpr int C_GATE = 13312;

struct Params {
  const float *x, *c, *ctx, *c_ctx, *ada_w, *ada_b, *norm_g, *w_in, *hg_lb, *hg_onorm, *gdn_conv,
      *gdn_a_log, *gdn_dt_bias, *gdn_onorm, *ml_i_bias, *ml_f_bias, *ml_onorm, *w_branch, *w_out, *final_g;
  float* out;
  u16 *WinT, *WbrT, *WoT, *hbuf, *proj, *obuf;
  float *mod, *lb, *silc, *gates, *ctxs;
  unsigned* bar;
};

typedef __bf16 bf16v2 __attribute__((ext_vector_type(2)));
typedef float f32v2 __attribute__((ext_vector_type(2)));
__device__ __forceinline__ unsigned pack2(float a, float b) {
  f32v2 v = {a, b};
  return __builtin_bit_cast(unsigned, __builtin_convertvector(v, bf16v2));
}
__device__ __forceinline__ u16 f2bf(float f) { return (u16)(pack2(f, 0.f) & 0xffffu); }
__device__ __forceinline__ float bf2f(u16 h) { return __uint_as_float(((unsigned)h) << 16); }
__device__ __forceinline__ float sigmoidf_(float x) { return 1.f / (1.f + __expf(-x)); }
__device__ __forceinline__ float siluf_(float x) { return x / (1.f + __expf(-x)); }
__device__ __forceinline__ float softplusf_(float y) { return fmaxf(y, 0.f) + log1pf(__expf(-fabsf(y))); }
__device__ __forceinline__ float wave_sum(float v) {
#pragma unroll
  for (int o = 32; o >= 1; o >>= 1) v += __shfl_xor(v, o);
  return v;
}
__device__ __forceinline__ void unpack8(const uint4& u, float* f) {
  f[0] = __uint_as_float(u.x << 16); f[1] = __uint_as_float(u.x & 0xffff0000u);
  f[2] = __uint_as_float(u.y << 16); f[3] = __uint_as_float(u.y & 0xffff0000u);
  f[4] = __uint_as_float(u.z << 16); f[5] = __uint_as_float(u.z & 0xffff0000u);
  f[6] = __uint_as_float(u.w << 16); f[7] = __uint_as_float(u.w & 0xffff0000u);
}

__device__ __forceinline__ int otid() { int t = threadIdx.x; asm volatile("" : "+v"(t)); return t; }
__device__ __forceinline__ int win_src_col(int np) {
  if (np < 9216) return np;
  if (np < 13312) return np + 32;
  if (np < 16384) return np + 48;
  if (np < 16416) return 9216 + (np - 16384);
  if (np < 16432) return 13344 + (np - 16416);
  return -1;
}

__device__ void ph_convert(const Params& p, int l, char* smem) {
  float (*tile)[65] = (float (*)[65])smem;
  const int tid = otid();
  for (int t = blockIdx.x; t < 5152; t += gridDim.x) {
    const float* src; long sld; u16* dst; int n0, k0, kind;
    if (t < 4128) { kind = 0; n0 = (t / 16) * 64; k0 = (t % 16) * 64; src = p.w_in + (long)l * D * IN_DIM; sld = IN_DIM; dst = p.WinT; }
    else if (t < 4896) { int u = t - 4128; int i = u / 256; u %= 256; kind = 1; n0 = (u / 16) * 64; k0 = (u % 16) * 64;
      src = p.w_branch + ((long)l * 3 + i) * D * D; sld = D; dst = p.WbrT + (long)i * D * D; }
    else { int u = t - 4896; kind = 1; n0 = (u / 16) * 64; k0 = (u % 16) * 64; src = p.w_out + (long)l * D * D; sld = D; dst = p.WoT; }
#pragma unroll 4
    for (int i = 0; i < 16; ++i) {
      int kk = (tid >> 6) + 4 * i, nn = tid & 63;
      int np = n0 + nn;
      int ns = kind == 0 ? win_src_col(np) : np;
      tile[kk][nn] = ns >= 0 ? src[(long)(k0 + kk) * sld + ns] : 0.f;
    }
    __syncthreads();
#pragma unroll 4
    for (int i = 0; i < 16; ++i) {
      int nn = (tid >> 6) + 4 * i, kk = tid & 63;
      dst[(long)(n0 + nn) * D + k0 + kk] = f2bf(tile[kk][nn]);
    }
    __syncthreads();
  }
}

__device__ void ph_prep_small(const Params& p) {
  int gt = blockIdx.x * blockDim.x + otid(), gs = gridDim.x * blockDim.x;
  for (int i = gt; i < 17 * D + 2 * D; i += gs) {
    if (i < 16 * D) p.silc[i] = siluf_(p.c[i]);
    else if (i < 17 * D) p.silc[i] = siluf_(p.c_ctx[i - 16 * D]);
    else {
      int j = i - 17 * D;
      if (j < D) p.lb[j] = 0.f;
      else { int ch = j - D; p.lb[j] = sigmoidf_(p.hg_lb[D + ch] - p.hg_lb[ch]); }
    }
  }
}

__device__ void ph_mod(const Params& p, char* smem) {
  float (*red)[17][64] = (float (*)[17][64])smem;
  const int tid = otid();
  const int kq = __builtin_amdgcn_readfirstlane(tid >> 6), cc = tid & 63;
  for (int u = blockIdx.x; u < 96; u += gridDim.x) {
    int l = u / 48, col = (u % 48) * 64 + cc;
    float acc[17];
#pragma unroll
    for (int r = 0; r < 17; ++r) acc[r] = 0.f;
    const float* w = p.ada_w + (long)l * D * 3072 + col;
    for (int k = kq * 256; k < kq * 256 + 256; ++k) {
      float wv = w[(long)k * 3072];
#pragma unroll
      for (int r = 0; r < 17; ++r) acc[r] += p.silc[r * D + k] * wv;
    }
#pragma unroll
    for (int r = 0; r < 17; ++r) red[kq][r][cc] = acc[r];
    __syncthreads();
    for (int i = tid; i < 17 * 64; i += 256) {
      int r = i / 64, c2 = i % 64;
      int colo = (u % 48) * 64 + c2;
      float s = red[0][r][c2] + red[1][r][c2] + red[2][r][c2] + red[3][r][c2] + p.ada_b[l * 3072 + colo];
      p.mod[((long)l * 17 + r) * 3072 + colo] = s;
    }
    __syncthreads();
  }
}

__device__ void ph_prenorm(const Params& p, int l, int g) {
  const int tid = otid();
  const int lane = tid & 63;
  const int gw = blockIdx.x * 4 + (tid >> 6), nw = gridDim.x * 4;
  for (int row = gw; row < TG; row += nw) {
    int bl = row / TPB, pp = row % TPB, b = g * GB + bl;
    const float* src; int mrow;
    if (pp < CTX) { src = (l == 0 ? p.ctx : p.ctxs) + ((long)b * CTX + pp) * D; mrow = 16; }
    else { src = (l == 0 ? p.x : p.out) + ((long)b * SEQ + (pp - CTX)) * D; mrow = b; }
    const float* md = p.mod + ((long)l * 17 + mrow) * 3072;
    float4 v[4]; float ss = 0.f;
#pragma unroll
    for (int i = 0; i < 4; ++i) {
      v[i] = ((const float4*)src)[lane + 64 * i];
      ss += v[i].x * v[i].x + v[i].y * v[i].y + v[i].z * v[i].z + v[i].w * v[i].w;
    }
    ss = wave_sum(ss);
    float rs = rsqrtf(ss * (1.f / D) + 1e-6f);
#pragma unroll
    for (int i = 0; i < 4; ++i) {
      int idx = (lane + 64 * i) * 4;
      float4 g4 = *(const float4*)(p.norm_g + l * D + idx);
      float4 sh = *(const float4*)(md + idx);
      float4 sc = *(const float4*)(md + D + idx);
      float h0 = v[i].x * rs * g4.x * (1.f + sc.x) + sh.x;
      float h1 = v[i].y * rs * g4.y * (1.f + sc.y) + sh.y;
      float h2 = v[i].z * rs * g4.z * (1.f + sc.z) + sh.z;
      float h3 = v[i].w * rs * g4.w * (1.f + sc.w) + sh.w;
      uint2 o; o.x = pack2(h0, h1); o.y = pack2(h2, h3);
      *(uint2*)(p.hbuf + (long)row * D + idx) = o;
    }
  }
}

template <int NF>
__device__ __forceinline__ void gemm_kloop256(const u16* Ag, long lda, const u16* Bg, long ldb, int K, char* smem, f32x4 (&acc)[8][NF]) {
  const int tid = otid();
  const int wid = tid >> 6, lane = tid & 63, wr = wid >> 1, wc = wid & 1, fr = lane & 15, fq = lane >> 4;
  constexpr int ASZ = 256 * 64;
  constexpr int BSZ = NF * 32 * 64;
  constexpr int SSZ = ASZ + BSZ;
  constexpr int NLD = 4 + NF / 2;
  const int lrow = tid >> 2, cs = tid & 3;
  const int cgl = cs ^ ((lrow >> 2) & 3);
  const u16* Ap = Ag + (long)lrow * lda + cgl * 8;
  const u16* Bp = Bg + (long)lrow * ldb + cgl * 8;
  const int nt = K / 32;
#define GK_ISSUE(T, S)                                                                                                   \
  {                                                                                                                      \
    char* _SA = smem + (S) * SSZ; char* _SB = _SA + ASZ;                                                                 \
    _Pragma("unroll") for (int _i = 0; _i < 4; ++_i)                                                                     \
      __builtin_amdgcn_global_load_lds((const unsigned*)(Ap + (long)_i * 64 * lda + (T) * 32),                           \
                                       (__attribute__((address_space(3))) unsigned*)(_SA + _i * 4096 + tid * 16), 16, 0, 0); \
    _Pragma("unroll") for (int _i = 0; _i < NF / 2; ++_i)                                                                \
      __builtin_amdgcn_global_load_lds((const unsigned*)(Bp + (long)_i * 64 * ldb + (T) * 32),                           \
                                       (__attribute__((address_space(3))) unsigned*)(_SB + _i * 4096 + tid * 16), 16, 0, 0); \
  }
  GK_ISSUE(0, 0)
  GK_ISSUE(1, 1)
  const int co = (fq ^ ((fr >> 2) & 3)) * 16;
#define GK_STEP(T, ST, S2, LAST1, LAST2)                                                                                 \
  {                                                                                                                      \
    if (!(LAST1)) asm volatile("s_waitcnt vmcnt(%0)" ::"n"(NLD) : "memory");                                             \
    else asm volatile("s_waitcnt vmcnt(0)" ::: "memory");                                                                \
    __builtin_amdgcn_s_barrier();                                                                                        \
    if (!(LAST2)) GK_ISSUE((T) + 2, S2)                                                                                  \
    bf16x8 At[8], Bl[NF];                                                                                                \
    _Pragma("unroll") for (int m = 0; m < 8; ++m)                                                                        \
      asm volatile("ds_read_b128 %0, %1 offset:%2" : "=v"(At[m]) : "v"(aA), "n"((ST) * SSZ + m * 1024));                  \
    _Pragma("unroll") for (int n = 0; n < NF; ++n)                                                                       \
      asm volatile("ds_read_b128 %0, %1 offset:%2" : "=v"(Bl[n]) : "v"(aB), "n"((ST) * SSZ + n * 1024));                  \
    if (NF == 4)                                                                                                         \
      asm volatile("s_waitcnt lgkmcnt(0)" : "+v"(At[0]), "+v"(At[1]), "+v"(At[2]), "+v"(At[3]), "+v"(At[4]), "+v"(At[5]), \
                   "+v"(At[6]), "+v"(At[7]), "+v"(Bl[0]), "+v"(Bl[1]), "+v"(Bl[NF - 2]), "+v"(Bl[NF - 1]));              \
    else                                                                                                                 \
      asm volatile("s_waitcnt lgkmcnt(0)" : "+v"(At[0]), "+v"(At[1]), "+v"(At[2]), "+v"(At[3]), "+v"(At[4]), "+v"(At[5]), \
                   "+v"(At[6]), "+v"(At[7]), "+v"(Bl[0]), "+v"(Bl[1]));                                                  \
    _Pragma("unroll") for (int m = 0; m < 8; ++m)                                                                        \
      _Pragma("unroll") for (int n = 0; n < NF; ++n)                                                                     \
        acc[m][n] = __builtin_amdgcn_mfma_f32_16x16x32_bf16(Bl[n], At[m], acc[m][n], 0, 0, 0);                           \
  }
  const unsigned lds0 = (unsigned)(unsigned long)(__attribute__((address_space(3))) const char*)smem;
  const unsigned aA = lds0 + (wr * 128 + fr) * 64 + co;
  const unsigned aB = lds0 + ASZ + (wc * NF * 16 + fr) * 64 + co;
  for (int t = 0; t < nt - 2; t += 3) {
    GK_STEP(t, 0, 2, false, false)
    GK_STEP(t + 1, 1, 0, false, false)
    GK_STEP(t + 2, 2, 1, false, false)
  }
  GK_STEP(nt - 2, 0, 2, false, true)
  GK_STEP(nt - 1, 1, 0, true, true)
#undef GK_STEP
  __builtin_amdgcn_s_barrier();
#undef GK_ISSUE
}

__device__ void ph_gemm_in(const Params& p, char* smem) {
  const int tid = otid();
  const int wid = tid >> 6, lane = tid & 63, wr = wid >> 1, wc = wid & 1, fr = lane & 15, fq = lane >> 4;
  for (int t = blockIdx.x; t < 36 * 129; t += gridDim.x) {
    int nt = t / 36, mt = t % 36;
    f32x4 acc[8][4];
#pragma unroll
    for (int m = 0; m < 8; ++m)
#pragma unroll
      for (int n = 0; n < 4; ++n) acc[m][n] = f32x4{0.f, 0.f, 0.f, 0.f};
    gemm_kloop256<4>(p.hbuf + (long)mt * 256 * D, D, p.WinT + (long)nt * 128 * D, D, D, smem, acc);
    if (nt < 128) {
      u16* dbase; long dld; int cb;
      if (nt >= 40 && nt < 64) { dbase = p.obuf + (long)TG * 3072; dld = 3072; cb = (nt - 40) * 128; }
      else { dbase = p.proj; dld = PLD; cb = nt * 128; }
#pragma unroll
      for (int m = 0; m < 8; ++m) {
        int row = mt * 256 + wr * 128 + m * 16 + fr;
#pragma unroll
        for (int n = 0; n < 4; ++n) {
          int col = cb + wc * 64 + n * 16 + fq * 4;
          uint2 o; o.x = pack2(acc[m][n][0], acc[m][n][1]); o.y = pack2(acc[m][n][2], acc[m][n][3]);
          *(uint2*)(dbase + (long)row * dld + col) = o;
        }
      }
    } else if (wc == 0) {
#pragma unroll
      for (int m = 0; m < 8; ++m) {
        int row = mt * 256 + wr * 128 + m * 16 + fr;
#pragma unroll
        for (int n = 0; n < 4; ++n) {
          int col = n * 16 + fq * 4;
          *(float4*)(p.gates + (long)row * GLD + col) = float4{acc[m][n][0], acc[m][n][1], acc[m][n][2], acc[m][n][3]};
        }
      }
    }
  }
}

__device__ void ph_conv(const Params& p, int l) {
  const int tid = otid();
  const int lane = tid & 63;
  const int gw = blockIdx.x * 4 + (tid >> 6), nw = gridDim.x * 4;
  const u16* stg = p.obuf + (long)TG * 3072;
  for (int task = gw; task < TG * 8; task += nw) {
    int row = task >> 3, h = task & 7;
    int bl = row / TPB, t = row % TPB;
    int part = lane >> 4, c8 = lane & 15;
    int chn = part * 1024 + h * 128 + c8 * 8;
    float val[8];
#pragma unroll
    for (int e = 0; e < 8; ++e) val[e] = 0.f;
    if (part < 3) {
      const float* cwb = p.gdn_conv + (long)l * 9 * 3072 + chn;
      if (t < CTX) {
#pragma unroll
        for (int jj = 0; jj < 3; ++jj) {
          int tt = t + jj - 1;
          if (tt >= 0 && tt < CTX) {
            uint4 raw = *(const uint4*)(stg + (long)(bl * TPB + tt) * 3072 + chn);
            float xv[8]; unpack8(raw, xv);
            float4 w0 = *(const float4*)(cwb + (3 + jj) * 3072), w1 = *(const float4*)(cwb + (3 + jj) * 3072 + 4);
            val[0] += xv[0] * w0.x; val[1] += xv[1] * w0.y; val[2] += xv[2] * w0.z; val[3] += xv[3] * w0.w;
            val[4] += xv[4] * w1.x; val[5] += xv[5] * w1.y; val[6] += xv[6] * w1.z; val[7] += xv[7] * w1.w;
          }
        }
      } else {
        int lt = t - CTX, rr0 = lt >> 6, cc0 = lt & 63;
#pragma unroll
        for (int ii = 0; ii < 3; ++ii) {
          int rr = rr0 + ii - 1;
          if (rr < 0 || rr >= 32) continue;
#pragma unroll
          for (int jj = 0; jj < 3; ++jj) {
            int cc = cc0 + jj - 1;
            if (cc < 0 || cc >= 64) continue;
            uint4 raw = *(const uint4*)(stg + (long)(bl * TPB + CTX + rr * 64 + cc) * 3072 + chn);
            float xv[8]; unpack8(raw, xv);
            float4 w0 = *(const float4*)(cwb + (ii * 3 + jj) * 3072), w1 = *(const float4*)(cwb + (ii * 3 + jj) * 3072 + 4);
            val[0] += xv[0] * w0.x; val[1] += xv[1] * w0.y; val[2] += xv[2] * w0.z; val[3] += xv[3] * w0.w;
            val[4] += xv[4] * w1.x; val[5] += xv[5] * w1.y; val[6] += xv[6] * w1.z; val[7] += xv[7] * w1.w;
          }
        }
      }
    }
    float ss = 0.f;
#pragma unroll
    for (int e = 0; e < 8; ++e) { val[e] = siluf_(val[e]); ss += val[e] * val[e]; }
    ss += __shfl_xor(ss, 1); ss += __shfl_xor(ss, 2); ss += __shfl_xor(ss, 4); ss += __shfl_xor(ss, 8);
    float scl = 1.f;
    if (part == 0) scl = rsqrtf(ss + 1e-6f) * 0.08838834764831845f;
    else if (part == 1) scl = rsqrtf(ss + 1e-6f);
    if (part < 3) {
      uint4 o;
      o.x = pack2(val[0] * scl, val[1] * scl); o.y = pack2(val[2] * scl, val[3] * scl);
      o.z = pack2(val[4] * scl, val[5] * scl); o.w = pack2(val[6] * scl, val[7] * scl);
      *(uint4*)(p.proj + (long)row * PLD + C_GQ + chn) = o;
    }
  }
}

struct ScanSmem {
  float q[TC][128];
  float k[TC][128];
  float f[TC][128];
  float v[TC][64];
  float sc[TC][4];
};

__device__ __forceinline__ int scan_row(int bl, int dir, int pos) {
  int t;
  if (pos < CTX) t = dir ? (CTX - 1 - pos) : pos;
  else { int u = pos - CTX; t = CTX + (dir ? (SEQ - 1 - u) : u); }
  return bl * TPB + t;
}

__device__ void scan_unit(const Params& p, int l, int g, int u, ScanSmem& sm) {
  const int tid = otid(), lane = tid & 63, w = tid >> 6;
  const int j = lane & 15, gq = lane >> 4;
  const int mixer = u / 128, r = u % 128;
  int bl, h, dir, vs;
  bl = r / 32;
  if (mixer < 2) { h = (r % 32) / 4; dir = (r % 4) / 2; vs = r % 2; }
  else { h = (r % 32) / 8; dir = (r % 8) / 4; vs = r % 4; }
  int cq, ck, cv, ocol;
  if (mixer == 0) { cq = C_HGQ + h * 128; ck = C_HGF + dir * 1024 + h * 128; cv = C_HGI + h * 128 + vs * 64; ocol = h * 128 + vs * 64; }
  else if (mixer == 1) { cq = C_GQ + h * 128; ck = C_GK + h * 128; cv = C_GV + h * 128 + vs * 64; ocol = 1024 + h * 128 + vs * 64; }
  else { cq = C_MQ + h * 128; ck = C_MK + h * 128; cv = C_MV + h * 256 + vs * 64; ocol = 2048 + h * 256 + vs * 64; }

  float S[32];
#pragma unroll
  for (int i = 0; i < 32; ++i) S[i] = 0.f;
  float n0 = 0.f, n1 = 0.f;
  float mstate = 0.f;
  float gA = 0.f, gDt = 0.f, ibias = 0.f, fbias = 0.f;
  if (mixer == 1) { gA = -__expf(p.gdn_a_log[l * 16 + dir * 8 + h]); gDt = p.gdn_dt_bias[l * 16 + dir * 8 + h]; }
  if (mixer == 2) { ibias = p.ml_i_bias[l * 8 + dir * 4 + h]; fbias = p.ml_f_bias[l * 8 + dir * 4 + h]; }

  __syncthreads();
  if (mixer == 1) {
    float* cw = &sm.f[0][0];
    for (int i = tid; i < 9 * 320; i += 256) {
      int tap = i / 320, lc = i % 320;
      int ch = lc < 128 ? (h * 128 + lc) : (lc < 256 ? (1024 + h * 128 + lc - 128) : (2048 + h * 128 + vs * 64 + lc - 256));
      cw[i] = p.gdn_conv[((long)l * 9 + tap) * 3072 + ch];
    }
    __syncthreads();
  }

  for (int ch0 = 0; ch0 < TPB / TC; ++ch0) {
    const int pos0 = ch0 * TC;
    const bool is_ctx = pos0 < CTX;
    __syncthreads();
    for (int idx = tid; idx < TC * 40; idx += 256) {
      int tok = idx / 40, cgp = idx % 40;
      int row = scan_row(bl, dir, pos0 + tok);
      int col, lc;
      if (cgp < 16) { col = cq + cgp * 8; lc = cgp * 8; }
      else if (cgp < 32) { col = ck + (cgp - 16) * 8; lc = 128 + (cgp - 16) * 8; }
      else { col = cv + (cgp - 32) * 8; lc = 256 + (cgp - 32) * 8; }
      float val[8];
      if (mixer != 1) {
        uint4 raw = *(const uint4*)(p.proj + (long)row * PLD + col);
        unpack8(raw, val);
      } else {
        const float* cw = &sm.f[0][0];
#pragma unroll
        for (int e = 0; e < 8; ++e) val[e] = 0.f;
        int t = row - bl * TPB;
        if (is_ctx) {
#pragma unroll
          for (int jj = 0; jj < 3; ++jj) {
            int tt = t + jj - 1;
            if (tt >= 0 && tt < CTX) {
              uint4 raw = *(const uint4*)(p.proj + (long)(bl * TPB + tt) * PLD + col);
              float xv[8]; unpack8(raw, xv);
              const float* wv = cw + (3 + jj) * 320 + lc;
#pragma unroll
              for (int e = 0; e < 8; ++e) val[e] += xv[e] * wv[e];
            }
          }
        } else {
          int lt = t - CTX, rr0 = lt >> 6, cc0 = lt & 63;
#pragma unroll
          for (int ii = 0; ii < 3; ++ii) {
            int rr = rr0 + ii - 1;
            if (rr < 0 || rr >= 32) continue;
#pragma unroll
            for (int jj = 0; jj < 3; ++jj) {
              int cc = cc0 + jj - 1;
              if (cc < 0 || cc >= 64) continue;
              uint4 raw = *(const uint4*)(p.proj + (long)(bl * TPB + CTX + rr * 64 + cc) * PLD + col);
              float xv[8]; unpack8(raw, xv);
              const float* wv = cw + (ii * 3 + jj) * 320 + lc;
#pragma unroll
              for (int e = 0; e < 8; ++e) val[e] += xv[e] * wv[e];
            }
          }
        }
#pragma unroll
        for (int e = 0; e < 8; ++e) val[e] = siluf_(val[e]);
      }
      if (cgp < 16) {
        float scl = (mixer == 2) ? 0.08838834764831845f : 1.f;
#pragma unroll
        for (int e = 0; e < 8; ++e) sm.q[tok][lc + e] = val[e] * scl;
      } else if (cgp < 32) {
        int d0 = lc - 128;
        if (mixer == 0) {
#pragma unroll
          for (int e = 0; e < 8; ++e) {
            float lbv = p.lb[l * D + h * 128 + d0 + e];
            float f = lbv + (1.f - lbv) * sigmoidf_(val[e]);
            sm.f[tok][d0 + e] = f;
            sm.k[tok][d0 + e] = 1.f - f;
          }
        } else {
#pragma unroll
          for (int e = 0; e < 8; ++e) sm.k[tok][d0 + e] = val[e];
        }
      } else {
        int c0 = lc - 256;
#pragma unroll
        for (int e = 0; e < 8; ++e) sm.v[tok][c0 + e] = val[e];
      }
    }
    if (mixer == 2 && tid < TC) {
      int row = scan_row(bl, dir, pos0 + tid);
      float ig = p.gates[(long)row * GLD + 32 + dir * 4 + h] + ibias;
      float fx = p.gates[(long)row * GLD + 40 + dir * 4 + h] + fbias;
      sm.sc[tid][0] = ig;
      sm.sc[tid][1] = -softplusf_(-fx);
    }
    __syncthreads();
    if (mixer == 1) {
      for (int tk = w * 8; tk < w * 8 + 8; ++tk) {
        float q0 = sm.q[tk][lane], q1 = sm.q[tk][lane + 64], k0 = sm.k[tk][lane], k1 = sm.k[tk][lane + 64];
        float sq = wave_sum(q0 * q0 + q1 * q1), sk = wave_sum(k0 * k0 + k1 * k1), qk = wave_sum(q0 * k0 + q1 * k1);
        float rq = rsqrtf(sq + 1e-6f) * 0.08838834764831845f, rk = rsqrtf(sk + 1e-6f);
        sm.q[tk][lane] = q0 * rq; sm.q[tk][lane + 64] = q1 * rq;
        sm.k[tk][lane] = k0 * rk; sm.k[tk][lane + 64] = k1 * rk;
        if (lane == 0) {
          int row = scan_row(bl, dir, pos0 + tk);
          float beta = sigmoidf_(p.gates[(long)row * GLD + dir * 8 + h]);
          float gg = gA * softplusf_(p.gates[(long)row * GLD + 16 + dir * 8 + h] + gDt);
          sm.sc[tk][0] = __expf(gg); sm.sc[tk][1] = beta; sm.sc[tk][2] = qk * rq * rk;
        }
      }
      __syncthreads();
    } else if (mixer == 2) {
      if (tid == 0) {
        float m = mstate;
        for (int tk = 0; tk < TC; ++tk) {
          float ig = sm.sc[tk][0], lf = sm.sc[tk][1];
          float mn = fmaxf(lf + m, ig);
          sm.sc[tk][0] = __expf(lf + m - mn);
          sm.sc[tk][1] = __expf(ig - mn);
          sm.sc[tk][2] = __expf(-mn);
          m = mn;
        }
        mstate = m;
      }
      __syncthreads();
    }
    if (mixer == 0) {
      for (int tk = 0; tk < TC; ++tk) {
        float vj = sm.v[tk][w * 16 + j];
        const float4* qp = (const float4*)&sm.q[tk][gq * 32];
        const float4* kp = (const float4*)&sm.k[tk][gq * 32];
        const float4* fp = (const float4*)&sm.f[tk][gq * 32];
        float acc = 0.f;
#pragma unroll
        for (int i = 0; i < 8; ++i) {
          float4 q4 = qp[i], k4 = kp[i], f4 = fp[i];
          S[4 * i + 0] = f4.x * S[4 * i + 0] + k4.x * vj; acc += q4.x * S[4 * i + 0];
          S[4 * i + 1] = f4.y * S[4 * i + 1] + k4.y * vj; acc += q4.y * S[4 * i + 1];
          S[4 * i + 2] = f4.z * S[4 * i + 2] + k4.z * vj; acc += q4.z * S[4 * i + 2];
          S[4 * i + 3] = f4.w * S[4 * i + 3] + k4.w * vj; acc += q4.w * S[4 * i + 3];
        }
        acc += __shfl_xor(acc, 16); acc += __shfl_xor(acc, 32);
        if (gq == 0) sm.v[tk][w * 16 + j] = acc;
      }
    } else if (mixer == 1) {
      for (int tk = 0; tk < TC; ++tk) {
        float vj = sm.v[tk][w * 16 + j];
        float a = sm.sc[tk][0], beta = sm.sc[tk][1], qk = sm.sc[tk][2];
        const float4* qp = (const float4*)&sm.q[tk][gq * 32];
        const float4* kp = (const float4*)&sm.k[tk][gq * 32];
        float kr[32];
        float rr = 0.f, pq = 0.f;
#pragma unroll
        for (int i = 0; i < 8; ++i) {
          float4 q4 = qp[i], k4 = kp[i];
          kr[4 * i + 0] = k4.x; kr[4 * i + 1] = k4.y; kr[4 * i + 2] = k4.z; kr[4 * i + 3] = k4.w;
          rr += k4.x * S[4 * i + 0]; pq += q4.x * S[4 * i + 0];
          rr += k4.y * S[4 * i + 1]; pq += q4.y * S[4 * i + 1];
          rr += k4.z * S[4 * i + 2]; pq += q4.z * S[4 * i + 2];
          rr += k4.w * S[4 * i + 3]; pq += q4.w * S[4 * i + 3];
        }
        rr += __shfl_xor(rr, 16); pq += __shfl_xor(pq, 16);
        rr += __shfl_xor(rr, 32); pq += __shfl_xor(pq, 32);
        float vn = beta * (vj - a * rr);
        float ov = a * pq + qk * vn;
#pragma unroll
        for (int i = 0; i < 32; ++i) S[i] = a * S[i] + kr[i] * vn;
        if (gq == 0) sm.v[tk][w * 16 + j] = ov;
      }
    } else {
      for (int tk = 0; tk < TC; ++tk) {
        float vj = sm.v[tk][w * 16 + j];
        float fd = sm.sc[tk][0], iw = sm.sc[tk][1], em = sm.sc[tk][2];
        float ivj = iw * vj;
        const float4* qp = (const float4*)&sm.q[tk][gq * 32];
        const float4* kp = (const float4*)&sm.k[tk][gq * 32];
        float acc = 0.f;
#pragma unroll
        for (int i = 0; i < 8; ++i) {
          float4 q4 = qp[i], k4 = kp[i];
          S[4 * i + 0] = fd * S[4 * i + 0] + k4.x * ivj; acc += q4.x * S[4 * i + 0];
          S[4 * i + 1] = fd * S[4 * i + 1] + k4.y * ivj; acc += q4.y * S[4 * i + 1];
          S[4 * i + 2] = fd * S[4 * i + 2] + k4.z * ivj; acc += q4.z * S[4 * i + 2];
          S[4 * i + 3] = fd * S[4 * i + 3] + k4.w * ivj; acc += q4.w * S[4 * i + 3];
        }
        float2 kk = *(const float2*)&sm.k[tk][gq * 32 + 2 * j];
        float2 qq = *(const float2*)&sm.q[tk][gq * 32 + 2 * j];
        n0 = fd * n0 + iw * kk.x; n1 = fd * n1 + iw * kk.y;
        float den = n0 * qq.x + n1 * qq.y;
        den = wave_sum(den);
        acc += __shfl_xor(acc, 16); acc += __shfl_xor(acc, 32);
        if (gq == 0) sm.v[tk][w * 16 + j] = acc / fmaxf(fabsf(den), em);
      }
    }
    __syncthreads();
    {
      int tok = tid >> 3, c8 = tid & 7;
      int row = scan_row(bl, dir, pos0 + tok);
      const float* op = &sm.v[tok][c8 * 8];
      uint4 o;
      o.x = pack2(op[0], op[1]); o.y = pack2(op[2], op[3]); o.z = pack2(op[4], op[5]); o.w = pack2(op[6], op[7]);
      *(uint4*)(p.obuf + ((long)dir * TG + row) * 3072 + ocol + c8 * 8) = o;
    }
  }
}

struct CSmem {
  u16 QA[32][136];
  u16 KA[32][136];
  u16 KDT[128][40];
  u16 XT[64][40];
  u16 ATT[32][40];
  u16 ST[64][136];
  float sc[32][8];
  union {
    struct { u16 QD[32][136]; float dec[128]; float hsum[2][128]; } hg;
    struct { u16 YT[64][40]; u16 TM[32][40]; float NM[32][36]; u16 VF[32][72]; } gd;
    struct { float nvec[128]; } ml;
  } u;
};

__device__ __forceinline__ f32x4 mfma16(bf16x8 a, bf16x8 b, f32x4 c) { return __builtin_amdgcn_mfma_f32_16x16x32_bf16(a, b, c, 0, 0, 0); }
__device__ __forceinline__ bf16x8 ldf(const u16* base, int ld, int row, int k) { return *(const bf16x8*)(base + row * ld + k); }
__device__ __forceinline__ void st4(u16* dst, float a, float b, float c, float d) { uint2 v; v.x = pack2(a, b); v.y = pack2(c, d); *(uint2*)dst = v; }

__device__ void scan_unit_mma(const Params& p, int l, int g, int u, CSmem& sm) {
  const int tid0 = otid();
  const int mixer = u / 128, r = u % 128;
  int bl, h, dir, vs;
  bl = r / 32;
  if (mixer < 2) { h = (r % 32) / 4; dir = (r % 4) / 2; vs = r % 2; }
  else { h = (r % 32) / 8; dir = (r % 8) / 4; vs = r % 4; }
  int cq, ck, cv, ocol;
  if (mixer == 0) { cq = C_HGQ + h * 128; ck = C_HGF + dir * 1024 + h * 128; cv = C_HGI + h * 128 + vs * 64; ocol = h * 128 + vs * 64; }
  else if (mixer == 1) { cq = C_GQ + h * 128; ck = C_GK + h * 128; cv = C_GV + h * 128 + vs * 64; ocol = 1024 + h * 128 + vs * 64; }
  else { cq = C_MQ + h * 128; ck = C_MK + h * 128; cv = C_MV + h * 256 + vs * 64; ocol = 2048 + h * 256 + vs * 64; }
  const float QS = 0.08838834764831845f;

  f32x4 S[2][4];
#pragma unroll
  for (int a = 0; a < 2; ++a)
#pragma unroll
    for (int b = 0; b < 4; ++b) S[a][b] = f32x4{0.f, 0.f, 0.f, 0.f};
  float mcar = 0.f;
  float gA = 0.f, gDt = 0.f, ibias = 0.f, fbias = 0.f;
  if (mixer == 1) { gA = -__expf(p.gdn_a_log[l * 16 + dir * 8 + h]); gDt = p.gdn_dt_bias[l * 16 + dir * 8 + h]; }
  if (mixer == 2) { ibias = p.ml_i_bias[l * 8 + dir * 4 + h]; fbias = p.ml_f_bias[l * 8 + dir * 4 + h]; }

  __syncthreads();
  for (int i = tid0; i < 64 * 136 / 2; i += 256) ((unsigned*)&sm.ST[0][0])[i] = 0u;
  if (mixer == 2 && tid0 < 128) sm.u.ml.nvec[tid0] = 0.f;
  __syncthreads();


  uint4 pq0, pq1, pk0, pk1, pv;
  float pg0 = 0.f, pg1 = 0.f;
  const int gc0 = (mixer == 1) ? (dir * 8 + h) : (32 + dir * 4 + h);
  const int gc1 = (mixer == 1) ? (16 + dir * 8 + h) : (40 + dir * 4 + h);
  const float lbv = (mixer == 0) ? p.lb[l * D + h * 128 + (tid0 & 127)] : 0.f;
#define ISSUE_LOADS(CH, TID)                                                                          \
  {                                                                                                   \
    const int _pos = (CH) * 32;                                                                       \
    {                                                                                                 \
      int _idx = (TID), _tok = _idx >> 4, _c = _idx & 15;                                             \
      const u16* _pr = p.proj + (long)scan_row(bl, dir, _pos + _tok) * PLD;                           \
      pq0 = *(const uint4*)(_pr + cq + _c * 8);                                                       \
      pk0 = *(const uint4*)(_pr + ck + _c * 8);                                                       \
    }                                                                                                 \
    {                                                                                                 \
      int _idx = (TID) + 256, _tok = _idx >> 4, _c = _idx & 15;                                       \
      const u16* _pr = p.proj + (long)scan_row(bl, dir, _pos + _tok) * PLD;                           \
      pq1 = *(const uint4*)(_pr + cq + _c * 8);                                                       \
      pk1 = *(const uint4*)(_pr + ck + _c * 8);                                                       \
    }                                                                                                 \
    {                                                                                                 \
      int _tok = (TID) >> 3, _c8 = (TID) & 7;                                                         \
      pv = *(const uint4*)(p.proj + (long)scan_row(bl, dir, _pos + _tok) * PLD + cv + _c8 * 8);       \
    }                                                                                                 \
    if (mixer != 0 && (TID) < 64) {                                                                   \
      const float* _gp = p.gates + (long)scan_row(bl, dir, _pos + ((TID) & 31)) * GLD;                \
      pg0 = _gp[gc0]; pg1 = _gp[gc1];                                                                 \
    }                                                                                                 \
  }
  ISSUE_LOADS(0, tid0)

  for (int ch0 = 0; ch0 < TPB / 32; ++ch0) {
    const int tid = otid(), lane = tid & 63, w = tid >> 6, fr = lane & 15, fq = lane >> 4;
    const int rt_o = w & 1, cp_o = w >> 1;
    const int pos0 = ch0 * 32;
    float mnew = 0.f;
    {
      int tok = tid >> 4, c = tid & 15;
      *(uint4*)&sm.QA[tok][c * 8] = pq0; *(uint4*)&sm.KA[tok][c * 8] = pk0;
      *(uint4*)&sm.QA[tok + 16][c * 8] = pq1; *(uint4*)&sm.KA[tok + 16][c * 8] = pk1;
    }
    {
      int t = tid >> 3, c8 = tid & 7;
      if (mixer == 1) *(uint4*)&sm.u.gd.VF[t][c8 * 8] = pv;
      else {
        sm.XT[c8 * 8 + 0][t] = (u16)(pv.x & 0xffffu); sm.XT[c8 * 8 + 1][t] = (u16)(pv.x >> 16);
        sm.XT[c8 * 8 + 2][t] = (u16)(pv.y & 0xffffu); sm.XT[c8 * 8 + 3][t] = (u16)(pv.y >> 16);
        sm.XT[c8 * 8 + 4][t] = (u16)(pv.z & 0xffffu); sm.XT[c8 * 8 + 5][t] = (u16)(pv.z >> 16);
        sm.XT[c8 * 8 + 6][t] = (u16)(pv.w & 0xffffu); sm.XT[c8 * 8 + 7][t] = (u16)(pv.w >> 16);
      }
    }
    const float g0 = pg0, g1 = pg1;
    if (ch0 + 1 < TPB / 32) ISSUE_LOADS(ch0 + 1, tid)
    if (mixer == 0) {
      __syncthreads();
      const int d = tid & 127, hh = tid >> 7;
      float bb[16], qv[16], kv[16];
      float run = 0.f;
#pragma unroll
      for (int i = 0; i < 16; ++i) {
        int t = hh * 16 + i;
        float fx = bf2f(sm.KA[t][d]);
        qv[i] = bf2f(sm.QA[t][d]);
        float f = lbv + (1.f - lbv) * sigmoidf_(fx);
        kv[i] = 1.f - f;
        run += __logf(f);
        bb[i] = run;
      }
      sm.u.hg.hsum[hh][d] = run;
      __syncthreads();
      float h0 = sm.u.hg.hsum[0][d], h1 = sm.u.hg.hsum[1][d];
      float bref = h0, bend = h0 + h1, off = hh ? h0 : 0.f;
      if (hh == 0) sm.u.hg.dec[d] = __expf(bend);
      unsigned kd2[8];
#pragma unroll
      for (int i = 0; i < 16; ++i) {
        float b = bb[i] + off;
        float qa = qv[i] * __expf(fminf(b - bref, 80.f));
        float ka = kv[i] * __expf(fminf(bref - b, 80.f));
        float qd = qv[i] * __expf(b);
        float kd = kv[i] * __expf(bend - b);
        int t = hh * 16 + i;
        sm.QA[t][d] = f2bf(qa); sm.KA[t][d] = f2bf(ka); sm.u.hg.QD[t][d] = f2bf(qd);
        if (i & 1) kd2[i >> 1] |= ((unsigned)f2bf(kd)) << 16; else kd2[i >> 1] = (unsigned)f2bf(kd);
      }
      *(uint4*)&sm.KDT[d][hh * 16] = uint4{kd2[0], kd2[1], kd2[2], kd2[3]};
      *(uint4*)&sm.KDT[d][hh * 16 + 8] = uint4{kd2[4], kd2[5], kd2[6], kd2[7]};
      __syncthreads();
    } else if (mixer == 1) {
      if (w == 0) {
        int tk = lane & 31;
        float beta = sigmoidf_(g0);
        float G = gA * softplusf_(g1 + gDt);
#pragma unroll
        for (int o = 1; o < 32; o <<= 1) { float t2 = __shfl_up(G, o); if (tk >= o) G += t2; }
        if (lane < 32) { sm.sc[tk][0] = G; sm.sc[tk][1] = beta; }
      }
      __syncthreads();
      {
        const int d = tid & 127, hh = tid >> 7;
        float Gend = sm.sc[31][0];
        unsigned kd2[8];
#pragma unroll
        for (int i = 0; i < 16; ++i) {
          int s_ = hh * 16 + i;
          float kd = bf2f(sm.KA[s_][d]) * __expf(Gend - sm.sc[s_][0]);
          if (i & 1) kd2[i >> 1] |= ((unsigned)f2bf(kd)) << 16; else kd2[i >> 1] = (unsigned)f2bf(kd);
        }
        *(uint4*)&sm.KDT[d][hh * 16] = uint4{kd2[0], kd2[1], kd2[2], kd2[3]};
        *(uint4*)&sm.KDT[d][hh * 16 + 8] = uint4{kd2[4], kd2[5], kd2[6], kd2[7]};
      }
      {
        const int ai = w & 1, bi = w >> 1;
        if (ai >= bi) {
          f32x4 acc = f32x4{0.f, 0.f, 0.f, 0.f};
#pragma unroll
          for (int kk = 0; kk < 4; ++kk)
            acc = mfma16(ldf(&sm.KA[0][0], 136, ai * 16 + fr, kk * 32 + fq * 8), ldf(&sm.KA[0][0], 136, bi * 16 + fr, kk * 32 + fq * 8), acc);
          int b = bi * 16 + fr;
          float Gb = sm.sc[b][0];
#pragma unroll
          for (int j = 0; j < 4; ++j) {
            int a = ai * 16 + fq * 4 + j;
            if (a > b) sm.u.gd.NM[a][b] = sm.sc[a][1] * acc[j] * __expf(sm.sc[a][0] - Gb);
          }
        }
      }
      __syncthreads();
    } else {
      if (w == 0) {
        int tk = lane & 31;
        float ig = g0 + ibias;
        float F = -softplusf_(-(g1 + fbias));
#pragma unroll
        for (int o = 1; o < 32; o <<= 1) { float t2 = __shfl_up(F, o); if (tk >= o) F += t2; }
        float a = ig - F;
        float pm = a;
#pragma unroll
        for (int o = 1; o < 32; o <<= 1) { float t2 = __shfl_up(pm, o); if (tk >= o) pm = fmaxf(pm, t2); }
        float M = fmaxf(mcar, pm);
        if (lane < 32) { sm.sc[tk][0] = F; sm.sc[tk][1] = a; sm.sc[tk][2] = M; }
      }
      __syncthreads();
      {
        const int d = tid & 127, hh = tid >> 7;
        float Mend = sm.sc[31][2];
        mnew = sm.sc[31][0] + Mend;
        unsigned kd2[8];
#pragma unroll
        for (int i = 0; i < 16; ++i) {
          int s_ = hh * 16 + i;
          float kd = bf2f(sm.KA[s_][d]) * __expf(sm.sc[s_][1] - Mend);
          if (i & 1) kd2[i >> 1] |= ((unsigned)f2bf(kd)) << 16; else kd2[i >> 1] = (unsigned)f2bf(kd);
        }
        *(uint4*)&sm.KDT[d][hh * 16] = uint4{kd2[0], kd2[1], kd2[2], kd2[3]};
        *(uint4*)&sm.KDT[d][hh * 16 + 8] = uint4{kd2[4], kd2[5], kd2[6], kd2[7]};
      }
    }
    if (mixer == 1 && w == 0) {
      if (lane < 32) {
        const int c = lane;
        float Tc[32];
#pragma unroll
        for (int t = 0; t < 32; ++t) {
          float v = (t == c) ? 1.f : 0.f;
#pragma unroll
          for (int s4 = 0; s4 < (t + 3) / 4; ++s4) {
            float4 n4 = *(const float4*)&sm.u.gd.NM[t][s4 * 4];
            if (s4 * 4 + 0 < t) v -= n4.x * Tc[s4 * 4 + 0];
            if (s4 * 4 + 1 < t) v -= n4.y * Tc[s4 * 4 + 1];
            if (s4 * 4 + 2 < t) v -= n4.z * Tc[s4 * 4 + 2];
            if (s4 * 4 + 3 < t) v -= n4.w * Tc[s4 * 4 + 3];
          }
          Tc[t] = v;
          sm.u.gd.TM[t][c] = f2bf(v);
          __builtin_amdgcn_sched_barrier(0);
        }
      }
      { int t = lane >> 2, s4 = (lane & 3) * 4; *(uint2*)&sm.ATT[t][16 + s4] = uint2{0u, 0u}; }
    } else {
      int si, ti; bool doit = true;
      if (mixer == 1) { si = (w == 3) ? 1 : 0; ti = (w == 1) ? 0 : 1; }
      else { si = w & 1; ti = w >> 1; doit = !(si == 1 && ti == 0); }
      if (doit) {
        f32x4 acc = f32x4{0.f, 0.f, 0.f, 0.f};
#pragma unroll
        for (int kk = 0; kk < 4; ++kk)
          acc = mfma16(ldf(&sm.KA[0][0], 136, si * 16 + fr, kk * 32 + fq * 8), ldf(&sm.QA[0][0], 136, ti * 16 + fr, kk * 32 + fq * 8), acc);
        const int t = ti * 16 + fr;
        float o4[4];
        if (mixer == 0) {
#pragma unroll
          for (int j = 0; j < 4; ++j) { int s_ = si * 16 + fq * 4 + j; o4[j] = (s_ <= t) ? acc[j] : 0.f; }
        } else if (mixer == 1) {
          float Gt = sm.sc[t][0];
#pragma unroll
          for (int j = 0; j < 4; ++j) { int s_ = si * 16 + fq * 4 + j; o4[j] = (s_ <= t) ? acc[j] * __expf(Gt - sm.sc[s_][0]) : 0.f; }
        } else {
          float Mt = sm.sc[t][2];
#pragma unroll
          for (int j = 0; j < 4; ++j) { int s_ = si * 16 + fq * 4 + j; o4[j] = (s_ <= t) ? acc[j] * QS * __expf(sm.sc[s_][1] - Mt) : 0.f; }
        }
        st4(&sm.ATT[t][si * 16 + fq * 4], o4[0], o4[1], o4[2], o4[3]);
      } else {
        int t = lane >> 2, s4 = (lane & 3) * 4; *(uint2*)&sm.ATT[t][16 + s4] = uint2{0u, 0u};
      }
    }
    __syncthreads();
    if (mixer == 1) {
      f32x4 acc[2];
      acc[0] = acc[1] = f32x4{0.f, 0.f, 0.f, 0.f};
#pragma unroll
      for (int kk = 0; kk < 4; ++kk) {
        bf16x8 a = ldf(&sm.KA[0][0], 136, rt_o * 16 + fr, kk * 32 + fq * 8);
#pragma unroll
        for (int c = 0; c < 2; ++c) acc[c] = mfma16(a, ldf(&sm.ST[0][0], 136, (cp_o * 2 + c) * 16 + fr, kk * 32 + fq * 8), acc[c]);
      }
#pragma unroll
      for (int c = 0; c < 2; ++c) {
        int v = (cp_o * 2 + c) * 16 + fr;
        float y4[4];
#pragma unroll
        for (int j = 0; j < 4; ++j) {
          int t = rt_o * 16 + fq * 4 + j;
          float kg = __expf(sm.sc[t][0]);
          y4[j] = sm.sc[t][1] * (bf2f(sm.u.gd.VF[t][v]) - kg * acc[c][j]);
        }
        st4(&sm.u.gd.YT[v][rt_o * 16 + fq * 4], y4[0], y4[1], y4[2], y4[3]);
      }
      __syncthreads();
      {
        bf16x8 a = ldf(&sm.u.gd.TM[0][0], 40, rt_o * 16 + fr, fq * 8);
#pragma unroll
        for (int c = 0; c < 2; ++c) {
          int vt = cp_o * 2 + c;
          f32x4 vn = mfma16(a, ldf(&sm.u.gd.YT[0][0], 40, vt * 16 + fr, fq * 8), f32x4{0.f, 0.f, 0.f, 0.f});
          st4(&sm.XT[vt * 16 + fr][rt_o * 16 + fq * 4], vn[0], vn[1], vn[2], vn[3]);
        }
      }
      __syncthreads();
    } else if (mixer == 2) {
      int t = tid >> 3, part = tid & 7;
      float qn = 0.f;
#pragma unroll
      for (int e = 0; e < 16; ++e) qn += bf2f(sm.QA[t][part * 16 + e]) * sm.u.ml.nvec[part * 16 + e];
      float as = 0.f;
#pragma unroll
      for (int e = 0; e < 4; ++e) as += bf2f(sm.ATT[t][part * 4 + e]);
      float Mt = sm.sc[t][2];
      float den = QS * __expf(mcar - Mt) * qn + as;
      den += __shfl_xor(den, 1); den += __shfl_xor(den, 2); den += __shfl_xor(den, 4);
      if (part == 0) sm.sc[t][4] = 1.f / fmaxf(fabsf(den), __expf(-(sm.sc[t][0] + Mt)));
      __syncthreads();
    }
    {
      f32x4 acc[2];
      acc[0] = acc[1] = f32x4{0.f, 0.f, 0.f, 0.f};
      const u16* Qs = (mixer == 0) ? &sm.u.hg.QD[0][0] : &sm.QA[0][0];
#pragma unroll
      for (int kk = 0; kk < 4; ++kk) {
        bf16x8 a = ldf(Qs, 136, rt_o * 16 + fr, kk * 32 + fq * 8);
#pragma unroll
        for (int c = 0; c < 2; ++c) acc[c] = mfma16(a, ldf(&sm.ST[0][0], 136, (cp_o * 2 + c) * 16 + fr, kk * 32 + fq * 8), acc[c]);
      }
      float rs[4], fs[4];
#pragma unroll
      for (int j = 0; j < 4; ++j) {
        int t = rt_o * 16 + fq * 4 + j;
        if (mixer == 0) { rs[j] = 1.f; fs[j] = 1.f; }
        else if (mixer == 1) { rs[j] = __expf(sm.sc[t][0]); fs[j] = 1.f; }
        else { rs[j] = QS * __expf(mcar - sm.sc[t][2]); fs[j] = sm.sc[t][4]; }
      }
#pragma unroll
      for (int c = 0; c < 2; ++c)
#pragma unroll
        for (int j = 0; j < 4; ++j) acc[c][j] *= rs[j];
      {
        bf16x8 a = ldf(&sm.ATT[0][0], 40, rt_o * 16 + fr, fq * 8);
#pragma unroll
        for (int c = 0; c < 2; ++c) acc[c] = mfma16(a, ldf(&sm.XT[0][0], 40, (cp_o * 2 + c) * 16 + fr, fq * 8), acc[c]);
      }
#pragma unroll
      for (int j = 0; j < 4; ++j) {
        int t = rt_o * 16 + fq * 4 + j;
        int row = scan_row(bl, dir, pos0 + t);
        u16* dst = p.obuf + ((long)dir * TG + row) * 3072 + ocol;
#pragma unroll
        for (int c = 0; c < 2; ++c) dst[(cp_o * 2 + c) * 16 + fr] = f2bf(acc[c][j] * fs[j]);
      }
    }
    __syncthreads();
    {
      float dsc = 1.f;
      if (mixer == 1) dsc = __expf(sm.sc[31][0]);
      else if (mixer == 2) dsc = __expf(mcar - sm.sc[31][2]);
#pragma unroll
      for (int rt = 0; rt < 2; ++rt) {
        if (mixer == 0) {
          float4 d4 = *(const float4*)&sm.u.hg.dec[w * 32 + rt * 16 + fq * 4];
#pragma unroll
          for (int ct = 0; ct < 4; ++ct) { S[rt][ct][0] *= d4.x; S[rt][ct][1] *= d4.y; S[rt][ct][2] *= d4.z; S[rt][ct][3] *= d4.w; }
        } else {
#pragma unroll
          for (int ct = 0; ct < 4; ++ct) { S[rt][ct][0] *= dsc; S[rt][ct][1] *= dsc; S[rt][ct][2] *= dsc; S[rt][ct][3] *= dsc; }
        }
        bf16x8 a = ldf(&sm.KDT[0][0], 40, w * 32 + rt * 16 + fr, fq * 8);
#pragma unroll
        for (int ct = 0; ct < 4; ++ct) {
          S[rt][ct] = mfma16(a, ldf(&sm.XT[0][0], 40, ct * 16 + fr, fq * 8), S[rt][ct]);
          st4(&sm.ST[ct * 16 + fr][w * 32 + rt * 16 + fq * 4], S[rt][ct][0], S[rt][ct][1], S[rt][ct][2], S[rt][ct][3]);
        }
      }
      if (mixer == 2) {
        if (tid < 128) {
          float sum = 0.f;
#pragma unroll
          for (int e = 0; e < 32; ++e) sum += bf2f(sm.KDT[tid][e]);
          sm.u.ml.nvec[tid] = dsc * sm.u.ml.nvec[tid] + sum;
        }
        mcar = mnew;
      }
    }
    __syncthreads();
  }
}

#define MMA_MASK 7
__device__ void ph_scan(const Params& p, int l, int g, char* smem) {
  for (int u = blockIdx.x; u < 384; u += gridDim.x) {
    int mixer = u / 128;
#if MMA_MASK == 7
    scan_unit_mma(p, l, g, u, *(CSmem*)smem);
#else
    if ((MMA_MASK >> mixer) & 1) scan_unit_mma(p, l, g, u, *(CSmem*)smem);
    else scan_unit(p, l, g, u, *(ScanSmem*)smem);
#endif
  }
}

__device__ void ph_brfin(const Params& p, int l, int g) {
  const int tid = otid();
  const int lane = tid & 63;
  const int gw = blockIdx.x * 4 + (tid >> 6), nw = gridDim.x * 4;
  for (int wu = gw; wu < TG * 3; wu += nw) {
    int row = wu / 3, mixer = wu % 3;
    int pp = row % TPB;
    if (l == 1 && pp < CTX) continue;
    const u16* of = p.obuf + (long)row * 3072 + mixer * 1024 + lane * 16;
    const u16* ob = p.obuf + ((long)TG + row) * 3072 + mixer * 1024 + lane * 16;
    float o[16], t8[8];
    uint4 a0 = *(const uint4*)of, a1 = *(const uint4*)(of + 8), b0 = *(const uint4*)ob, b1 = *(const uint4*)(ob + 8);
    unpack8(a0, o); unpack8(a1, o + 8);
    unpack8(b0, t8);
#pragma unroll
    for (int e = 0; e < 8; ++e) o[e] += t8[e];
    unpack8(b1, t8);
#pragma unroll
    for (int e = 0; e < 8; ++e) o[8 + e] += t8[e];
    float ss = 0.f;
#pragma unroll
    for (int e = 0; e < 16; ++e) ss += o[e] * o[e];
    ss += __shfl_xor(ss, 1); ss += __shfl_xor(ss, 2); ss += __shfl_xor(ss, 4);
    float hd = 128.f;
    if (mixer == 2) { ss += __shfl_xor(ss, 8); hd = 256.f; }
    float rs = rsqrtf(ss / hd + 1e-6f);
    const float* on = (mixer == 0 ? p.hg_onorm : (mixer == 1 ? p.gdn_onorm : p.ml_onorm)) + l * D + lane * 16;
    int zc = mixer == 0 ? C_HGZ : (mixer == 1 ? C_GZ : C_MZ);
    const u16* zp = p.proj + (long)row * PLD + zc + lane * 16;
    float z[16];
    uint4 z0 = *(const uint4*)zp, z1 = *(const uint4*)(zp + 8);
    unpack8(z0, z); unpack8(z1, z + 8);
    float res[16];
#pragma unroll
    for (int e = 0; e < 16; ++e) res[e] = o[e] * rs * on[e] * siluf_(z[e]);
    if (mixer == 2) {
      const u16* gp = p.proj + (long)row * PLD + C_MO + lane * 16;
      uint4 g0 = *(const uint4*)gp, g1 = *(const uint4*)(gp + 8);
      unpack8(g0, z); unpack8(g1, z + 8);
#pragma unroll
      for (int e = 0; e < 16; ++e) res[e] *= sigmoidf_(z[e]);
    }
    uint4 w0, w1;
    w0.x = pack2(res[0], res[1]); w0.y = pack2(res[2], res[3]); w0.z = pack2(res[4], res[5]); w0.w = pack2(res[6], res[7]);
    w1.x = pack2(res[8], res[9]); w1.y = pack2(res[10], res[11]); w1.z = pack2(res[12], res[13]); w1.w = pack2(res[14], res[15]);
    u16* dst = p.obuf + (long)row * 3072 + mixer * 1024 + lane * 16;
    *(uint4*)dst = w0; *(uint4*)(dst + 8) = w1;
  }
}

__device__ void ph_gemm_merge(const Params& p, int l, char* smem) {
  for (int t = blockIdx.x; t < 36 * 16; t += gridDim.x) {
    int nt = t / 36, mt = t % 36;
    if (l == 1 && (mt % 9) == 0) continue;
    f32x4 tot[8][2];
#pragma unroll
    for (int m = 0; m < 8; ++m)
#pragma unroll
      for (int n = 0; n < 2; ++n) tot[m][n] = f32x4{0.f, 0.f, 0.f, 0.f};
    for (int i = 0; i < 3; ++i) {
      f32x4 acc[8][2];
#pragma unroll
      for (int m = 0; m < 8; ++m)
#pragma unroll
        for (int n = 0; n < 2; ++n) acc[m][n] = f32x4{0.f, 0.f, 0.f, 0.f};
      gemm_kloop256<2>(p.obuf + (long)mt * 256 * 3072 + i * 1024, 3072, p.WbrT + ((long)i * D + nt * 64) * D, D, D, smem, acc);
      const int tid2 = otid();
      const int wr = (tid2 >> 7) & 1, wc = (tid2 >> 6) & 1, fr = tid2 & 15, fq = (tid2 >> 4) & 3;
#pragma unroll
      for (int m = 0; m < 8; ++m) {
        int row = mt * 256 + wr * 128 + m * 16 + fr;
#pragma unroll
        for (int n = 0; n < 2; ++n) {
          int col = nt * 64 + wc * 32 + n * 16 + fq * 4;
          uint2 gr = *(const uint2*)(p.proj + (long)row * PLD + C_GATE + i * 1024 + col);
          tot[m][n][0] += sigmoidf_(__uint_as_float(gr.x << 16)) * acc[m][n][0];
          tot[m][n][1] += sigmoidf_(__uint_as_float(gr.x & 0xffff0000u)) * acc[m][n][1];
          tot[m][n][2] += sigmoidf_(__uint_as_float(gr.y << 16)) * acc[m][n][2];
          tot[m][n][3] += sigmoidf_(__uint_as_float(gr.y & 0xffff0000u)) * acc[m][n][3];
        }
      }
    }
    const int tid3 = otid();
    const int wr = (tid3 >> 7) & 1, wc = (tid3 >> 6) & 1, fr = tid3 & 15, fq = (tid3 >> 4) & 3;
#pragma unroll
    for (int m = 0; m < 8; ++m) {
      int row = mt * 256 + wr * 128 + m * 16 + fr;
#pragma unroll
      for (int n = 0; n < 2; ++n) {
        int col = nt * 64 + wc * 32 + n * 16 + fq * 4;
        uint2 o; o.x = pack2(tot[m][n][0], tot[m][n][1]); o.y = pack2(tot[m][n][2], tot[m][n][3]);
        *(uint2*)(p.hbuf + (long)row * D + col) = o;
      }
    }
  }
}

__device__ void ph_gemm_out(const Params& p, int l, int g, char* smem) {
  const int tid = otid();
  const int wid = tid >> 6, lane = tid & 63, wr = wid >> 1, wc = wid & 1, fr = lane & 15, fq = lane >> 4;
  for (int t = blockIdx.x; t < 36 * 16; t += gridDim.x) {
    int nt = t / 36, mt = t % 36;
    if (l == 1 && (mt % 9) == 0) continue;
    f32x4 acc[8][2];
#pragma unroll
    for (int m = 0; m < 8; ++m)
#pragma unroll
      for (int n = 0; n < 2; ++n) acc[m][n] = f32x4{0.f, 0.f, 0.f, 0.f};
    gemm_kloop256<2>(p.hbuf + (long)mt * 256 * D, D, p.WoT + (long)nt * 64 * D, D, D, smem, acc);
#pragma unroll
    for (int m = 0; m < 8; ++m) {
      int row = mt * 256 + wr * 128 + m * 16 + fr;
      int bl = row / TPB, pp = row % TPB, b = g * GB + bl;
      const float* src; float* dst; int mrow;
      if (pp < CTX) { src = p.ctx + ((long)b * CTX + pp) * D; dst = p.ctxs + ((long)b * CTX + pp) * D; mrow = 16; }
      else { long off = ((long)b * SEQ + (pp - CTX)) * D; src = (l == 0 ? p.x : p.out) + off; dst = p.out + off; mrow = b; }
      const float* gt = p.mod + ((long)l * 17 + mrow) * 3072 + 2048;
#pragma unroll
      for (int n = 0; n < 2; ++n) {
        int col = nt * 64 + wc * 32 + n * 16 + fq * 4;
        float4 xv = *(const float4*)(src + col), gv = *(const float4*)(gt + col);
        float4 o;
        o.x = xv.x + gv.x * acc[m][n][0]; o.y = xv.y + gv.y * acc[m][n][1];
        o.z = xv.z + gv.z * acc[m][n][2]; o.w = xv.w + gv.w * acc[m][n][3];
        *(float4*)(dst + col) = o;
      }
    }
  }
}

__device__ void ph_final(const Params& p) {
  const int tid = otid();
  const int lane = tid & 63;
  const int gw = blockIdx.x * 4 + (tid >> 6), nw = gridDim.x * 4;
  for (int row = gw; row < NB * SEQ; row += nw) {
    float4* src = (float4*)(p.out + (long)row * D);
    float4 v[4]; float ss = 0.f;
#pragma unroll
    for (int i = 0; i < 4; ++i) {
      v[i] = src[lane + 64 * i];
      ss += v[i].x * v[i].x + v[i].y * v[i].y + v[i].z * v[i].z + v[i].w * v[i].w;
    }
    ss = wave_sum(ss);
    float rs = rsqrtf(ss * (1.f / D) + 1e-6f);
#pragma unroll
    for (int i = 0; i < 4; ++i) {
      float4 g4 = ((const float4*)p.final_g)[lane + 64 * i];
      float4 o; o.x = v[i].x * rs * g4.x; o.y = v[i].y * rs * g4.y; o.z = v[i].z * rs * g4.z; o.w = v[i].w * rs * g4.w;
      src[lane + 64 * i] = o;
    }
  }
}


#define XB_TMO      128
#define XB_XCNT(j)  (256  + 64 * (j))
#define XB_XSUB(j)  (1280 + 64 * (j))
#define XB_XGEN(j)  (2304 + 64 * (j))
#define XB_TOP      3328
#define XB_TOPGEN   3392
#define XCD_BAR_WORDS 3456
#define XB_SPIN_CAP (1u << 22)
#define LAS __attribute__((address_space(3)))
__device__ __forceinline__ unsigned xb_ld(unsigned* p) { return __hip_atomic_load(p, __ATOMIC_RELAXED, __HIP_MEMORY_SCOPE_AGENT); }
__device__ __forceinline__ unsigned xb_add(unsigned* p, unsigned v) { return __hip_atomic_fetch_add(p, v, __ATOMIC_RELAXED, __HIP_MEMORY_SCOPE_AGENT); }
__device__ __forceinline__ unsigned xb_xcc_id() { return (unsigned)__builtin_amdgcn_s_getreg((3 << 11) | 20) & 0xFu; }
#define XB_SPIN(cond, bar) do { unsigned _sp = 0; while (cond) { __builtin_amdgcn_s_sleep(1); \
    if ((++_sp & 255u) == 0u) { if (xb_ld(&(bar)[XB_TMO])) break; if (_sp > XB_SPIN_CAP) { atomicAdd(&(bar)[XB_TMO], 1u); break; } } } } while (0)
struct XcdBarrier { unsigned* bar; unsigned x; volatile LAS unsigned* st; };
__device__ __forceinline__ XcdBarrier xcd_barrier_post(unsigned* bar, volatile LAS unsigned* st) {
  XcdBarrier b; b.bar = bar; b.x = xb_xcc_id(); b.st = st;
  if (threadIdx.x == 0) (void)xb_add(&bar[XB_XCNT(b.x)], 1u);
  return b;
}
__device__ __forceinline__ void xcd_barrier_complete(unsigned* bar, unsigned x, unsigned& nloc, unsigned& nx) {
  const unsigned G = gridDim.x * gridDim.y * gridDim.z;
  unsigned sum, cnt, mine, sp = 0u;
  for (;;) {
    sum = 0u; cnt = 0u; mine = 0u;
#pragma unroll
    for (unsigned j = 0; j < 16; ++j) { const unsigned c = xb_ld(&bar[XB_XCNT(j)]); sum += c; cnt += (c > 0u) ? 1u : 0u; mine = (j == x) ? c : mine; }
    if (sum == G) break;
    __builtin_amdgcn_s_sleep(1);
    if ((++sp & 255u) == 0u) { if (xb_ld(&bar[XB_TMO])) break; if (sp > XB_SPIN_CAP) { atomicAdd(&bar[XB_TMO], 1u); break; } }
  }
  nloc = mine > 0u ? mine : 1u; nx = cnt > 0u ? cnt : 1u;
}
__device__ __forceinline__ void xcd_barrier(const XcdBarrier& b) {
  asm volatile("s_waitcnt vmcnt(0)" ::: "memory");
  __syncthreads();
  if (threadIdx.x == 0) {
    unsigned* bar = b.bar;
    __builtin_amdgcn_s_waitcnt(0);
    unsigned nloc = b.st[0], nx = b.st[1];
    if (nloc == 0u) { xcd_barrier_complete(bar, b.x, nloc, nx); b.st[0] = nloc; b.st[1] = nx; }
    const unsigned old = xb_add(&bar[XB_XSUB(b.x)], 1u);
    const unsigned gen = old / nloc;
    if (old + 1u == (gen + 1u) * nloc) {
      __builtin_amdgcn_fence(__ATOMIC_RELEASE, "agent");
      asm volatile("s_waitcnt vmcnt(0)" ::: "memory");
      const unsigned og = xb_add(&bar[XB_TOP], 1u);
      const unsigned tg = og / nx;
      if (og + 1u == (tg + 1u) * nx) xb_add(&bar[XB_TOPGEN], 1u);
      else XB_SPIN(xb_ld(&bar[XB_TOPGEN]) == tg, bar);
      __builtin_amdgcn_fence(__ATOMIC_ACQUIRE, "agent");
      xb_add(&bar[XB_XGEN(b.x)], 1u);
      asm volatile("s_waitcnt vmcnt(0)" ::: "memory");
    } else {
      XB_SPIN(xb_ld(&bar[XB_XGEN(b.x)]) == gen, bar);
      __builtin_amdgcn_fence(__ATOMIC_ACQUIRE, "agent");
      asm volatile("s_waitcnt vmcnt(0)" ::: "memory");
    }
  }
  __syncthreads();
}

constexpr int NSTEPS = 2 + 24 + 1 + 24 + 1;

__device__ void run_step(const Params& p, int step, char* smem) {
  if (step == 0) { ph_convert(p, 0, smem); ph_prep_small(p); return; }
  if (step == 1) { ph_mod(p, smem); return; }
  if (step == 26) { ph_convert(p, 1, smem); return; }
  if (step == NSTEPS - 1) { ph_final(p); return; }
  int l, s;
  if (step < 26) { l = 0; s = step - 2; } else { l = 1; s = step - 27; }
  int g = s / 6, k = s % 6;
  switch (k) {
    case 0: ph_prenorm(p, l, g); break;
    case 1: ph_gemm_in(p, smem); break;
    case 2: ph_scan(p, l, g, smem); break;
    case 3: ph_brfin(p, l, g); break;
    case 4: ph_gemm_merge(p, l, smem); break;
    case 5: ph_gemm_out(p, l, g, smem); break;
  }
}

#if !COOP
__global__ void __launch_bounds__(256, 2) k_step(Params p, int step) {
  __shared__ __attribute__((aligned(16))) char smem[73728];
  run_step(p, step, smem);
}
#else
__global__ void __launch_bounds__(256, 2) k_mega(Params p) {
  __shared__ __attribute__((aligned(16))) char smem[73728];
  __shared__ uint4 xb_words;
  cg::grid_group grid = cg::this_grid();
  if (threadIdx.x == 0) xb_words = make_uint4(0u, 0u, 0u, 0u);
  __syncthreads();
  XcdBarrier xb = xcd_barrier_post(p.bar, (volatile LAS unsigned*)&xb_words);
#define GSYNC() xcd_barrier(xb)
  ph_prep_small(p);
#pragma unroll 1
  for (int l = 0; l < 2; ++l) {
    ph_convert(p, l, smem);
    if (l == 0) { grid.sync(); ph_mod(p, smem); }
    GSYNC();
#pragma unroll 1
    for (int g = 0; g < NGRP; ++g) {
      ph_prenorm(p, l, g); GSYNC();
      ph_gemm_in(p, smem); GSYNC();
      ph_conv(p, l); GSYNC();
      ph_scan(p, l, g, smem); GSYNC();
      ph_brfin(p, l, g); GSYNC();
      ph_gemm_merge(p, l, smem); GSYNC();
      ph_gemm_out(p, l, g, smem); GSYNC();
    }
  }
  ph_final(p);
}
#endif

extern "C" void kernel_launch(void* const* d_in, const int* in_sizes, int n_in, void* d_out, int out_size, void* d_ws,
                              size_t ws_size, hipStream_t stream) {
  Params p{};
  p.x = (const float*)d_in[0]; p.c = (const float*)d_in[1]; p.ctx = (const float*)d_in[2]; p.c_ctx = (const float*)d_in[3];
  p.ada_w = (const float*)d_in[4]; p.ada_b = (const float*)d_in[5]; p.norm_g = (const float*)d_in[6]; p.w_in = (const float*)d_in[7];
  p.hg_lb = (const float*)d_in[8]; p.hg_onorm = (const float*)d_in[9]; p.gdn_conv = (const float*)d_in[10];
  p.gdn_a_log = (const float*)d_in[11]; p.gdn_dt_bias = (const float*)d_in[12]; p.gdn_onorm = (const float*)d_in[13];
  p.ml_i_bias = (const float*)d_in[14]; p.ml_f_bias = (const float*)d_in[15]; p.ml_onorm = (const float*)d_in[16];
  p.w_branch = (const float*)d_in[17]; p.w_out = (const float*)d_in[18]; p.final_g = (const float*)d_in[19];
  p.out = (float*)d_out;
  char* ws = (char*)d_ws;
  size_t off = 0;
  auto take = [&](size_t bytes) { char* r = ws + off; off += (bytes + 255) & ~(size_t)255; return r; };
  p.WinT = (u16*)take((size_t)NPAD * D * 2);
  p.WbrT = (u16*)take((size_t)3 * D * D * 2);
  p.WoT = (u16*)take((size_t)D * D * 2);
  p.hbuf = (u16*)take((size_t)TG * D * 2);
  p.proj = (u16*)take((size_t)TG * PLD * 2);
  p.obuf = (u16*)take((size_t)2 * TG * 3072 * 2);
  p.mod = (float*)take((size_t)2 * 17 * 3072 * 4);
  p.lb = (float*)take((size_t)2 * D * 4);
  p.silc = (float*)take((size_t)17 * D * 4);
  p.gates = (float*)take((size_t)TG * GLD * 4);
  p.ctxs = (float*)take((size_t)NB * CTX * D * 4);
  p.bar = (unsigned*)take((size_t)XCD_BAR_WORDS * 4);
  if (off > ws_size) { fprintf(stderr, "workspace too small: need %zu have %zu\n", off, ws_size); return; }

  static int grid_blocks = 0;
  if (!grid_blocks) {
    int dev = 0, cus = 0, per_cu = 0;
    hipGetDevice(&dev);
    hipDeviceGetAttribute(&cus, hipDeviceAttributeMultiprocessorCount, dev);
#if COOP
    hipOccupancyMaxActiveBlocksPerMultiprocessor(&per_cu, k_mega, 256, 0);
#else
    hipOccupancyMaxActiveBlocksPerMultiprocessor(&per_cu, k_step, 256, 0);
#endif
    if (per_cu < 1) per_cu = 1;
    if (per_cu > 2) per_cu = 2;
    grid_blocks = cus * per_cu;
  }
#if COOP
  hipMemsetAsync(p.bar, 0, (size_t)XCD_BAR_WORDS * 4, stream);
  void* args[] = {&p};
  hipError_t e = hipLaunchCooperativeKernel((void*)k_mega, dim3(grid_blocks), dim3(256), args, 0, stream);
  if (e != hipSuccess) fprintf(stderr, "cooperative launch failed: %s (grid %d)\n", hipGetErrorString(e), grid_blocks);
#else
  for (int s = 0; s < NSTEPS; ++s) k_step<<<grid_blocks, 256, 0, stream>>>(p, s);
#endif
}
```

```cpp
#include <hip/hip_runtime.h>
#include <hip/hip_bf16.h>
#include <hip/hip_cooperative_groups.h>
#include <cstdio>
namespace cg = cooperative_groups;

#define REP_PRE 1
#define REP_GIN 1
#define REP_SCAN 1
#define REP_MRG 1
#define REP_SYNC 0
#define SPL_G 3
#define SPL_H 3
#define SPL_M 1
#define SPL_F 9
#define XB_CTR(j)  (3456 + 64 * (j))
#define BAR_TOTAL_WORDS (3456 + 8 * 64)
#ifndef COOP
#define COOP 1
#endif

typedef unsigned short u16;
using bf16x8 = __attribute__((ext_vector_type(8))) short;
using f32x4 = __attribute__((ext_vector_type(4))) float;

constexpr int D = 1024;
constexpr int NB = 16;
constexpr int SEQ = 2048;
constexpr int CTX = 256;
constexpr int TPB = SEQ + CTX;
constexpr int GB = 4;
constexpr int NGRP = NB / GB;
constexpr int TG = GB * TPB;
constexpr int IN_DIM = 16432;
constexpr int NPAD = 16512;
constexpr int PLD = 16384;
constexpr int GLD = 64;
constexpr int TC = 32;
constexpr int C_HGQ = 0, C_HGI = 1024, C_HGF = 2048, C_HGZ = 4096;
constexpr int C_GQ = 5120, C_GK = 6144, C_GV = 7168, C_GZ = 8192;
constexpr int C_MQ = 9216, C_MK = 9728, C_MV = 10240, C_MO = 11264, C_MZ = 12288;
constexpr int C_GATE = 13312;

struct Params {
  const float *x, *c, *ctx, *c_ctx, *ada_w, *ada_b, *norm_g, *w_in, *hg_lb, *hg_onorm, *gdn_conv,
      *gdn_a_log, *gdn_dt_bias, *gdn_onorm, *ml_i_bias, *ml_f_bias, *ml_onorm, *w_branch, *w_out, *final_g;
  float* out;
  u16 *WinT, *WbrT, *WoT, *hbuf, *proj, *obuf;
  float *mod, *lb, *silc, *gates, *ctxs;
  unsigned* bar;
  u16* gprep;
  float* mprep;
};

typedef __bf16 bf16v2 __attribute__((ext_vector_type(2)));
typedef float f32v2 __attribute__((ext_vector_type(2)));
__device__ __forceinline__ unsigned pack2(float a, float b) {
  f32v2 v = {a, b};
  return __builtin_bit_cast(unsigned, __builtin_convertvector(v, bf16v2));
}
__device__ __forceinline__ u16 f2bf(float f) { return (u16)(pack2(f, 0.f) & 0xffffu); }
__device__ __forceinline__ float bf2f(u16 h) { return __uint_as_float(((unsigned)h) << 16); }
__device__ __forceinline__ float sigmoidf_(float x) { return 1.f / (1.f + __expf(-x)); }
__device__ __forceinline__ float siluf_(float x) { return x / (1.f + __expf(-x)); }
__device__ __forceinline__ float softplusf_(float y) { return fmaxf(y, 0.f) + log1pf(__expf(-fabsf(y))); }
__device__ __forceinline__ float wave_sum(float v) {
#pragma unroll
  for (int o = 32; o >= 1; o >>= 1) v += __shfl_xor(v, o);
  return v;
}
__device__ __forceinline__ void unpack8(const uint4& u, float* f) {
  f[0] = __uint_as_float(u.x << 16); f[1] = __uint_as_float(u.x & 0xffff0000u);
  f[2] = __uint_as_float(u.y << 16); f[3] = __uint_as_float(u.y & 0xffff0000u);
  f[4] = __uint_as_float(u.z << 16); f[5] = __uint_as_float(u.z & 0xffff0000u);
  f[6] = __uint_as_float(u.w << 16); f[7] = __uint_as_float(u.w & 0xffff0000u);
}

__device__ __forceinline__ int otid() { int t = threadIdx.x; asm volatile("" : "+v"(t)); return t; }
__device__ __forceinline__ int win_src_col(int np) {
  if (np < 9216) return np;
  if (np < 13312) return np + 32;
  if (np < 16384) return np + 48;
  if (np < 16416) return 9216 + (np - 16384);
  if (np < 16432) return 13344 + (np - 16416);
  return -1;
}

__device__ void ph_convert(const Params& p, int l, char* smem) {
  float (*tile)[65] = (float (*)[65])smem;
  const int tid = otid();
  for (int t = blockIdx.x; t < 5152; t += gridDim.x) {
    const float* src; long sld; u16* dst; int n0, k0, kind; long ntot = D;
    if (t < 4128) { kind = 0; ntot = NPAD; n0 = (t / 16) * 64; k0 = (t % 16) * 64; src = p.w_in + (long)l * D * IN_DIM; sld = IN_DIM; dst = p.WinT; }
    else if (t < 4896) { int u = t - 4128; int i = u / 256; u %= 256; kind = 1; n0 = (u / 16) * 64; k0 = (u % 16) * 64;
      src = p.w_branch + ((long)l * 3 + i) * D * D; sld = D; dst = p.WbrT + (long)i * D * D; }
    else { int u = t - 4896; kind = 1; n0 = (u / 16) * 64; k0 = (u % 16) * 64; src = p.w_out + (long)l * D * D; sld = D; dst = p.WoT; }
#pragma unroll 4
    for (int i = 0; i < 16; ++i) {
      int kk = (tid >> 6) + 4 * i, nn = tid & 63;
      int np = n0 + nn;
      int ns = kind == 0 ? win_src_col(np) : np;
      tile[kk][nn] = ns >= 0 ? src[(long)(k0 + kk) * sld + ns] : 0.f;
    }
    __syncthreads();
#pragma unroll 4
    for (int i = 0; i < 16; ++i) {
      int nn = (tid >> 6) + 4 * i, kk = tid & 63;
      dst[((long)((k0 + kk) >> 5) * ntot + (n0 + nn)) * 32 + ((k0 + kk) & 31)] = f2bf(tile[kk][nn]);
    }
    __syncthreads();
  }
}

__device__ void ph_prep_small(const Params& p) {
  int gt = blockIdx.x * blockDim.x + otid(), gs = gridDim.x * blockDim.x;
  for (int j = gt; j < 2 * D; j += gs) {
    if (j < D) p.lb[j] = 0.f;
    else { int ch = j - D; p.lb[j] = sigmoidf_(p.hg_lb[D + ch] - p.hg_lb[ch]); }
  }
}

__device__ void ph_mod(const Params& p, char* smem) {
  float (*sl)[D] = (float (*)[D])smem;
  float (*red)[17][64] = (float (*)[17][64])smem;
  const int tid = otid();
  const int kq = __builtin_amdgcn_readfirstlane(tid >> 6), cc = tid & 63;
  for (int u = blockIdx.x; u < 96; u += gridDim.x) {
    for (int i = tid; i < 17 * D; i += 256) sl[0][i] = siluf_(i < 16 * D ? p.c[i] : p.c_ctx[i - 16 * D]);
    __syncthreads();
    int l = u / 48, col = (u % 48) * 64 + cc;
    float acc[17];
#pragma unroll
    for (int r = 0; r < 17; ++r) acc[r] = 0.f;
    const float* w = p.ada_w + (long)l * D * 3072 + col;
#pragma unroll 4
    for (int k = kq * 256; k < kq * 256 + 256; ++k) {
      float wv = w[(long)k * 3072];
#pragma unroll
      for (int r = 0; r < 17; ++r) acc[r] += sl[r][k] * wv;
    }
    __syncthreads();
#pragma unroll
    for (int r = 0; r < 17; ++r) red[kq][r][cc] = acc[r];
    __syncthreads();
    for (int i = tid; i < 17 * 64; i += 256) {
      int r = i / 64, c2 = i % 64;
      int colo = (u % 48) * 64 + c2;
      float s_ = red[0][r][c2] + red[1][r][c2] + red[2][r][c2] + red[3][r][c2] + p.ada_b[l * 3072 + colo];
      p.mod[((long)l * 17 + r) * 3072 + colo] = s_;
    }
    __syncthreads();
  }
}

__device__ void ph_prenorm(const Params& p, int l, int g) {
  const int tid = otid();
  const int lane = tid & 63;
  const int gw = blockIdx.x * 4 + (tid >> 6), nw = gridDim.x * 4;
  for (int row = gw; row < TG; row += nw) {
    int bl = row / TPB, pp = row % TPB, b = g * GB + bl;
    const float* src; int mrow;
    if (pp < CTX) { src = (l == 0 ? p.ctx : p.ctxs) + ((long)b * CTX + pp) * D; mrow = 16; }
    else { src = (l == 0 ? p.x : p.out) + ((long)b * SEQ + (pp - CTX)) * D; mrow = b; }
    const float* md = p.mod + ((long)l * 17 + mrow) * 3072;
    float4 v[4]; float ss = 0.f;
#pragma unroll
    for (int i = 0; i < 4; ++i) {
      v[i] = ((const float4*)src)[lane + 64 * i];
      ss += v[i].x * v[i].x + v[i].y * v[i].y + v[i].z * v[i].z + v[i].w * v[i].w;
    }
    ss = wave_sum(ss);
    float rs = rsqrtf(ss * (1.f / D) + 1e-6f);
#pragma unroll
    for (int i = 0; i < 4; ++i) {
      int idx = (lane + 64 * i) * 4;
      float4 g4 = *(const float4*)(p.norm_g + l * D + idx);
      float4 sh = *(const float4*)(md + idx);
      float4 sc = *(const float4*)(md + D + idx);
      float h0 = v[i].x * rs * g4.x * (1.f + sc.x) + sh.x;
      float h1 = v[i].y * rs * g4.y * (1.f + sc.y) + sh.y;
      float h2 = v[i].z * rs * g4.z * (1.f + sc.z) + sh.z;
      float h3 = v[i].w * rs * g4.w * (1.f + sc.w) + sh.w;
      uint2 o; o.x = pack2(h0, h1); o.y = pack2(h2, h3);
      *(uint2*)(p.hbuf + ((long)(idx >> 5) * TG + row) * 32 + (idx & 31)) = o;
    }
  }
}

template <int MF, int NF>
__device__ __forceinline__ void gemm_kloopT(const u16* Ag, long lda, long aks, const u16* Bg, long ldb, long bks, int K, char* smem, f32x4 (&acc)[MF][NF]) {
  const int tid = otid();
  const int wid = tid >> 6, lane = tid & 63, wr = wid >> 1, wc = wid & 1, fr = lane & 15, fq = lane >> 4;
  constexpr int ASZ = MF * 32 * 64;
  constexpr int BSZ = NF * 32 * 64;
  constexpr int SSZ = ASZ + BSZ;
  constexpr int NLD = MF / 2 + NF / 2;
  const int lrow = tid >> 2, cs = tid & 3;
  const int cgl = cs ^ (((lrow >> 3) & 1) << 1);
  const u16* Ap = Ag + (long)lrow * lda + cgl * 8;
  const u16* Bp = Bg + (long)lrow * ldb + cgl * 8;
  const int nt = K / 32;
#define GK_ISSUE(T, S)                                                                                                   \
  {                                                                                                                      \
    char* _SA = smem + (S) * SSZ; char* _SB = _SA + ASZ;                                                                 \
    _Pragma("unroll") for (int _i = 0; _i < MF / 2; ++_i)                                                                \
      __builtin_amdgcn_global_load_lds((const unsigned*)(Ap + (long)_i * 64 * lda + (long)(T) * aks),                           \
                                       (__attribute__((address_space(3))) unsigned*)(_SA + _i * 4096 + tid * 16), 16, 0, 0); \
    _Pragma("unroll") for (int _i = 0; _i < NF / 2; ++_i)                                                                \
      __builtin_amdgcn_global_load_lds((const unsigned*)(Bp + (long)_i * 64 * ldb + (long)(T) * bks),                           \
                                       (__attribute__((address_space(3))) unsigned*)(_SB + _i * 4096 + tid * 16), 16, 0, 0); \
  }
  GK_ISSUE(0, 0)
  GK_ISSUE(1, 1)
  const int co = (fq ^ (((fr >> 3) & 1) << 1)) * 16;
#define GK_STEP(T, ST, S2, LAST1, LAST2)                                                                                 \
  {                                                                                                                      \
    if (!(LAST1)) asm volatile("s_waitcnt vmcnt(%0)" ::"n"(NLD) : "memory");                                             \
    else asm volatile("s_waitcnt vmcnt(0)" ::: "memory");                                                                \
    __builtin_amdgcn_s_barrier();                                                                                        \
    if (!(LAST2)) GK_ISSUE((T) + 2, S2)                                                                                  \
    bf16x8 At[MF], Bl[NF];                                                                                               \
    _Pragma("unroll") for (int m = 0; m < MF; ++m)                                                                       \
      asm volatile("ds_read_b128 %0, %1 offset:%2" : "=v"(At[m]) : "v"(aA), "n"((ST) * SSZ + m * 1024));                  \
    _Pragma("unroll") for (int n = 0; n < NF; ++n)                                                                       \
      asm volatile("ds_read_b128 %0, %1 offset:%2" : "=v"(Bl[n]) : "v"(aB), "n"((ST) * SSZ + n * 1024));                  \
    if (MF == 8 && NF == 4)                                                                                              \
      asm volatile("s_waitcnt lgkmcnt(0)" : "+v"(At[0]), "+v"(At[1]), "+v"(At[2]), "+v"(At[3]), "+v"(At[MF - 4]), "+v"(At[MF - 3]), \
                   "+v"(At[MF - 2]), "+v"(At[MF - 1]), "+v"(Bl[0]), "+v"(Bl[1]), "+v"(Bl[NF - 2]), "+v"(Bl[NF - 1]));    \
    else if (MF == 8)                                                                                                    \
      asm volatile("s_waitcnt lgkmcnt(0)" : "+v"(At[0]), "+v"(At[1]), "+v"(At[2]), "+v"(At[3]), "+v"(At[MF - 4]), "+v"(At[MF - 3]), \
                   "+v"(At[MF - 2]), "+v"(At[MF - 1]), "+v"(Bl[0]), "+v"(Bl[1]));                                        \
    else                                                                                                                 \
      asm volatile("s_waitcnt lgkmcnt(0)" : "+v"(At[0]), "+v"(At[1]), "+v"(At[2]), "+v"(At[3]),                          \
                   "+v"(Bl[0]), "+v"(Bl[1]), "+v"(Bl[NF - 2]), "+v"(Bl[NF - 1]));                                        \
    _Pragma("unroll") for (int m = 0; m < MF; ++m)                                                                       \
      _Pragma("unroll") for (int n = 0; n < NF; ++n)                                                                     \
        acc[m][n] = __builtin_amdgcn_mfma_f32_16x16x32_bf16(Bl[n], At[m], acc[m][n], 0, 0, 0);                           \
  }
  const unsigned lds0 = (unsigned)(unsigned long)(__attribute__((address_space(3))) const char*)smem;
  const unsigned aA = lds0 + (wr * MF * 16 + fr) * 64 + co;
  const unsigned aB = lds0 + ASZ + (wc * NF * 16 + fr) * 64 + co;
  for (int t = 0; t < nt - 2; t += 3) {
    GK_STEP(t, 0, 2, false, false)
    GK_STEP(t + 1, 1, 0, false, false)
    GK_STEP(t + 2, 2, 1, false, false)
  }
  GK_STEP(nt - 2, 0, 2, false, true)
  GK_STEP(nt - 1, 1, 0, true, true)
#undef GK_STEP
  __builtin_amdgcn_s_barrier();
#undef GK_ISSUE
}

template <int MF>
__device__ __forceinline__ void gemm_in_tile(const Params& p, int l, char* smem, int mt, int nt) {
  f32x4 acc[MF][4];
#pragma unroll
  for (int m = 0; m < MF; ++m)
#pragma unroll
    for (int n = 0; n < 4; ++n) acc[m][n] = f32x4{0.f, 0.f, 0.f, 0.f};
  gemm_kloopT<MF, 4>(p.hbuf + (long)mt * (MF * 32) * 32, 32, (long)TG * 32, p.WinT + (long)nt * 128 * 32, 32, (long)NPAD * 32, D, smem, acc);
  const int tid = otid();
  const int wr = (tid >> 7) & 1, wc = (tid >> 6) & 1, fr = tid & 15, fq = (tid >> 4) & 3;
  if (nt < 128) {
    u16* dbase; long dld; int cb;
    if (nt >= 40 && nt < 64) { dbase = p.obuf; dld = 3072; cb = (nt - 40) * 128; }
    else { dbase = p.proj; dld = PLD; cb = nt * 128; }
#pragma unroll
    for (int m = 0; m < MF; ++m) {
      int row = mt * (MF * 32) + wr * (MF * 16) + m * 16 + fr;
#pragma unroll
      for (int n = 0; n < 4; ++n) {
        int col = cb + wc * 64 + n * 16 + fq * 4;
        if (nt >= 16 && nt < 32) {
          float4 lb4 = *(const float4*)(p.lb + l * D + ((col - C_HGF) & 1023));
          acc[m][n][0] = __logf(lb4.x + (1.f - lb4.x) * sigmoidf_(acc[m][n][0]));
          acc[m][n][1] = __logf(lb4.y + (1.f - lb4.y) * sigmoidf_(acc[m][n][1]));
          acc[m][n][2] = __logf(lb4.z + (1.f - lb4.z) * sigmoidf_(acc[m][n][2]));
          acc[m][n][3] = __logf(lb4.w + (1.f - lb4.w) * sigmoidf_(acc[m][n][3]));
        }
        uint2 o; o.x = pack2(acc[m][n][0], acc[m][n][1]); o.y = pack2(acc[m][n][2], acc[m][n][3]);
        *(uint2*)(dbase + (long)row * dld + col) = o;
      }
    }
  } else if (wc == 0) {
#pragma unroll
    for (int m = 0; m < MF; ++m) {
      int row = mt * (MF * 32) + wr * (MF * 16) + m * 16 + fr;
#pragma unroll
      for (int n = 0; n < 4; ++n) {
        int col = n * 16 + fq * 4;
        *(float4*)(p.gates + (long)row * GLD + col) = float4{acc[m][n][0], acc[m][n][1], acc[m][n][2], acc[m][n][3]};
      }
    }
  }
}

__device__ void ph_gemm_in_a(const Params& p, int l, char* smem) {
  for (int t = blockIdx.x; t < 36 * 73; t += gridDim.x) {
    int i = t / 36, mt = t % 36;
    int nt = i < 32 ? i : (i < 56 ? 40 + (i - 32) : (i < 72 ? 72 + (i - 56) : 128));
    gemm_in_tile<8>(p, l, smem, mt, nt);
  }
}
__device__ __forceinline__ void gemm_in_b_tile(const Params& p, int l, char* smem, int tb) {
  constexpr int QB_ALL = 36 * 56, QB_TAIL = 256, QB_BIG = QB_ALL - QB_TAIL;
  int half = -1;
  if (tb >= QB_BIG) { int hb = tb - QB_BIG; tb = QB_BIG + (hb >> 1); half = hb & 1; }
  int i = tb / 36, mt = tb % 36;
  if (l == 1 && (mt % 9) == 0) return;
  int nt = i < 8 ? 32 + i : (i < 16 ? 64 + (i - 8) : 88 + (i - 16));
  if (half < 0) gemm_in_tile<8>(p, l, smem, mt, nt);
  else gemm_in_tile<4>(p, l, smem, mt * 2 + half, nt);
}
constexpr int QB_END = 36 * 56 + 256;

__device__ void ph_conv(const Params& p, int l) {
  const int tid = otid();
  const int lane = tid & 63;
  const int gw = blockIdx.x * 4 + (tid >> 6), nw = gridDim.x * 4;
  const u16* stg = p.obuf;
  const int h = gw & 7;
  const int part = lane >> 4, c8 = lane & 15;
  const int chn = (part < 3 ? part : 0) * 1024 + h * 128 + c8 * 8;
  float4 wa[9], wb[9];
  {
    const float* cwb = p.gdn_conv + (long)l * 9 * 3072 + chn;
#pragma unroll
    for (int k = 0; k < 9; ++k) { wa[k] = *(const float4*)(cwb + k * 3072); wb[k] = *(const float4*)(cwb + k * 3072 + 4); }
  }
  uint4 nx0, nx1, nx2, nx3, nx4, nx5, nx6, nx7, nx8;
#define CONV_LOAD(TASK)                                                                                        \
  {                                                                                                            \
    const uint4 _z = uint4{0u, 0u, 0u, 0u};                                                                    \
    nx0 = nx1 = nx2 = nx3 = nx4 = nx5 = nx6 = nx7 = nx8 = _z;                                                  \
    if ((TASK) < TG * 8 && part < 3) {                                                                         \
      int _row = (TASK) >> 3, _bl = _row / TPB, _t = _row % TPB;                                               \
      const u16* _b = stg + (long)_bl * TPB * 3072 + chn;                                                      \
      if (_t < CTX) {                                                                                          \
        if (_t > 0) nx3 = *(const uint4*)(_b + (long)(_t - 1) * 3072);                                         \
        nx4 = *(const uint4*)(_b + (long)_t * 3072);                                                           \
        if (_t < CTX - 1) nx5 = *(const uint4*)(_b + (long)(_t + 1) * 3072);                                   \
      } else {                                                                                                 \
        int _lt = _t - CTX, _r = _lt >> 6, _c = _lt & 63;                                                      \
        const u16* _q = _b + (long)(CTX + _lt) * 3072;                                                         \
        bool _u = _r > 0, _d = _r < 31, _l = _c > 0, _rr = _c < 63;                                            \
        if (_u && _l) nx0 = *(const uint4*)(_q - 65 * 3072);                                                   \
        if (_u) nx1 = *(const uint4*)(_q - 64 * 3072);                                                         \
        if (_u && _rr) nx2 = *(const uint4*)(_q - 63 * 3072);                                                  \
        if (_l) nx3 = *(const uint4*)(_q - 1 * 3072);                                                          \
        nx4 = *(const uint4*)(_q);                                                                             \
        if (_rr) nx5 = *(const uint4*)(_q + 1 * 3072);                                                         \
        if (_d && _l) nx6 = *(const uint4*)(_q + 63 * 3072);                                                   \
        if (_d) nx7 = *(const uint4*)(_q + 64 * 3072);                                                         \
        if (_d && _rr) nx8 = *(const uint4*)(_q + 65 * 3072);                                                  \
      }                                                                                                        \
    }                                                                                                          \
  }
#define CONV_TAP(R, K)                                                                                         \
  {                                                                                                            \
    float xv[8]; unpack8(R, xv);                                                                               \
    val[0] += xv[0] * wa[K].x; val[1] += xv[1] * wa[K].y; val[2] += xv[2] * wa[K].z; val[3] += xv[3] * wa[K].w; \
    val[4] += xv[4] * wb[K].x; val[5] += xv[5] * wb[K].y; val[6] += xv[6] * wb[K].z; val[7] += xv[7] * wb[K].w; \
  }
  CONV_LOAD(gw)
  for (int task = gw; task < TG * 8; task += nw) {
    const uint4 c0 = nx0, c1 = nx1, c2 = nx2, c3 = nx3, c4 = nx4, c5 = nx5, c6 = nx6, c7 = nx7, c8r = nx8;
    CONV_LOAD(task + nw)
    int row = task >> 3;
    float val[8];
#pragma unroll
    for (int e = 0; e < 8; ++e) val[e] = 0.f;
    CONV_TAP(c0, 0) CONV_TAP(c1, 1) CONV_TAP(c2, 2) CONV_TAP(c3, 3) CONV_TAP(c4, 4)
    CONV_TAP(c5, 5) CONV_TAP(c6, 6) CONV_TAP(c7, 7) CONV_TAP(c8r, 8)
    float ss = 0.f;
#pragma unroll
    for (int e = 0; e < 8; ++e) { val[e] = siluf_(val[e]); ss += val[e] * val[e]; }
    ss += __shfl_xor(ss, 1); ss += __shfl_xor(ss, 2); ss += __shfl_xor(ss, 4); ss += __shfl_xor(ss, 8);
    float scl = 1.f;
    if (part == 0) scl = rsqrtf(ss + 1e-6f) * 0.08838834764831845f;
    else if (part == 1) scl = rsqrtf(ss + 1e-6f);
    if (part < 3) {
      uint4 o;
      o.x = pack2(val[0] * scl, val[1] * scl); o.y = pack2(val[2] * scl, val[3] * scl);
      o.z = pack2(val[4] * scl, val[5] * scl); o.w = pack2(val[6] * scl, val[7] * scl);
      *(uint4*)(p.proj + (long)row * PLD + C_GQ + chn) = o;
    }
  }
#undef CONV_LOAD
#undef CONV_TAP
}

struct ScanSmem {
  float q[TC][128];
  float k[TC][128];
  float f[TC][128];
  float v[TC][64];
  float sc[TC][4];
};

__device__ __forceinline__ int scan_row(int bl, int dir, int pos) {
  int t;
  if (pos < CTX) t = dir ? (CTX - 1 - pos) : pos;
  else { int u = pos - CTX; t = CTX + (dir ? (SEQ - 1 - u) : u); }
  return bl * TPB + t;
}

__device__ void scan_unit(const Params& p, int l, int g, int u, ScanSmem& sm) {
  const int tid = otid(), lane = tid & 63, w = tid >> 6;
  const int j = lane & 15, gq = lane >> 4;
  const int mixer = u / 128, r = u % 128;
  int bl, h, dir, vs;
  bl = r / 32;
  if (mixer < 2) { h = (r % 32) / 4; dir = (r % 4) / 2; vs = r % 2; }
  else { h = (r % 32) / 8; dir = (r % 8) / 4; vs = r % 4; }
  int cq, ck, cv, ocol;
  if (mixer == 0) { cq = C_HGQ + h * 128; ck = C_HGF + dir * 1024 + h * 128; cv = C_HGI + h * 128 + vs * 64; ocol = h * 128 + vs * 64; }
  else if (mixer == 1) { cq = C_GQ + h * 128; ck = C_GK + h * 128; cv = C_GV + h * 128 + vs * 64; ocol = 1024 + h * 128 + vs * 64; }
  else { cq = C_MQ + h * 128; ck = C_MK + h * 128; cv = C_MV + h * 256 + vs * 64; ocol = 2048 + h * 256 + vs * 64; }

  float S[32];
#pragma unroll
  for (int i = 0; i < 32; ++i) S[i] = 0.f;
  float n0 = 0.f, n1 = 0.f;
  float mstate = 0.f;
  float gA = 0.f, gDt = 0.f, ibias = 0.f, fbias = 0.f;
  if (mixer == 1) { gA = -__expf(p.gdn_a_log[l * 16 + dir * 8 + h]); gDt = p.gdn_dt_bias[l * 16 + dir * 8 + h]; }
  if (mixer == 2) { ibias = p.ml_i_bias[l * 8 + dir * 4 + h]; fbias = p.ml_f_bias[l * 8 + dir * 4 + h]; }

  __syncthreads();
  if (mixer == 1) {
    float* cw = &sm.f[0][0];
    for (int i = tid; i < 9 * 320; i += 256) {
      int tap = i / 320, lc = i % 320;
      int ch = lc < 128 ? (h * 128 + lc) : (lc < 256 ? (1024 + h * 128 + lc - 128) : (2048 + h * 128 + vs * 64 + lc - 256));
      cw[i] = p.gdn_conv[((long)l * 9 + tap) * 3072 + ch];
    }
    __syncthreads();
  }

  for (int ch0 = 0; ch0 < TPB / TC; ++ch0) {
    const int pos0 = ch0 * TC;
    const bool is_ctx = pos0 < CTX;
    __syncthreads();
    for (int idx = tid; idx < TC * 40; idx += 256) {
      int tok = idx / 40, cgp = idx % 40;
      int row = scan_row(bl, dir, pos0 + tok);
      int col, lc;
      if (cgp < 16) { col = cq + cgp * 8; lc = cgp * 8; }
      else if (cgp < 32) { col = ck + (cgp - 16) * 8; lc = 128 + (cgp - 16) * 8; }
      else { col = cv + (cgp - 32) * 8; lc = 256 + (cgp - 32) * 8; }
      float val[8];
      if (mixer != 1) {
        uint4 raw = *(const uint4*)(p.proj + (long)row * PLD + col);
        unpack8(raw, val);
      } else {
        const float* cw = &sm.f[0][0];
#pragma unroll
        for (int e = 0; e < 8; ++e) val[e] = 0.f;
        int t = row - bl * TPB;
        if (is_ctx) {
#pragma unroll
          for (int jj = 0; jj < 3; ++jj) {
            int tt = t + jj - 1;
            if (tt >= 0 && tt < CTX) {
              uint4 raw = *(const uint4*)(p.proj + (long)(bl * TPB + tt) * PLD + col);
              float xv[8]; unpack8(raw, xv);
              const float* wv = cw + (3 + jj) * 320 + lc;
#pragma unroll
              for (int e = 0; e < 8; ++e) val[e] += xv[e] * wv[e];
            }
          }
        } else {
          int lt = t - CTX, rr0 = lt >> 6, cc0 = lt & 63;
#pragma unroll
          for (int ii = 0; ii < 3; ++ii) {
            int rr = rr0 + ii - 1;
            if (rr < 0 || rr >= 32) continue;
#pragma unroll
            for (int jj = 0; jj < 3; ++jj) {
              int cc = cc0 + jj - 1;
              if (cc < 0 || cc >= 64) continue;
              uint4 raw = *(const uint4*)(p.proj + (long)(bl * TPB + CTX + rr * 64 + cc) * PLD + col);
              float xv[8]; unpack8(raw, xv);
              const float* wv = cw + (ii * 3 + jj) * 320 + lc;
#pragma unroll
              for (int e = 0; e < 8; ++e) val[e] += xv[e] * wv[e];
            }
          }
        }
#pragma unroll
        for (int e = 0; e < 8; ++e) val[e] = siluf_(val[e]);
      }
      if (cgp < 16) {
        float scl = (mixer == 2) ? 0.08838834764831845f : 1.f;
#pragma unroll
        for (int e = 0; e < 8; ++e) sm.q[tok][lc + e] = val[e] * scl;
      } else if (cgp < 32) {
        int d0 = lc - 128;
        if (mixer == 0) {
#pragma unroll
          for (int e = 0; e < 8; ++e) {
            float lbv = p.lb[l * D + h * 128 + d0 + e];
            float f = lbv + (1.f - lbv) * sigmoidf_(val[e]);
            sm.f[tok][d0 + e] = f;
            sm.k[tok][d0 + e] = 1.f - f;
          }
        } else {
#pragma unroll
          for (int e = 0; e < 8; ++e) sm.k[tok][d0 + e] = val[e];
        }
      } else {
        int c0 = lc - 256;
#pragma unroll
        for (int e = 0; e < 8; ++e) sm.v[tok][c0 + e] = val[e];
      }
    }
    if (mixer == 2 && tid < TC) {
      int row = scan_row(bl, dir, pos0 + tid);
      float ig = p.gates[(long)row * GLD + 32 + dir * 4 + h] + ibias;
      float fx = p.gates[(long)row * GLD + 40 + dir * 4 + h] + fbias;
      sm.sc[tid][0] = ig;
      sm.sc[tid][1] = -softplusf_(-fx);
    }
    __syncthreads();
    if (mixer == 1) {
      for (int tk = w * 8; tk < w * 8 + 8; ++tk) {
        float q0 = sm.q[tk][lane], q1 = sm.q[tk][lane + 64], k0 = sm.k[tk][lane], k1 = sm.k[tk][lane + 64];
        float sq = wave_sum(q0 * q0 + q1 * q1), sk = wave_sum(k0 * k0 + k1 * k1), qk = wave_sum(q0 * k0 + q1 * k1);
        float rq = rsqrtf(sq + 1e-6f) * 0.08838834764831845f, rk = rsqrtf(sk + 1e-6f);
        sm.q[tk][lane] = q0 * rq; sm.q[tk][lane + 64] = q1 * rq;
        sm.k[tk][lane] = k0 * rk; sm.k[tk][lane + 64] = k1 * rk;
        if (lane == 0) {
          int row = scan_row(bl, dir, pos0 + tk);
          float beta = sigmoidf_(p.gates[(long)row * GLD + dir * 8 + h]);
          float gg = gA * softplusf_(p.gates[(long)row * GLD + 16 + dir * 8 + h] + gDt);
          sm.sc[tk][0] = __expf(gg); sm.sc[tk][1] = beta; sm.sc[tk][2] = qk * rq * rk;
        }
      }
      __syncthreads();
    } else if (mixer == 2) {
      if (tid == 0) {
        float m = mstate;
        for (int tk = 0; tk < TC; ++tk) {
          float ig = sm.sc[tk][0], lf = sm.sc[tk][1];
          float mn = fmaxf(lf + m, ig);
          sm.sc[tk][0] = __expf(lf + m - mn);
          sm.sc[tk][1] = __expf(ig - mn);
          sm.sc[tk][2] = __expf(-mn);
          m = mn;
        }
        mstate = m;
      }
      __syncthreads();
    }
    if (mixer == 0) {
      for (int tk = 0; tk < TC; ++tk) {
        float vj = sm.v[tk][w * 16 + j];
        const float4* qp = (const float4*)&sm.q[tk][gq * 32];
        const float4* kp = (const float4*)&sm.k[tk][gq * 32];
        const float4* fp = (const float4*)&sm.f[tk][gq * 32];
        float acc = 0.f;
#pragma unroll
        for (int i = 0; i < 8; ++i) {
          float4 q4 = qp[i], k4 = kp[i], f4 = fp[i];
          S[4 * i + 0] = f4.x * S[4 * i + 0] + k4.x * vj; acc += q4.x * S[4 * i + 0];
          S[4 * i + 1] = f4.y * S[4 * i + 1] + k4.y * vj; acc += q4.y * S[4 * i + 1];
          S[4 * i + 2] = f4.z * S[4 * i + 2] + k4.z * vj; acc += q4.z * S[4 * i + 2];
          S[4 * i + 3] = f4.w * S[4 * i + 3] + k4.w * vj; acc += q4.w * S[4 * i + 3];
        }
        acc += __shfl_xor(acc, 16); acc += __shfl_xor(acc, 32);
        if (gq == 0) sm.v[tk][w * 16 + j] = acc;
      }
    } else if (mixer == 1) {
      for (int tk = 0; tk < TC; ++tk) {
        float vj = sm.v[tk][w * 16 + j];
        float a = sm.sc[tk][0], beta = sm.sc[tk][1], qk = sm.sc[tk][2];
        const float4* qp = (const float4*)&sm.q[tk][gq * 32];
        const float4* kp = (const float4*)&sm.k[tk][gq * 32];
        float kr[32];
        float rr = 0.f, pq = 0.f;
#pragma unroll
        for (int i = 0; i < 8; ++i) {
          float4 q4 = qp[i], k4 = kp[i];
          kr[4 * i + 0] = k4.x; kr[4 * i + 1] = k4.y; kr[4 * i + 2] = k4.z; kr[4 * i + 3] = k4.w;
          rr += k4.x * S[4 * i + 0]; pq += q4.x * S[4 * i + 0];
          rr += k4.y * S[4 * i + 1]; pq += q4.y * S[4 * i + 1];
          rr += k4.z * S[4 * i + 2]; pq += q4.z * S[4 * i + 2];
          rr += k4.w * S[4 * i + 3]; pq += q4.w * S[4 * i + 3];
        }
        rr += __shfl_xor(rr, 16); pq += __shfl_xor(pq, 16);
        rr += __shfl_xor(rr, 32); pq += __shfl_xor(pq, 32);
        float vn = beta * (vj - a * rr);
        float ov = a * pq + qk * vn;
#pragma unroll
        for (int i = 0; i < 32; ++i) S[i] = a * S[i] + kr[i] * vn;
        if (gq == 0) sm.v[tk][w * 16 + j] = ov;
      }
    } else {
      for (int tk = 0; tk < TC; ++tk) {
        float vj = sm.v[tk][w * 16 + j];
        float fd = sm.sc[tk][0], iw = sm.sc[tk][1], em = sm.sc[tk][2];
        float ivj = iw * vj;
        const float4* qp = (const float4*)&sm.q[tk][gq * 32];
        const float4* kp = (const float4*)&sm.k[tk][gq * 32];
        float acc = 0.f;
#pragma unroll
        for (int i = 0; i < 8; ++i) {
          float4 q4 = qp[i], k4 = kp[i];
          S[4 * i + 0] = fd * S[4 * i + 0] + k4.x * ivj; acc += q4.x * S[4 * i + 0];
          S[4 * i + 1] = fd * S[4 * i + 1] + k4.y * ivj; acc += q4.y * S[4 * i + 1];
          S[4 * i + 2] = fd * S[4 * i + 2] + k4.z * ivj; acc += q4.z * S[4 * i + 2];
          S[4 * i + 3] = fd * S[4 * i + 3] + k4.w * ivj; acc += q4.w * S[4 * i + 3];
        }
        float2 kk = *(const float2*)&sm.k[tk][gq * 32 + 2 * j];
        float2 qq = *(const float2*)&sm.q[tk][gq * 32 + 2 * j];
        n0 = fd * n0 + iw * kk.x; n1 = fd * n1 + iw * kk.y;
        float den = n0 * qq.x + n1 * qq.y;
        den = wave_sum(den);
        acc += __shfl_xor(acc, 16); acc += __shfl_xor(acc, 32);
        if (gq == 0) sm.v[tk][w * 16 + j] = acc / fmaxf(fabsf(den), em);
      }
    }
    __syncthreads();
    {
      int tok = tid >> 3, c8 = tid & 7;
      int row = scan_row(bl, dir, pos0 + tok);
      const float* op = &sm.v[tok][c8 * 8];
      uint4 o;
      o.x = pack2(op[0], op[1]); o.y = pack2(op[2], op[3]); o.z = pack2(op[4], op[5]); o.w = pack2(op[6], op[7]);
      *(uint4*)(p.obuf + ((long)dir * TG + row) * 3072 + ocol + c8 * 8) = o;
    }
  }
}

struct CSmem {
  u16 QA[32][136];
  u16 KA[32][136];
  u16 KDT[128][40];
  u16 XT[64][40];
  u16 ATT[32][40];
  u16 ST[64][136];
  float sc[32][8];
  union {
    struct { u16 QD[32][136]; float dec[128]; float hsum[4][128]; } hg;
    struct { u16 YT[64][40]; u16 TM[32][40]; float NM[32][36]; u16 VF[32][72]; float TS[3][16][20]; } gd;
    struct { float nvec[128]; } ml;
  } u;
};

__device__ __forceinline__ f32x4 mfma16(bf16x8 a, bf16x8 b, f32x4 c) { return __builtin_amdgcn_mfma_f32_16x16x32_bf16(a, b, c, 0, 0, 0); }
__device__ __forceinline__ bf16x8 ldf(const u16* base, int ld, int row, int k) { return *(const bf16x8*)(base + row * ld + k); }
__device__ __forceinline__ void st4(u16* dst, float a, float b, float c, float d) { uint2 v; v.x = pack2(a, b); v.y = pack2(c, d); *(uint2*)dst = v; }

__device__ void scan_unit_mma(const Params& p, int l, int g, int u, CSmem& sm) {
  const int tid0 = otid();
  const int mixer = u / 128, r = u % 128;
  int bl, h, dir, vs;
  bl = r / 32;
  if (mixer < 2) { h = (r % 32) / 4; dir = (r % 4) / 2; vs = r % 2; }
  else { h = (r % 32) / 8; dir = (r % 8) / 4; vs = r % 4; }
  int cq, ck, cv, ocol;
  if (mixer == 0) { cq = C_HGQ + h * 128; ck = C_HGF + dir * 1024 + h * 128; cv = C_HGI + h * 128 + vs * 64; ocol = h * 128 + vs * 64; }
  else if (mixer == 1) { cq = C_GQ + h * 128; ck = C_GK + h * 128; cv = C_GV + h * 128 + vs * 64; ocol = 1024 + h * 128 + vs * 64; }
  else { cq = C_MQ + h * 128; ck = C_MK + h * 128; cv = C_MV + h * 256 + vs * 64; ocol = 2048 + h * 256 + vs * 64; }
  const float QS = 0.08838834764831845f;

  f32x4 S[2][4];
#pragma unroll
  for (int a = 0; a < 2; ++a)
#pragma unroll
    for (int b = 0; b < 4; ++b) S[a][b] = f32x4{0.f, 0.f, 0.f, 0.f};
  float mcar = 0.f;
  float gA = 0.f, gDt = 0.f, ibias = 0.f, fbias = 0.f;
  if (mixer == 1) { gA = -__expf(p.gdn_a_log[l * 16 + dir * 8 + h]); gDt = p.gdn_dt_bias[l * 16 + dir * 8 + h]; }
  if (mixer == 2) { ibias = p.ml_i_bias[l * 8 + dir * 4 + h]; fbias = p.ml_f_bias[l * 8 + dir * 4 + h]; }

  __syncthreads();
  for (int i = tid0; i < 64 * 136 / 2; i += 256) ((unsigned*)&sm.ST[0][0])[i] = 0u;
  if (mixer == 2 && tid0 < 128) sm.u.ml.nvec[tid0] = 0.f;
  __syncthreads();


  uint4 pq0, pq1, pk0, pk1, pv, pt = uint4{0u, 0u, 0u, 0u};
  float pg0 = 0.f, pg1 = 0.f, pg2 = 0.f;
  const int ptask0 = ((bl * 8 + h) * 2 + dir) * 72;
  const int mtask0 = ((bl * 4 + h) * 2 + dir) * 72;
  const int gc0 = (mixer == 1) ? (dir * 8 + h) : (32 + dir * 4 + h);
  const int gc1 = (mixer == 1) ? (16 + dir * 8 + h) : (40 + dir * 4 + h);
  const float lbv = (mixer == 0) ? p.lb[l * D + h * 128 + (tid0 & 127)] : 0.f;
#define ISSUE_LOADS(CH, TID)                                                                          \
  {                                                                                                   \
    const int _pos = (CH) * 32;                                                                       \
    {                                                                                                 \
      int _idx = (TID), _tok = _idx >> 4, _c = _idx & 15;                                             \
      const u16* _pr = p.proj + (long)scan_row(bl, dir, _pos + _tok) * PLD;                           \
      pq0 = *(const uint4*)(_pr + cq + _c * 8);                                                       \
      pk0 = *(const uint4*)(_pr + ck + _c * 8);                                                       \
    }                                                                                                 \
    {                                                                                                 \
      int _idx = (TID) + 256, _tok = _idx >> 4, _c = _idx & 15;                                       \
      const u16* _pr = p.proj + (long)scan_row(bl, dir, _pos + _tok) * PLD;                           \
      pq1 = *(const uint4*)(_pr + cq + _c * 8);                                                       \
      pk1 = *(const uint4*)(_pr + ck + _c * 8);                                                       \
    }                                                                                                 \
    {                                                                                                 \
      int _tok = (TID) >> 3, _c8 = (TID) & 7;                                                         \
      pv = *(const uint4*)(p.proj + (long)scan_row(bl, dir, _pos + _tok) * PLD + cv + _c8 * 8);       \
    }                                                                                                 \
    if (mixer == 2 && (TID) < 64) {                                                                   \
      const float* _gs = p.mprep + ((long)mtask0 + (CH)) * 96;                                        \
      pg0 = _gs[(TID) & 31]; pg1 = _gs[32 + ((TID) & 31)]; pg2 = _gs[64 + ((TID) & 31)];             \
    }                                                                                                 \
    if (mixer == 1) {                                                                                 \
      const u16* _gq = p.gprep + ((long)ptask0 + (CH)) * 2176;                                        \
      pt = *(const uint4*)(_gq + (TID) * 8);                                                          \
      if ((TID) < 64) { const float* _gs = (const float*)(_gq + 2048); pg0 = _gs[(TID) & 31]; pg1 = _gs[32 + ((TID) & 31)]; } \
    }                                                                                                 \
  }
  ISSUE_LOADS(0, tid0)

  for (int ch0 = 0; ch0 < TPB / 32; ++ch0) {
    const int tid = otid(), lane = tid & 63, w = tid >> 6, fr = lane & 15, fq = lane >> 4;
    const int rt_o = w & 1, cp_o = w >> 1;
    const int pos0 = ch0 * 32;
    float mnew = 0.f;
    {
      int tok = tid >> 4, c = tid & 15;
      *(uint4*)&sm.QA[tok][c * 8] = pq0; *(uint4*)&sm.KA[tok][c * 8] = pk0;
      *(uint4*)&sm.QA[tok + 16][c * 8] = pq1; *(uint4*)&sm.KA[tok + 16][c * 8] = pk1;
    }
    {
      int t = tid >> 3, c8 = tid & 7;
      if (mixer == 1) *(uint4*)&sm.u.gd.VF[t][c8 * 8] = pv;
      else {
        sm.XT[c8 * 8 + 0][t] = (u16)(pv.x & 0xffffu); sm.XT[c8 * 8 + 1][t] = (u16)(pv.x >> 16);
        sm.XT[c8 * 8 + 2][t] = (u16)(pv.y & 0xffffu); sm.XT[c8 * 8 + 3][t] = (u16)(pv.y >> 16);
        sm.XT[c8 * 8 + 4][t] = (u16)(pv.z & 0xffffu); sm.XT[c8 * 8 + 5][t] = (u16)(pv.z >> 16);
        sm.XT[c8 * 8 + 6][t] = (u16)(pv.w & 0xffffu); sm.XT[c8 * 8 + 7][t] = (u16)(pv.w >> 16);
      }
    }
    if (mixer == 1) {
      int which = tid >> 7, idx = tid & 127, row = idx >> 2, c8 = (idx & 3) * 8;
      if (which == 0) *(uint4*)&sm.u.gd.TM[row][c8] = pt; else *(uint4*)&sm.ATT[row][c8] = pt;
    }
    const float g0 = pg0, g1 = pg1, g2 = pg2;
    if (ch0 + 1 < TPB / 32) ISSUE_LOADS(ch0 + 1, tid)
    if (mixer == 0) {
      __syncthreads();
      const int dp = lane, d0 = 2 * lane, t0 = w * 8;
      float bb0[8], bb1[8], qv0[8], qv1[8], kv0[8], kv1[8];
      float run0 = 0.f, run1 = 0.f;
#pragma unroll
      for (int i = 0; i < 8; ++i) {
        unsigned lfp = *(const unsigned*)&sm.KA[t0 + i][d0];
        unsigned qp = *(const unsigned*)&sm.QA[t0 + i][d0];
        float lf0 = __uint_as_float(lfp << 16), lf1 = __uint_as_float(lfp & 0xffff0000u);
        qv0[i] = __uint_as_float(qp << 16); qv1[i] = __uint_as_float(qp & 0xffff0000u);
        kv0[i] = 1.f - __expf(lf0); kv1[i] = 1.f - __expf(lf1);
        run0 += lf0; run1 += lf1;
        bb0[i] = run0; bb1[i] = run1;
      }
      *(float2*)&sm.u.hg.hsum[w][d0] = float2{run0, run1};
      __syncthreads();
      float2 h0 = *(const float2*)&sm.u.hg.hsum[0][d0], h1 = *(const float2*)&sm.u.hg.hsum[1][d0];
      float2 h2 = *(const float2*)&sm.u.hg.hsum[2][d0], h3 = *(const float2*)&sm.u.hg.hsum[3][d0];
      const float bref0 = h0.x + h1.x, bref1 = h0.y + h1.y;
      const float bend0 = bref0 + h2.x + h3.x, bend1 = bref1 + h2.y + h3.y;
      const float off0 = (w > 0 ? h0.x : 0.f) + (w > 1 ? h1.x : 0.f) + (w > 2 ? h2.x : 0.f);
      const float off1 = (w > 0 ? h0.y : 0.f) + (w > 1 ? h1.y : 0.f) + (w > 2 ? h2.y : 0.f);
      if (w == 0) *(float2*)&sm.u.hg.dec[d0] = float2{__expf(bend0), __expf(bend1)};
      const float ebref0 = __expf(bref0), ebref1 = __expf(bref1), eber0 = __expf(bend0 - bref0), eber1 = __expf(bend1 - bref1);
      unsigned kda[4], kdb[4];
#pragma unroll
      for (int i = 0; i < 8; ++i) {
        float b0 = bb0[i] + off0, b1 = bb1[i] + off1;
        float qa0 = qv0[i] * __expf(fminf(b0 - bref0, 80.f)), qa1 = qv1[i] * __expf(fminf(b1 - bref1, 80.f));
        float ka0 = kv0[i] * __expf(fminf(bref0 - b0, 80.f)), ka1 = kv1[i] * __expf(fminf(bref1 - b1, 80.f));
        *(unsigned*)&sm.QA[t0 + i][d0] = pack2(qa0, qa1);
        *(unsigned*)&sm.KA[t0 + i][d0] = pack2(ka0, ka1);
        *(unsigned*)&sm.u.hg.QD[t0 + i][d0] = pack2(qa0 * ebref0, qa1 * ebref1);
        unsigned kp = pack2(ka0 * eber0, ka1 * eber1);
        if (i & 1) { kda[i >> 1] |= (kp & 0xffffu) << 16; kdb[i >> 1] |= kp & 0xffff0000u; }
        else { kda[i >> 1] = kp & 0xffffu; kdb[i >> 1] = kp >> 16; }
      }
      *(uint4*)&sm.KDT[d0][t0] = uint4{kda[0], kda[1], kda[2], kda[3]};
      *(uint4*)&sm.KDT[d0 + 1][t0] = uint4{kdb[0], kdb[1], kdb[2], kdb[3]};
      (void)dp;
      __syncthreads();
    } else if (mixer == 1) {
      if (w == 0) {
        const float Gend_ = __shfl(g0, 31);
        if (lane < 32) { sm.sc[lane][0] = g0; sm.sc[lane][1] = g1; sm.sc[lane][3] = __expf(Gend_ - g0); }
      }
    } else {
      if (w == 0) {
        const float Mend_ = fmaxf(mcar, __shfl(g2, 31));
        if (lane < 32) { sm.sc[lane][0] = g0; sm.sc[lane][1] = g1; sm.sc[lane][2] = fmaxf(mcar, g2); sm.sc[lane][3] = __expf(g1 - Mend_); }
      }
      __syncthreads();
      mnew = sm.sc[31][0] + sm.sc[31][2];
      {
        const int d0 = 2 * lane, t0 = w * 8;
        unsigned kda[4], kdb[4];
#pragma unroll
        for (int i = 0; i < 8; ++i) {
          unsigned kk2 = *(const unsigned*)&sm.KA[t0 + i][d0];
          float fct = sm.sc[t0 + i][3];
          unsigned kp = pack2(__uint_as_float(kk2 << 16) * fct, __uint_as_float(kk2 & 0xffff0000u) * fct);
          if (i & 1) { kda[i >> 1] |= (kp & 0xffffu) << 16; kdb[i >> 1] |= kp & 0xffff0000u; }
          else { kda[i >> 1] = kp & 0xffffu; kdb[i >> 1] = kp >> 16; }
        }
        *(uint4*)&sm.KDT[d0][t0] = uint4{kda[0], kda[1], kda[2], kda[3]};
        *(uint4*)&sm.KDT[d0 + 1][t0] = uint4{kdb[0], kdb[1], kdb[2], kdb[3]};
      }
    }
    if (mixer == 1) {
    } else {
      int si, ti; bool doit = true;
      si = w & 1; ti = w >> 1; doit = !(si == 1 && ti == 0);
      if (doit) {
        f32x4 acc = f32x4{0.f, 0.f, 0.f, 0.f};
#pragma unroll
        for (int kk = 0; kk < 4; ++kk)
          acc = mfma16(ldf(&sm.KA[0][0], 136, si * 16 + fr, kk * 32 + fq * 8), ldf(&sm.QA[0][0], 136, ti * 16 + fr, kk * 32 + fq * 8), acc);
        const int t = ti * 16 + fr;
        float o4[4];
        if (mixer == 0) {
#pragma unroll
          for (int j = 0; j < 4; ++j) { int s_ = si * 16 + fq * 4 + j; o4[j] = (s_ <= t) ? acc[j] : 0.f; }
        } else if (mixer == 1) {
          float Gt = sm.sc[t][0];
#pragma unroll
          for (int j = 0; j < 4; ++j) { int s_ = si * 16 + fq * 4 + j; o4[j] = (s_ <= t) ? acc[j] * __expf(Gt - sm.sc[s_][0]) : 0.f; }
        } else {
          float Mt = sm.sc[t][2];
#pragma unroll
          for (int j = 0; j < 4; ++j) { int s_ = si * 16 + fq * 4 + j; o4[j] = (s_ <= t) ? acc[j] * QS * __expf(sm.sc[s_][1] - Mt) : 0.f; }
        }
        st4(&sm.ATT[t][si * 16 + fq * 4], o4[0], o4[1], o4[2], o4[3]);
      } else {
        int t = lane >> 2, s4 = (lane & 3) * 4; *(uint2*)&sm.ATT[t][16 + s4] = uint2{0u, 0u};
      }
    }
    __syncthreads();
    if (mixer == 1) {
      f32x4 acc[2];
      acc[0] = acc[1] = f32x4{0.f, 0.f, 0.f, 0.f};
#pragma unroll
      for (int kk = 0; kk < 4; ++kk) {
        bf16x8 a = ldf(&sm.KA[0][0], 136, rt_o * 16 + fr, kk * 32 + fq * 8);
#pragma unroll
        for (int c = 0; c < 2; ++c) acc[c] = mfma16(a, ldf(&sm.ST[0][0], 136, (cp_o * 2 + c) * 16 + fr, kk * 32 + fq * 8), acc[c]);
      }
#pragma unroll
      for (int c = 0; c < 2; ++c) {
        int v = (cp_o * 2 + c) * 16 + fr;
        float y4[4];
#pragma unroll
        for (int j = 0; j < 4; ++j) {
          int t = rt_o * 16 + fq * 4 + j;
          float kg = __expf(sm.sc[t][0]);
          y4[j] = sm.sc[t][1] * (bf2f(sm.u.gd.VF[t][v]) - kg * acc[c][j]);
        }
        st4(&sm.u.gd.YT[v][rt_o * 16 + fq * 4], y4[0], y4[1], y4[2], y4[3]);
      }
      {
        const int d0 = 2 * lane, t0 = w * 8;
        unsigned kda[4], kdb[4];
#pragma unroll
        for (int i = 0; i < 8; ++i) {
          unsigned kk2 = *(const unsigned*)&sm.KA[t0 + i][d0];
          float fct = sm.sc[t0 + i][3];
          unsigned kp = pack2(__uint_as_float(kk2 << 16) * fct, __uint_as_float(kk2 & 0xffff0000u) * fct);
          if (i & 1) { kda[i >> 1] |= (kp & 0xffffu) << 16; kdb[i >> 1] |= kp & 0xffff0000u; }
          else { kda[i >> 1] = kp & 0xffffu; kdb[i >> 1] = kp >> 16; }
        }
        *(uint4*)&sm.KDT[d0][t0] = uint4{kda[0], kda[1], kda[2], kda[3]};
        *(uint4*)&sm.KDT[d0 + 1][t0] = uint4{kdb[0], kdb[1], kdb[2], kdb[3]};
      }
      __syncthreads();
      {
        bf16x8 a = ldf(&sm.u.gd.TM[0][0], 40, rt_o * 16 + fr, fq * 8);
#pragma unroll
        for (int c = 0; c < 2; ++c) {
          int vt = cp_o * 2 + c;
          f32x4 vn = mfma16(a, ldf(&sm.u.gd.YT[0][0], 40, vt * 16 + fr, fq * 8), f32x4{0.f, 0.f, 0.f, 0.f});
          st4(&sm.XT[vt * 16 + fr][rt_o * 16 + fq * 4], vn[0], vn[1], vn[2], vn[3]);
        }
      }
      __syncthreads();
    } else if (mixer == 2) {
      int t = tid >> 3, part = tid & 7;
      float qn = 0.f;
#pragma unroll
      for (int e = 0; e < 16; ++e) qn += bf2f(sm.QA[t][part * 16 + e]) * sm.u.ml.nvec[part * 16 + e];
      float as = 0.f;
#pragma unroll
      for (int e = 0; e < 4; ++e) as += bf2f(sm.ATT[t][part * 4 + e]);
      float Mt = sm.sc[t][2];
      float den = QS * __expf(mcar - Mt) * qn + as;
      den += __shfl_xor(den, 1); den += __shfl_xor(den, 2); den += __shfl_xor(den, 4);
      if (part == 0) sm.sc[t][4] = 1.f / fmaxf(fabsf(den), __expf(-(sm.sc[t][0] + Mt)));
      __syncthreads();
    }
    {
      f32x4 acc[2];
      acc[0] = acc[1] = f32x4{0.f, 0.f, 0.f, 0.f};
      const u16* Qs = (mixer == 0) ? &sm.u.hg.QD[0][0] : &sm.QA[0][0];
#pragma unroll
      for (int kk = 0; kk < 4; ++kk) {
        bf16x8 qb = ldf(Qs, 136, rt_o * 16 + fr, kk * 32 + fq * 8);
#pragma unroll
        for (int c = 0; c < 2; ++c) acc[c] = mfma16(ldf(&sm.ST[0][0], 136, (cp_o * 2 + c) * 16 + fr, kk * 32 + fq * 8), qb, acc[c]);
      }
      const int t = rt_o * 16 + fr;
      float rs, fs;
      if (mixer == 0) { rs = 1.f; fs = 1.f; }
      else if (mixer == 1) { rs = __expf(sm.sc[t][0]); fs = 1.f; }
      else { rs = QS * __expf(mcar - sm.sc[t][2]); fs = sm.sc[t][4]; }
#pragma unroll
      for (int c = 0; c < 2; ++c)
#pragma unroll
        for (int j = 0; j < 4; ++j) acc[c][j] *= rs;
      {
        bf16x8 ab = ldf(&sm.ATT[0][0], 40, rt_o * 16 + fr, fq * 8);
#pragma unroll
        for (int c = 0; c < 2; ++c) acc[c] = mfma16(ldf(&sm.XT[0][0], 40, (cp_o * 2 + c) * 16 + fr, fq * 8), ab, acc[c]);
      }
      const int row = scan_row(bl, dir, pos0 + t);
      u16* dst = p.obuf + ((long)dir * TG + row) * 3072 + ocol;
#pragma unroll
      for (int c = 0; c < 2; ++c) {
        uint2 o; o.x = pack2(acc[c][0] * fs, acc[c][1] * fs); o.y = pack2(acc[c][2] * fs, acc[c][3] * fs);
        *(uint2*)(dst + (cp_o * 2 + c) * 16 + fq * 4) = o;
      }
    }
    __syncthreads();
    {
      float dsc = 1.f;
      if (mixer == 1) dsc = __expf(sm.sc[31][0]);
      else if (mixer == 2) dsc = __expf(mcar - sm.sc[31][2]);
#pragma unroll
      for (int rt = 0; rt < 2; ++rt) {
        if (mixer == 0) {
          float4 d4 = *(const float4*)&sm.u.hg.dec[w * 32 + rt * 16 + fq * 4];
#pragma unroll
          for (int ct = 0; ct < 4; ++ct) { S[rt][ct][0] *= d4.x; S[rt][ct][1] *= d4.y; S[rt][ct][2] *= d4.z; S[rt][ct][3] *= d4.w; }
        } else {
#pragma unroll
          for (int ct = 0; ct < 4; ++ct) { S[rt][ct][0] *= dsc; S[rt][ct][1] *= dsc; S[rt][ct][2] *= dsc; S[rt][ct][3] *= dsc; }
        }
        bf16x8 a = ldf(&sm.KDT[0][0], 40, w * 32 + rt * 16 + fr, fq * 8);
#pragma unroll
        for (int ct = 0; ct < 4; ++ct) {
          S[rt][ct] = mfma16(a, ldf(&sm.XT[0][0], 40, ct * 16 + fr, fq * 8), S[rt][ct]);
          st4(&sm.ST[ct * 16 + fr][w * 32 + rt * 16 + fq * 4], S[rt][ct][0], S[rt][ct][1], S[rt][ct][2], S[rt][ct][3]);
        }
      }
      if (mixer == 2) {
        if (tid < 128) {
          float sum = 0.f;
#pragma unroll
          for (int e = 0; e < 32; ++e) sum += bf2f(sm.KDT[tid][e]);
          sm.u.ml.nvec[tid] = dsc * sm.u.ml.nvec[tid] + sum;
        }
        mcar = mnew;
      }
    }
    __syncthreads();
  }
}

struct PrepW { float NM[32][36]; float TS[3][16][20]; float G[32]; float B[32]; };
__device__ __forceinline__ bf16x8 asbf(const uint4& u) { return __builtin_bit_cast(bf16x8, u); }
__device__ void ph_gdn_prep(const Params& p, int l, char* smem) {
  const int tid = otid();
  const int lane = tid & 63, w = tid >> 6, fr = lane & 15, fq = lane >> 4;
  PrepW& sw = ((PrepW*)smem)[w];
  const int gw = blockIdx.x * 4 + w, nw = gridDim.x * 4;
  for (int task = gw; task < 2304; task += nw) {
    const int chunk = task % 72, r = task / 72, dir = r & 1, h = (r >> 1) & 3, bl = r >> 3;
    const int tk = lane & 31;
    const float* gp = p.gates + (long)scan_row(bl, dir, chunk * 32 + tk) * GLD;
    float ig = gp[32 + dir * 4 + h] + p.ml_i_bias[l * 8 + dir * 4 + h];
    float F = -softplusf_(-(gp[40 + dir * 4 + h] + p.ml_f_bias[l * 8 + dir * 4 + h]));
#pragma unroll
    for (int o = 1; o < 32; o <<= 1) { float t2 = __shfl_up(F, o); if (tk >= o) F += t2; }
    float a = ig - F;
    float pm = a;
#pragma unroll
    for (int o = 1; o < 32; o <<= 1) { float t2 = __shfl_up(pm, o); if (tk >= o) pm = fmaxf(pm, t2); }
    if (lane < 32) { float* o_ = p.mprep + (long)task * 96; o_[tk] = F; o_[32 + tk] = a; o_[64 + tk] = pm; }
  }
  for (int task = gw; task < 4608; task += nw) {
    const int chunk = task % 72, r = task / 72, dir = r & 1, h = (r >> 1) & 7, bl = r >> 4;
    const int pos0 = chunk * 32;
    const float gA = -__expf(p.gdn_a_log[l * 16 + dir * 8 + h]), gDt = p.gdn_dt_bias[l * 16 + dir * 8 + h];
    uint4 kf[2][4], qf[2][4];
#pragma unroll
    for (int rt = 0; rt < 2; ++rt) {
      const u16* pr = p.proj + (long)scan_row(bl, dir, pos0 + rt * 16 + fr) * PLD + h * 128 + fq * 8;
#pragma unroll
      for (int kk = 0; kk < 4; ++kk) { kf[rt][kk] = *(const uint4*)(pr + C_GK + kk * 32); qf[rt][kk] = *(const uint4*)(pr + C_GQ + kk * 32); }
    }
    const int tk = lane & 31;
    float beta, G;
    {
      const float* gp = p.gates + (long)scan_row(bl, dir, pos0 + tk) * GLD;
      beta = sigmoidf_(gp[dir * 8 + h]);
      G = gA * softplusf_(gp[16 + dir * 8 + h] + gDt);
#pragma unroll
      for (int o = 1; o < 32; o <<= 1) { float t2 = __shfl_up(G, o); if (tk >= o) G += t2; }
      if (lane < 32) { sw.G[tk] = G; sw.B[tk] = beta; }
    }
    u16* outT = p.gprep + (long)task * 2176;
    u16* outA = outT + 1024;
    float* outS = (float*)(outT + 2048);
    if (lane < 32) { outS[tk] = G; outS[32 + tk] = beta; }
#pragma unroll
    for (int ti_ = 0; ti_ < 3; ++ti_) {
      const int ai = ti_ == 0 ? 0 : 1, bi = ti_ == 2 ? 1 : 0;
      f32x4 acc = f32x4{0.f, 0.f, 0.f, 0.f};
#pragma unroll
      for (int kk = 0; kk < 4; ++kk) acc = mfma16(asbf(kf[ai][kk]), asbf(kf[bi][kk]), acc);
      const int b = bi * 16 + fr;
      const float Gb = sw.G[b];
#pragma unroll
      for (int j = 0; j < 4; ++j) {
        int a = ai * 16 + fq * 4 + j;
        if (a > b) sw.NM[a][b] = sw.B[a] * acc[j] * __expf(sw.G[a] - Gb);
      }
    }
#pragma unroll
    for (int ti_ = 0; ti_ < 3; ++ti_) {
      const int si = ti_ == 2 ? 1 : 0, ti = ti_ == 0 ? 0 : 1;
      f32x4 acc = f32x4{0.f, 0.f, 0.f, 0.f};
#pragma unroll
      for (int kk = 0; kk < 4; ++kk) acc = mfma16(asbf(kf[si][kk]), asbf(qf[ti][kk]), acc);
      const int t = ti * 16 + fr;
      const float Gt = sw.G[t];
      float o4[4];
#pragma unroll
      for (int j = 0; j < 4; ++j) { int s_ = si * 16 + fq * 4 + j; o4[j] = (s_ <= t) ? acc[j] * __expf(Gt - sw.G[s_]) : 0.f; }
      st4(outA + t * 32 + si * 16 + fq * 4, o4[0], o4[1], o4[2], o4[3]);
    }
    { int t = lane >> 2, s4 = (lane & 3) * 4; *(uint2*)(outA + t * 32 + 16 + s4) = uint2{0u, 0u}; }
    {
      const int blk = (lane >> 4) & 1, c = lane & 15;
      float Tc[16];
#pragma unroll
      for (int t = 0; t < 16; ++t) {
        float v = (t == c) ? 1.f : 0.f;
#pragma unroll
        for (int s4 = 0; s4 < (t + 3) / 4; ++s4) {
          float4 n4 = *(const float4*)&sw.NM[blk * 16 + t][blk * 16 + s4 * 4];
          if (s4 * 4 + 0 < t) v -= n4.x * Tc[s4 * 4 + 0];
          if (s4 * 4 + 1 < t) v -= n4.y * Tc[s4 * 4 + 1];
          if (s4 * 4 + 2 < t) v -= n4.z * Tc[s4 * 4 + 2];
          if (s4 * 4 + 3 < t) v -= n4.w * Tc[s4 * 4 + 3];
        }
        Tc[t] = v;
        if (lane < 32) {
          sw.TS[blk][t][c] = v;
          outT[(blk * 16 + t) * 32 + blk * 16 + c] = f2bf(v);
          if (blk == 0) outT[t * 32 + 16 + c] = 0;
        }
        __builtin_amdgcn_sched_barrier(0);
      }
    }
    {
      const int a = lane >> 2, c4 = (lane & 3) * 4;
      float w0 = 0.f, w1 = 0.f, w2 = 0.f, w3 = 0.f;
#pragma unroll
      for (int s4 = 0; s4 < 4; ++s4) {
        float4 n4 = *(const float4*)&sw.NM[16 + a][s4 * 4];
        float nn[4] = {n4.x, n4.y, n4.z, n4.w};
#pragma unroll
        for (int k = 0; k < 4; ++k) {
          float4 t4 = *(const float4*)&sw.TS[0][s4 * 4 + k][c4];
          w0 += nn[k] * t4.x; w1 += nn[k] * t4.y; w2 += nn[k] * t4.z; w3 += nn[k] * t4.w;
        }
      }
      *(float4*)&sw.TS[2][a][c4] = float4{w0, w1, w2, w3};
    }
    {
      const int t = lane >> 2, c4 = (lane & 3) * 4;
      float r0 = 0.f, r1 = 0.f, r2 = 0.f, r3 = 0.f;
#pragma unroll
      for (int a4 = 0; a4 < 4; ++a4) {
        float4 q4 = *(const float4*)&sw.TS[1][t][a4 * 4];
        float qq[4] = {q4.x, q4.y, q4.z, q4.w};
#pragma unroll
        for (int k = 0; k < 4; ++k) {
          float4 w4 = *(const float4*)&sw.TS[2][a4 * 4 + k][c4];
          r0 += qq[k] * w4.x; r1 += qq[k] * w4.y; r2 += qq[k] * w4.z; r3 += qq[k] * w4.w;
        }
      }
      st4(outT + (16 + t) * 32 + c4, -r0, -r1, -r2, -r3);
    }
  }
}

__device__ void ph_scan(const Params& p, int l, int g, char* smem) {
  const int b = blockIdx.x;
  __shared__ int tb_s[2];
  int u0, ustep;
  if (gridDim.x == 512) {
    ustep = 512;
    u0 = b < 128 ? 128 + b : (b < 256 ? b - 128 : (b < 384 ? b : 384));
  } else { u0 = b; ustep = gridDim.x; }
  for (int u = u0; u < 384; u += ustep) scan_unit_mma(p, l, g, u, *(CSmem*)smem);
  __syncthreads();
  unsigned* ctr = p.bar + XB_CTR(l * 4 + g);
  for (int it = 0;; ++it) {
    if (threadIdx.x == 0) tb_s[it & 1] = (int)atomicAdd(ctr, 1u);
    __syncthreads();
    const int tb = tb_s[it & 1];
    if (tb >= QB_END) break;
    gemm_in_b_tile(p, l, smem, tb);
  }
}

__device__ void ph_brfin(const Params& p, int l, int g) {
  const int tid = otid();
  const int lane = tid & 63;
  const int gw = blockIdx.x * 4 + (tid >> 6), nw = gridDim.x * 4;
  uint4 na0, na1, nb0, nb1, nz0, nz1, ng0, ng1;
  float4 no0, no1, no2, no3;
  const uint4 zz = uint4{0u, 0u, 0u, 0u};
  na0 = na1 = nb0 = nb1 = nz0 = nz1 = ng0 = ng1 = zz;
  no0 = no1 = no2 = no3 = float4{0.f, 0.f, 0.f, 0.f};
#define BR_LOAD(J)                                                                                           \
  if ((J) < TG * 3) {                                                                                        \
    const int _mx = (J) / TG, _row = (J) % TG;                                                               \
    if (!(l == 1 && (_row % TPB) < CTX)) {                                                                   \
      const u16* _of = p.obuf + (long)_row * 3072 + _mx * 1024 + lane * 16;                                  \
      const u16* _ob = _of + (long)TG * 3072;                                                                \
      na0 = *(const uint4*)_of; na1 = *(const uint4*)(_of + 8);                                              \
      nb0 = *(const uint4*)_ob; nb1 = *(const uint4*)(_ob + 8);                                              \
      const int _zc = _mx == 0 ? C_HGZ : (_mx == 1 ? C_GZ : C_MZ);                                           \
      const u16* _zp = p.proj + (long)_row * PLD + _zc + lane * 16;                                          \
      nz0 = *(const uint4*)_zp; nz1 = *(const uint4*)(_zp + 8);                                              \
      if (_mx == 2) { const u16* _gp = p.proj + (long)_row * PLD + C_MO + lane * 16;                         \
                      ng0 = *(const uint4*)_gp; ng1 = *(const uint4*)(_gp + 8); }                            \
      const float4* _on = (const float4*)((_mx == 0 ? p.hg_onorm : (_mx == 1 ? p.gdn_onorm : p.ml_onorm)) + l * D + lane * 16); \
      no0 = _on[0]; no1 = _on[1]; no2 = _on[2]; no3 = _on[3];                                                \
    }                                                                                                        \
  }
  BR_LOAD(gw)
  for (int j = gw; j < TG * 3; j += nw) {
    const uint4 a0 = na0, a1 = na1, b0 = nb0, b1 = nb1, z0 = nz0, z1 = nz1, g0 = ng0, g1 = ng1;
    const float4 o0 = no0, o1 = no1, o2 = no2, o3 = no3;
    BR_LOAD(j + nw)
    const int mixer = j / TG, row = j % TG;
    if (l == 1 && (row % TPB) < CTX) continue;
    float o[16], t8[8];
    unpack8(a0, o); unpack8(a1, o + 8);
    unpack8(b0, t8);
#pragma unroll
    for (int e = 0; e < 8; ++e) o[e] += t8[e];
    unpack8(b1, t8);
#pragma unroll
    for (int e = 0; e < 8; ++e) o[8 + e] += t8[e];
    float ss = 0.f;
#pragma unroll
    for (int e = 0; e < 16; ++e) ss += o[e] * o[e];
    ss += __shfl_xor(ss, 1); ss += __shfl_xor(ss, 2); ss += __shfl_xor(ss, 4);
    float hd = 128.f;
    if (mixer == 2) { ss += __shfl_xor(ss, 8); hd = 256.f; }
    float rs = rsqrtf(ss / hd + 1e-6f);
    const float on[16] = {o0.x, o0.y, o0.z, o0.w, o1.x, o1.y, o1.z, o1.w, o2.x, o2.y, o2.z, o2.w, o3.x, o3.y, o3.z, o3.w};
    float z[16];
    unpack8(z0, z); unpack8(z1, z + 8);
    float res[16];
#pragma unroll
    for (int e = 0; e < 16; ++e) res[e] = o[e] * rs * on[e] * siluf_(z[e]);
    if (mixer == 2) {
      unpack8(g0, z); unpack8(g1, z + 8);
#pragma unroll
      for (int e = 0; e < 16; ++e) res[e] *= sigmoidf_(z[e]);
    }
    uint4 w0, w1;
    w0.x = pack2(res[0], res[1]); w0.y = pack2(res[2], res[3]); w0.z = pack2(res[4], res[5]); w0.w = pack2(res[6], res[7]);
    w1.x = pack2(res[8], res[9]); w1.y = pack2(res[10], res[11]); w1.z = pack2(res[12], res[13]); w1.w = pack2(res[14], res[15]);
    u16* dst = p.obuf + (long)row * 3072 + mixer * 1024 + lane * 16;
    *(uint4*)dst = w0; *(uint4*)(dst + 8) = w1;
  }
#undef BR_LOAD
}

__device__ void ph_gemm_merge(const Params& p, int l, char* smem) {
  for (int t = blockIdx.x; t < 72 * 8; t += gridDim.x) {
    int nt = t / 72, mt = t % 72;
    if (l == 1 && (mt % 18) < 2) continue;
    f32x4 tot[4][4];
#pragma unroll
    for (int m = 0; m < 4; ++m)
#pragma unroll
      for (int n = 0; n < 4; ++n) tot[m][n] = f32x4{0.f, 0.f, 0.f, 0.f};
    for (int i = 0; i < 3; ++i) {
      f32x4 acc[4][4];
#pragma unroll
      for (int m = 0; m < 4; ++m)
#pragma unroll
        for (int n = 0; n < 4; ++n) acc[m][n] = f32x4{0.f, 0.f, 0.f, 0.f};
      gemm_kloopT<4, 4>(p.obuf + (long)mt * 128 * 3072 + i * 1024, 3072, 32, p.WbrT + (long)i * D * D + (long)nt * 128 * 32, 32, (long)D * 32, D, smem, acc);
      const int tid2 = otid();
      const int wr = (tid2 >> 7) & 1, wc = (tid2 >> 6) & 1, fr = tid2 & 15, fq = (tid2 >> 4) & 3;
#pragma unroll
      for (int m = 0; m < 4; ++m) {
        int row = mt * 128 + wr * 64 + m * 16 + fr;
#pragma unroll
        for (int n = 0; n < 4; ++n) {
          int col = nt * 128 + wc * 64 + n * 16 + fq * 4;
          uint2 gr = *(const uint2*)(p.proj + (long)row * PLD + C_GATE + i * 1024 + col);
          tot[m][n][0] += sigmoidf_(__uint_as_float(gr.x << 16)) * acc[m][n][0];
          tot[m][n][1] += sigmoidf_(__uint_as_float(gr.x & 0xffff0000u)) * acc[m][n][1];
          tot[m][n][2] += sigmoidf_(__uint_as_float(gr.y << 16)) * acc[m][n][2];
          tot[m][n][3] += sigmoidf_(__uint_as_float(gr.y & 0xffff0000u)) * acc[m][n][3];
        }
      }
    }
    const int tid3 = otid();
    const int wr = (tid3 >> 7) & 1, wc = (tid3 >> 6) & 1, fr = tid3 & 15, fq = (tid3 >> 4) & 3;
#pragma unroll
    for (int m = 0; m < 4; ++m) {
      int row = mt * 128 + wr * 64 + m * 16 + fr;
#pragma unroll
      for (int n = 0; n < 4; ++n) {
        int col = nt * 128 + wc * 64 + n * 16 + fq * 4;
        uint2 o; o.x = pack2(tot[m][n][0], tot[m][n][1]); o.y = pack2(tot[m][n][2], tot[m][n][3]);
        *(uint2*)(p.obuf + (long)TG * 3072 + (long)row * D + col) = o;
      }
    }
  }
}

__device__ void ph_gemm_out(const Params& p, int l, int g, char* smem) {
  for (int t = (int)gridDim.x - 1 - (int)blockIdx.x; t < 72 * 8; t += gridDim.x) {
    int nt = t / 72, mt = t % 72;
    if (l == 1 && (mt % 18) < 2) continue;
    f32x4 acc[4][4];
#pragma unroll
    for (int m = 0; m < 4; ++m)
#pragma unroll
      for (int n = 0; n < 4; ++n) acc[m][n] = f32x4{0.f, 0.f, 0.f, 0.f};
    gemm_kloopT<4, 4>(p.obuf + (long)TG * 3072 + (long)mt * 128 * D, D, 32, p.WoT + (long)nt * 128 * 32, 32, (long)D * 32, D, smem, acc);
    const int tid = otid();
    const int wr = (tid >> 7) & 1, wc = (tid >> 6) & 1, fr = tid & 15, fq = (tid >> 4) & 3;
#pragma unroll
    for (int m = 0; m < 4; ++m) {
      int row = mt * 128 + wr * 64 + m * 16 + fr;
      int bl = row / TPB, pp = row % TPB, b = g * GB + bl;
      const float* src; float* dst; int mrow;
      if (pp < CTX) { src = p.ctx + ((long)b * CTX + pp) * D; dst = p.ctxs + ((long)b * CTX + pp) * D; mrow = 16; }
      else { long off = ((long)b * SEQ + (pp - CTX)) * D; src = (l == 0 ? p.x : p.out) + off; dst = p.out + off; mrow = b; }
      const float* gt = p.mod + ((long)l * 17 + mrow) * 3072 + 2048;
#pragma unroll
      for (int n = 0; n < 4; ++n) {
        int col = nt * 128 + wc * 64 + n * 16 + fq * 4;
        float4 xv = *(const float4*)(src + col), gv = *(const float4*)(gt + col);
        float4 o;
        o.x = xv.x + gv.x * acc[m][n][0]; o.y = xv.y + gv.y * acc[m][n][1];
        o.z = xv.z + gv.z * acc[m][n][2]; o.w = xv.w + gv.w * acc[m][n][3];
        *(float4*)(dst + col) = o;
      }
    }
  }
}

__device__ void ph_final(const Params& p, int row0, int row1) {
  const int tid = otid();
  const int lane = tid & 63;
  const int gw = blockIdx.x * 4 + (tid >> 6), nw = gridDim.x * 4;
  for (int row = row0 + gw; row < row1; row += nw) {
    float4* src = (float4*)(p.out + (long)row * D);
    float4 v[4]; float ss = 0.f;
#pragma unroll
    for (int i = 0; i < 4; ++i) {
      v[i] = src[lane + 64 * i];
      ss += v[i].x * v[i].x + v[i].y * v[i].y + v[i].z * v[i].z + v[i].w * v[i].w;
    }
    ss = wave_sum(ss);
    float rs = rsqrtf(ss * (1.f / D) + 1e-6f);
#pragma unroll
    for (int i = 0; i < 4; ++i) {
      float4 g4 = ((const float4*)p.final_g)[lane + 64 * i];
      float4 o; o.x = v[i].x * rs * g4.x; o.y = v[i].y * rs * g4.y; o.z = v[i].z * rs * g4.z; o.w = v[i].w * rs * g4.w;
      src[lane + 64 * i] = o;
    }
  }
}


#define XB_TMO      128
#define XB_XCNT(j)  (256  + 64 * (j))
#define XB_XSUB(j)  (1280 + 64 * (j))
#define XB_XGEN(j)  (2304 + 64 * (j))
#define XB_TOP      3328
#define XB_TOPGEN   3392
#define XCD_BAR_WORDS 3456
#define XB_SPIN_CAP (1u << 22)
#define LAS __attribute__((address_space(3)))
__device__ __forceinline__ unsigned xb_ld(unsigned* p) { return __hip_atomic_load(p, __ATOMIC_RELAXED, __HIP_MEMORY_SCOPE_AGENT); }
__device__ __forceinline__ unsigned xb_add(unsigned* p, unsigned v) { return __hip_atomic_fetch_add(p, v, __ATOMIC_RELAXED, __HIP_MEMORY_SCOPE_AGENT); }
__device__ __forceinline__ unsigned xb_xcc_id() { return (unsigned)__builtin_amdgcn_s_getreg((3 << 11) | 20) & 0xFu; }
#define XB_SPIN(cond, bar) do { unsigned _sp = 0; while (cond) { __builtin_amdgcn_s_sleep(1); \
    if ((++_sp & 255u) == 0u) { if (xb_ld(&(bar)[XB_TMO])) break; if (_sp > XB_SPIN_CAP) { atomicAdd(&(bar)[XB_TMO], 1u); break; } } } } while (0)
struct XcdBarrier { unsigned* bar; unsigned x; volatile LAS unsigned* st; };
__device__ __forceinline__ XcdBarrier xcd_barrier_post(unsigned* bar, volatile LAS unsigned* st) {
  XcdBarrier b; b.bar = bar; b.x = xb_xcc_id(); b.st = st;
  if (threadIdx.x == 0) (void)xb_add(&bar[XB_XCNT(b.x)], 1u);
  return b;
}
__device__ __forceinline__ void xcd_barrier_complete(unsigned* bar, unsigned x, unsigned& nloc, unsigned& nx) {
  const unsigned G = gridDim.x * gridDim.y * gridDim.z;
  unsigned sum, cnt, mine, sp = 0u;
  for (;;) {
    sum = 0u; cnt = 0u; mine = 0u;
#pragma unroll
    for (unsigned j = 0; j < 16; ++j) { const unsigned c = xb_ld(&bar[XB_XCNT(j)]); sum += c; cnt += (c > 0u) ? 1u : 0u; mine = (j == x) ? c : mine; }
    if (sum == G) break;
    __builtin_amdgcn_s_sleep(1);
    if ((++sp & 255u) == 0u) { if (xb_ld(&bar[XB_TMO])) break; if (sp > XB_SPIN_CAP) { atomicAdd(&bar[XB_TMO], 1u); break; } }
  }
  nloc = mine > 0u ? mine : 1u; nx = cnt > 0u ? cnt : 1u;
}
__device__ __forceinline__ void xcd_barrier(const XcdBarrier& b) {
  asm volatile("s_waitcnt vmcnt(0)" ::: "memory");
  __syncthreads();
  if (threadIdx.x == 0) {
    unsigned* bar = b.bar;
    __builtin_amdgcn_s_waitcnt(0);
    unsigned nloc = b.st[0], nx = b.st[1];
    if (nloc == 0u) { xcd_barrier_complete(bar, b.x, nloc, nx); b.st[0] = nloc; b.st[1] = nx; }
    const unsigned old = xb_add(&bar[XB_XSUB(b.x)], 1u);
    const unsigned gen = old / nloc;
    if (old + 1u == (gen + 1u) * nloc) {
      __builtin_amdgcn_fence(__ATOMIC_RELEASE, "agent");
      asm volatile("s_waitcnt vmcnt(0)" ::: "memory");
      const unsigned og = xb_add(&bar[XB_TOP], 1u);
      const unsigned tg = og / nx;
      if (og + 1u == (tg + 1u) * nx) xb_add(&bar[XB_TOPGEN], 1u);
      else XB_SPIN(xb_ld(&bar[XB_TOPGEN]) == tg, bar);
      __builtin_amdgcn_fence(__ATOMIC_ACQUIRE, "agent");
      xb_add(&bar[XB_XGEN(b.x)], 1u);
      asm volatile("s_waitcnt vmcnt(0)" ::: "memory");
    } else {
      XB_SPIN(xb_ld(&bar[XB_XGEN(b.x)]) == gen, bar);
      __builtin_amdgcn_fence(__ATOMIC_ACQUIRE, "agent");
      asm volatile("s_waitcnt vmcnt(0)" ::: "memory");
    }
  }
  __syncthreads();
}

#if !COOP
#error multi-launch path removed
#else
__global__ void __launch_bounds__(256, 2) k_mega(Params p) {
  __shared__ __attribute__((aligned(16))) char smem[74240];
  __shared__ uint4 xb_words;
  cg::grid_group grid = cg::this_grid();
  if (threadIdx.x == 0) xb_words = make_uint4(0u, 0u, 0u, 0u);
  __syncthreads();
  XcdBarrier xb = xcd_barrier_post(p.bar, (volatile LAS unsigned*)&xb_words);
#define GSYNC() xcd_barrier(xb)
  ph_prep_small(p);
  ph_mod(p, smem);
  if (xb_ld(&p.bar[XB_TMO]) == 0x7fffffffu) grid.sync();
#pragma unroll 1
  for (int l = 0; l < 2; ++l) {
    ph_convert(p, l, smem);
    GSYNC();
#pragma unroll 1
    for (int g = 0; g < NGRP; ++g) {
      if (l == 0 && g == 0) { ph_prenorm(p, 0, 0); GSYNC(); }
      if (g == 0) { ph_gemm_in_a(p, l, smem); GSYNC(); }
      ph_conv(p, l);
      if (l == 1 && g > 0) ph_final(p, (g - 1) * GB * SEQ, g * GB * SEQ);
      GSYNC();
      ph_gdn_prep(p, l, smem); GSYNC();
      ph_scan(p, l, g, smem); GSYNC();
      ph_brfin(p, l, g);
      if (g + 1 < NGRP) ph_prenorm(p, l, g + 1); else if (l == 0) ph_prenorm(p, 1, 0);
      GSYNC();
      ph_gemm_merge(p, l, smem); GSYNC();
      ph_gemm_out(p, l, g, smem);
      if (g + 1 < NGRP) ph_gemm_in_a(p, l, smem);
      GSYNC();
    }
  }
  ph_final(p, (NGRP - 1) * GB * SEQ, NB * SEQ);
}
#endif

extern "C" void kernel_launch(void* const* d_in, const int* in_sizes, int n_in, void* d_out, int out_size, void* d_ws,
                              size_t ws_size, hipStream_t stream) {
  Params p{};
  p.x = (const float*)d_in[0]; p.c = (const float*)d_in[1]; p.ctx = (const float*)d_in[2]; p.c_ctx = (const float*)d_in[3];
  p.ada_w = (const float*)d_in[4]; p.ada_b = (const float*)d_in[5]; p.norm_g = (const float*)d_in[6]; p.w_in = (const float*)d_in[7];
  p.hg_lb = (const float*)d_in[8]; p.hg_onorm = (const float*)d_in[9]; p.gdn_conv = (const float*)d_in[10];
  p.gdn_a_log = (const float*)d_in[11]; p.gdn_dt_bias = (const float*)d_in[12]; p.gdn_onorm = (const float*)d_in[13];
  p.ml_i_bias = (const float*)d_in[14]; p.ml_f_bias = (const float*)d_in[15]; p.ml_onorm = (const float*)d_in[16];
  p.w_branch = (const float*)d_in[17]; p.w_out = (const float*)d_in[18]; p.final_g = (const float*)d_in[19];
  p.out = (float*)d_out;
  char* ws = (char*)d_ws;
  size_t off = 0;
  auto take = [&](size_t bytes) { char* r = ws + off; off += (bytes + 255) & ~(size_t)255; return r; };
  p.WinT = (u16*)take((size_t)NPAD * D * 2);
  p.WbrT = (u16*)take((size_t)3 * D * D * 2);
  p.WoT = (u16*)take((size_t)D * D * 2);
  p.hbuf = (u16*)take((size_t)TG * D * 2);
  p.proj = (u16*)take((size_t)TG * PLD * 2);
  p.obuf = (u16*)take((size_t)2 * TG * 3072 * 2);
  p.mod = (float*)take((size_t)2 * 17 * 3072 * 4);
  p.lb = (float*)take((size_t)2 * D * 4);
  p.silc = (float*)take((size_t)17 * D * 4);
  p.gates = (float*)take((size_t)TG * GLD * 4);
  p.ctxs = (float*)take((size_t)NB * CTX * D * 4);
  p.bar = (unsigned*)take((size_t)BAR_TOTAL_WORDS * 4);
  p.gprep = (u16*)take((size_t)4608 * 4352);
  p.mprep = (float*)take((size_t)2304 * 96 * 4);
  if (off > ws_size) { fprintf(stderr, "workspace too small: need %zu have %zu\n", off, ws_size); return; }

  static int grid_blocks = 0;
  if (!grid_blocks) {
    int dev = 0, cus = 0, per_cu = 0;
    hipGetDevice(&dev);
    hipDeviceGetAttribute(&cus, hipDeviceAttributeMultiprocessorCount, dev);
#if COOP
    hipOccupancyMaxActiveBlocksPerMultiprocessor(&per_cu, k_mega, 256, 0);
#else
    hipOccupancyMaxActiveBlocksPerMultiprocessor(&per_cu, k_step, 256, 0);
#endif
    if (per_cu < 1) per_cu = 1;
    if (per_cu > 2) per_cu = 2;
    grid_blocks = cus * per_cu;
  }
#if COOP
  hipMemsetAsync(p.bar, 0, (size_t)BAR_TOTAL_WORDS * 4, stream);
  void* args[] = {&p};
  hipError_t e = hipLaunchCooperativeKernel((void*)k_mega, dim3(grid_blocks), dim3(256), args, 0, stream);
  if (e != hipSuccess) fprintf(stderr, "cooperative launch failed: %s (grid %d)\n", hipGetErrorString(e), grid_blocks);
#else
  for (int s = 0; s < NSTEPS; ++s) k_step<<<grid_blocks, 256, 0, stream>>>(p, s);
#endif
}
```

```cpp
#include <hip/hip_runtime.h>
#include <hip/hip_bf16.h>
#include <hip/hip_cooperative_groups.h>
#include <cstdio>
namespace cg = cooperative_groups;

#define REP_PRE 1
#define REP_GIN 1
#define REP_SCAN 1
#define REP_MRG 1
#define REP_SYNC 0
#define SPL_G 3
#define SPL_H 3
#define SPL_M 1
#define SPL_F 9
#define XB_CTR(j)  (3456 + 64 * (j))
#define BAR_TOTAL_WORDS (3456 + 8 * 64)
#ifndef COOP
#define COOP 1
#endif

typedef unsigned short u16;
using bf16x8 = __attribute__((ext_vector_type(8))) short;
using f32x4 = __attribute__((ext_vector_type(4))) float;

constexpr int D = 1024;
constexpr int NB = 16;
constexpr int SEQ = 2048;
constexpr int CTX = 256;
constexpr int TPB = SEQ + CTX;
constexpr int GB = 4;
constexpr int NGRP = NB / GB;
constexpr int TG = GB * TPB;
constexpr int IN_DIM = 16432;
constexpr int NPAD = 16512;
constexpr int PLD = 16384;
constexpr int GLD = 64;
constexpr int TC = 32;
constexpr int C_HGQ = 0, C_HGI = 1024, C_HGF = 2048, C_HGZ = 4096;
constexpr int C_GQ = 5120, C_GK = 6144, C_GV = 7168, C_GZ = 8192;
constexpr int C_MQ = 9216, C_MK = 9728, C_MV = 10240, C_MO = 11264, C_MZ = 12288;
constexpr int C_GATE = 13312;

struct Params {
  const float *x, *c, *ctx, *c_ctx, *ada_w, *ada_b, *norm_g, *w_in, *hg_lb, *hg_onorm, *gdn_conv,
      *gdn_a_log, *gdn_dt_bias, *gdn_onorm, *ml_i_bias, *ml_f_bias, *ml_onorm, *w_branch, *w_out, *final_g;
  float* out;
  u16 *WinT, *WbrT, *WoT, *hbuf, *proj, *obuf;
  float *mod, *lb, *silc, *gates, *ctxs;
  unsigned* bar;
  u16* gprep;
  float* mprep;
};

typedef __bf16 bf16v2 __attribute__((ext_vector_type(2)));
typedef float f32v2 __attribute__((ext_vector_type(2)));
__device__ __forceinline__ unsigned pack2(float a, float b) {
  f32v2 v = {a, b};
  return __builtin_bit_cast(unsigned, __builtin_convertvector(v, bf16v2));
}
__device__ __forceinline__ u16 f2bf(float f) { return (u16)(pack2(f, 0.f) & 0xffffu); }
__device__ __forceinline__ float bf2f(u16 h) { return __uint_as_float(((unsigned)h) << 16); }
__device__ __forceinline__ float sigmoidf_(float x) { return 1.f / (1.f + __expf(-x)); }
__device__ __forceinline__ float siluf_(float x) { return x / (1.f + __expf(-x)); }
__device__ __forceinline__ float softplusf_(float y) { return fmaxf(y, 0.f) + log1pf(__expf(-fabsf(y))); }
__device__ __forceinline__ float wave_sum(float v) {
#pragma unroll
  for (int o = 32; o >= 1; o >>= 1) v += __shfl_xor(v, o);
  return v;
}
__device__ __forceinline__ void unpack8(const uint4& u, float* f) {
  f[0] = __uint_as_float(u.x << 16); f[1] = __uint_as_float(u.x & 0xffff0000u);
  f[2] = __uint_as_float(u.y << 16); f[3] = __uint_as_float(u.y & 0xffff0000u);
  f[4] = __uint_as_float(u.z << 16); f[5] = __uint_as_float(u.z & 0xffff0000u);
  f[6] = __uint_as_float(u.w << 16); f[7] = __uint_as_float(u.w & 0xffff0000u);
}

__device__ __forceinline__ int otid() { int t = threadIdx.x; asm volatile("" : "+v"(t)); return t; }
__device__ __forceinline__ int win_src_col(int np) {
  if (np < 9216) return np;
  if (np < 13312) return np + 32;
  if (np < 16384) return np + 48;
  if (np < 16416) return 9216 + (np - 16384);
  if (np < 16432) return 13344 + (np - 16416);
  return -1;
}

__device__ void ph_convert(const Params& p, int l, char* smem) {
  float (*tile)[65] = (float (*)[65])smem;
  const int tid = otid();
  for (int t = blockIdx.x; t < 5152; t += gridDim.x) {
    const float* src; long sld; u16* dst; int n0, k0, kind; long ntot = D;
    if (t < 4128) { kind = 0; ntot = NPAD; n0 = (t / 16) * 64; k0 = (t % 16) * 64; src = p.w_in + (long)l * D * IN_DIM; sld = IN_DIM; dst = p.WinT; }
    else if (t < 4896) { int u = t - 4128; int i = u / 256; u %= 256; kind = 1; n0 = (u / 16) * 64; k0 = (u % 16) * 64;
      src = p.w_branch + ((long)l * 3 + i) * D * D; sld = D; dst = p.WbrT + (long)i * D * D; }
    else { int u = t - 4896; kind = 1; n0 = (u / 16) * 64; k0 = (u % 16) * 64; src = p.w_out + (long)l * D * D; sld = D; dst = p.WoT; }
#pragma unroll 4
    for (int i = 0; i < 16; ++i) {
      int kk = (tid >> 6) + 4 * i, nn = tid & 63;
      int np = n0 + nn;
      int ns = kind == 0 ? win_src_col(np) : np;
      tile[kk][nn] = ns >= 0 ? src[(long)(k0 + kk) * sld + ns] : 0.f;
    }
    __syncthreads();
#pragma unroll 4
    for (int i = 0; i < 16; ++i) {
      int nn = (tid >> 6) + 4 * i, kk = tid & 63;
      dst[((long)((k0 + kk) >> 5) * ntot + (n0 + nn)) * 32 + ((k0 + kk) & 31)] = f2bf(tile[kk][nn]);
    }
    __syncthreads();
  }
}

__device__ void ph_prep_small(const Params& p) {
  int gt = blockIdx.x * blockDim.x + otid(), gs = gridDim.x * blockDim.x;
  for (int j = gt; j < 2 * D; j += gs) {
    if (j < D) p.lb[j] = 0.f;
    else { int ch = j - D; p.lb[j] = sigmoidf_(p.hg_lb[D + ch] - p.hg_lb[ch]); }
  }
}

__device__ void ph_mod(const Params& p, char* smem) {
  float (*sl)[D] = (float (*)[D])smem;
  float (*red)[17][64] = (float (*)[17][64])smem;
  const int tid = otid();
  const int kq = __builtin_amdgcn_readfirstlane(tid >> 6), cc = tid & 63;
  for (int u = blockIdx.x; u < 96; u += gridDim.x) {
    for (int i = tid; i < 17 * D; i += 256) sl[0][i] = siluf_(i < 16 * D ? p.c[i] : p.c_ctx[i - 16 * D]);
    __syncthreads();
    int l = u / 48, col = (u % 48) * 64 + cc;
    float acc[17];
#pragma unroll
    for (int r = 0; r < 17; ++r) acc[r] = 0.f;
    const float* w = p.ada_w + (long)l * D * 3072 + col;
#pragma unroll 4
    for (int k = kq * 256; k < kq * 256 + 256; ++k) {
      float wv = w[(long)k * 3072];
#pragma unroll
      for (int r = 0; r < 17; ++r) acc[r] += sl[r][k] * wv;
    }
    __syncthreads();
#pragma unroll
    for (int r = 0; r < 17; ++r) red[kq][r][cc] = acc[r];
    __syncthreads();
    for (int i = tid; i < 17 * 64; i += 256) {
      int r = i / 64, c2 = i % 64;
      int colo = (u % 48) * 64 + c2;
      float s_ = red[0][r][c2] + red[1][r][c2] + red[2][r][c2] + red[3][r][c2] + p.ada_b[l * 3072 + colo];
      p.mod[((long)l * 17 + r) * 3072 + colo] = s_;
    }
    __syncthreads();
  }
}

__device__ void ph_prenorm(const Params& p, int l, int g) {
  const int tid = otid();
  const int lane = tid & 63;
  const int gw = blockIdx.x * 4 + (tid >> 6), nw = gridDim.x * 4;
  for (int row = gw; row < TG; row += nw) {
    int bl = row / TPB, pp = row % TPB, b = g * GB + bl;
    const float* src; int mrow;
    if (pp < CTX) { src = (l == 0 ? p.ctx : p.ctxs) + ((long)b * CTX + pp) * D; mrow = 16; }
    else { src = (l == 0 ? p.x : p.out) + ((long)b * SEQ + (pp - CTX)) * D; mrow = b; }
    const float* md = p.mod + ((long)l * 17 + mrow) * 3072;
    float4 v[4]; float ss = 0.f;
#pragma unroll
    for (int i = 0; i < 4; ++i) {
      v[i] = ((const float4*)src)[lane + 64 * i];
      ss += v[i].x * v[i].x + v[i].y * v[i].y + v[i].z * v[i].z + v[i].w * v[i].w;
    }
    ss = wave_sum(ss);
    float rs = rsqrtf(ss * (1.f / D) + 1e-6f);
#pragma unroll
    for (int i = 0; i < 4; ++i) {
      int idx = (lane + 64 * i) * 4;
      float4 g4 = *(const float4*)(p.norm_g + l * D + idx);
      float4 sh = *(const float4*)(md + idx);
      float4 sc = *(const float4*)(md + D + idx);
      float h0 = v[i].x * rs * g4.x * (1.f + sc.x) + sh.x;
      float h1 = v[i].y * rs * g4.y * (1.f + sc.y) + sh.y;
      float h2 = v[i].z * rs * g4.z * (1.f + sc.z) + sh.z;
      float h3 = v[i].w * rs * g4.w * (1.f + sc.w) + sh.w;
      uint2 o; o.x = pack2(h0, h1); o.y = pack2(h2, h3);
      *(uint2*)(p.hbuf + ((long)(idx >> 5) * TG + row) * 32 + (idx & 31)) = o;
    }
  }
}

template <int MF, int NF>
__device__ __forceinline__ void gemm_kloopT(const u16* Ag, long lda, long aks, const u16* Bg, long ldb, long bks, int K, char* smem, f32x4 (&acc)[MF][NF]) {
  const int tid = otid();
  const int wid = tid >> 6, lane = tid & 63, wr = wid >> 1, wc = wid & 1, fr = lane & 15, fq = lane >> 4;
  constexpr int ASZ = MF * 32 * 64;
  constexpr int BSZ = NF * 32 * 64;
  constexpr int SSZ = ASZ + BSZ;
  constexpr int NLD = MF / 2 + NF / 2;
  const int lrow = tid >> 2, cs = tid & 3;
  const int cgl = cs ^ (((lrow >> 3) & 1) << 1);
  const u16* Ap = Ag + (long)lrow * lda + cgl * 8;
  const u16* Bp = Bg + (long)lrow * ldb + cgl * 8;
  const int nt = K / 32;
#define GK_ISSUE(T, S)                                                                                                   \
  {                                                                                                                      \
    char* _SA = smem + (S) * SSZ; char* _SB = _SA + ASZ;                                                                 \
    _Pragma("unroll") for (int _i = 0; _i < MF / 2; ++_i)                                                                \
      __builtin_amdgcn_global_load_lds((const unsigned*)(Ap + (long)_i * 64 * lda + (long)(T) * aks),                           \
                                       (__attribute__((address_space(3))) unsigned*)(_SA + _i * 4096 + tid * 16), 16, 0, 0); \
    _Pragma("unroll") for (int _i = 0; _i < NF / 2; ++_i)                                                                \
      __builtin_amdgcn_global_load_lds((const unsigned*)(Bp + (long)_i * 64 * ldb + (long)(T) * bks),                           \
                                       (__attribute__((address_space(3))) unsigned*)(_SB + _i * 4096 + tid * 16), 16, 0, 0); \
  }
  GK_ISSUE(0, 0)
  GK_ISSUE(1, 1)
  const int co = (fq ^ (((fr >> 3) & 1) << 1)) * 16;
#define GK_STEP(T, ST, S2, LAST1, LAST2)                                                                                 \
  {                                                                                                                      \
    if (!(LAST1)) asm volatile("s_waitcnt vmcnt(%0)" ::"n"(NLD) : "memory");                                             \
    else asm volatile("s_waitcnt vmcnt(0)" ::: "memory");                                                                \
    __builtin_amdgcn_s_barrier();                                                                                        \
    if (!(LAST2)) GK_ISSUE((T) + 2, S2)                                                                                  \
    bf16x8 At[MF], Bl[NF];                                                                                               \
    _Pragma("unroll") for (int m = 0; m < MF; ++m)                                                                       \
      asm volatile("ds_read_b128 %0, %1 offset:%2" : "=v"(At[m]) : "v"(aA), "n"((ST) * SSZ + m * 1024));                  \
    _Pragma("unroll") for (int n = 0; n < NF; ++n)                                                                       \
      asm volatile("ds_read_b128 %0, %1 offset:%2" : "=v"(Bl[n]) : "v"(aB), "n"((ST) * SSZ + n * 1024));                  \
    if (MF == 8 && NF == 4)                                                                                              \
      asm volatile("s_waitcnt lgkmcnt(0)" : "+v"(At[0]), "+v"(At[1]), "+v"(At[2]), "+v"(At[3]), "+v"(At[MF - 4]), "+v"(At[MF - 3]), \
                   "+v"(At[MF - 2]), "+v"(At[MF - 1]), "+v"(Bl[0]), "+v"(Bl[1]), "+v"(Bl[NF - 2]), "+v"(Bl[NF - 1]));    \
    else if (MF == 8)                                                                                                    \
      asm volatile("s_waitcnt lgkmcnt(0)" : "+v"(At[0]), "+v"(At[1]), "+v"(At[2]), "+v"(At[3]), "+v"(At[MF - 4]), "+v"(At[MF - 3]), \
                   "+v"(At[MF - 2]), "+v"(At[MF - 1]), "+v"(Bl[0]), "+v"(Bl[1]));                                        \
    else                                                                                                                 \
      asm volatile("s_waitcnt lgkmcnt(0)" : "+v"(At[0]), "+v"(At[1]), "+v"(At[2]), "+v"(At[3]),                          \
                   "+v"(Bl[0]), "+v"(Bl[1]), "+v"(Bl[NF - 2]), "+v"(Bl[NF - 1]));                                        \
    _Pragma("unroll") for (int m = 0; m < MF; ++m)                                                                       \
      _Pragma("unroll") for (int n = 0; n < NF; ++n)                                                                     \
        acc[m][n] = __builtin_amdgcn_mfma_f32_16x16x32_bf16(Bl[n], At[m], acc[m][n], 0, 0, 0);                           \
  }
  const unsigned lds0 = (unsigned)(unsigned long)(__attribute__((address_space(3))) const char*)smem;
  const unsigned aA = lds0 + (wr * MF * 16 + fr) * 64 + co;
  const unsigned aB = lds0 + ASZ + (wc * NF * 16 + fr) * 64 + co;
  for (int t = 0; t < nt - 2; t += 3) {
    GK_STEP(t, 0, 2, false, false)
    GK_STEP(t + 1, 1, 0, false, false)
    GK_STEP(t + 2, 2, 1, false, false)
  }
  GK_STEP(nt - 2, 0, 2, false, true)
  GK_STEP(nt - 1, 1, 0, true, true)
#undef GK_STEP
  __builtin_amdgcn_s_barrier();
#undef GK_ISSUE
}

template <int MF>
__device__ __forceinline__ void gemm_in_tile(const Params& p, int l, char* smem, int mt, int nt) {
  f32x4 acc[MF][4];
#pragma unroll
  for (int m = 0; m < MF; ++m)
#pragma unroll
    for (int n = 0; n < 4; ++n) acc[m][n] = f32x4{0.f, 0.f, 0.f, 0.f};
  gemm_kloopT<MF, 4>(p.hbuf + (long)mt * (MF * 32) * 32, 32, (long)TG * 32, p.WinT + (long)nt * 128 * 32, 32, (long)NPAD * 32, D, smem, acc);
  const int tid = otid();
  const int wr = (tid >> 7) & 1, wc = (tid >> 6) & 1, fr = tid & 15, fq = (tid >> 4) & 3;
  if (nt < 128) {
    u16* dbase; long dld; int cb;
    if (nt >= 40 && nt < 64) { dbase = p.obuf; dld = 3072; cb = (nt - 40) * 128; }
    else { dbase = p.proj; dld = PLD; cb = nt * 128; }
#pragma unroll
    for (int m = 0; m < MF; ++m) {
      int row = mt * (MF * 32) + wr * (MF * 16) + m * 16 + fr;
#pragma unroll
      for (int n = 0; n < 4; ++n) {
        int col = cb + wc * 64 + n * 16 + fq * 4;
        if (nt >= 16 && nt < 32) {
          float4 lb4 = *(const float4*)(p.lb + l * D + ((col - C_HGF) & 1023));
          acc[m][n][0] = __logf(lb4.x + (1.f - lb4.x) * sigmoidf_(acc[m][n][0]));
          acc[m][n][1] = __logf(lb4.y + (1.f - lb4.y) * sigmoidf_(acc[m][n][1]));
          acc[m][n][2] = __logf(lb4.z + (1.f - lb4.z) * sigmoidf_(acc[m][n][2]));
          acc[m][n][3] = __logf(lb4.w + (1.f - lb4.w) * sigmoidf_(acc[m][n][3]));
        }
        uint2 o; o.x = pack2(acc[m][n][0], acc[m][n][1]); o.y = pack2(acc[m][n][2], acc[m][n][3]);
        *(uint2*)(dbase + (long)row * dld + col) = o;
      }
    }
  } else if (wc == 0) {
#pragma unroll
    for (int m = 0; m < MF; ++m) {
      int row = mt * (MF * 32) + wr * (MF * 16) + m * 16 + fr;
#pragma unroll
      for (int n = 0; n < 4; ++n) {
        int col = n * 16 + fq * 4;
        *(float4*)(p.gates + (long)row * GLD + col) = float4{acc[m][n][0], acc[m][n][1], acc[m][n][2], acc[m][n][3]};
      }
    }
  }
}

__device__ void ph_gemm_in_a(const Params& p, int l, char* smem) {
  for (int t = blockIdx.x; t < 36 * 73; t += gridDim.x) {
    int i = t / 36, mt = t % 36;
    int nt = i < 32 ? i : (i < 56 ? 40 + (i - 32) : (i < 72 ? 72 + (i - 56) : 128));
    gemm_in_tile<8>(p, l, smem, mt, nt);
  }
}
__device__ __forceinline__ void gemm_in_b_tile(const Params& p, int l, char* smem, int tb) {
  constexpr int QB_ALL = 36 * 56, QB_TAIL = 256, QB_BIG = QB_ALL - QB_TAIL;
  int half = -1;
  if (tb >= QB_BIG) { int hb = tb - QB_BIG; tb = QB_BIG + (hb >> 1); half = hb & 1; }
  int i = tb / 36, mt = tb % 36;
  if (l == 1 && (mt % 9) == 0) return;
  int nt = i < 8 ? 32 + i : (i < 16 ? 64 + (i - 8) : 88 + (i - 16));
  if (half < 0) gemm_in_tile<8>(p, l, smem, mt, nt);
  else gemm_in_tile<4>(p, l, smem, mt * 2 + half, nt);
}
constexpr int QB_END = 36 * 56 + 256;

template <int MODE>
__device__ __forceinline__ void conv_pass(const Params& p, int l, int gw, int nw, int lane) {
  const u16* stg = p.obuf;
  const int c8 = lane & 15;
  int chn, ntask, tshift;
  bool isq = false;
  if (MODE == 0) {
    const int hp = gw & 3, sub = lane >> 5, part = (lane >> 4) & 1;
    chn = part * 1024 + (hp * 2 + sub) * 128 + c8 * 8; ntask = TG * 4; tshift = 2; isq = (part == 0);
  } else {
    const int hq = gw & 1, sub = lane >> 4;
    chn = 2048 + (hq * 4 + sub) * 128 + c8 * 8; ntask = TG * 2; tshift = 1;
  }
  float4 wa[9], wb[9];
  {
    const float* cwb = p.gdn_conv + (long)l * 9 * 3072 + chn;
#pragma unroll
    for (int k = 0; k < 9; ++k) { wa[k] = *(const float4*)(cwb + k * 3072); wb[k] = *(const float4*)(cwb + k * 3072 + 4); }
  }
  uint4 nx0, nx1, nx2, nx3, nx4, nx5, nx6, nx7, nx8;
#define CONV_LOAD(TASK)                                                                                        \
  {                                                                                                            \
    const uint4 _z = uint4{0u, 0u, 0u, 0u};                                                                    \
    nx0 = nx1 = nx2 = nx3 = nx4 = nx5 = nx6 = nx7 = nx8 = _z;                                                  \
    if ((TASK) < ntask) {                                                                                      \
      int _row = (TASK) >> tshift, _bl = _row / TPB, _t = _row % TPB;                                          \
      const u16* _b = stg + (long)_bl * TPB * 3072 + chn;                                                      \
      if (_t < CTX) {                                                                                          \
        if (_t > 0) nx3 = *(const uint4*)(_b + (long)(_t - 1) * 3072);                                         \
        nx4 = *(const uint4*)(_b + (long)_t * 3072);                                                           \
        if (_t < CTX - 1) nx5 = *(const uint4*)(_b + (long)(_t + 1) * 3072);                                   \
      } else {                                                                                                 \
        int _lt = _t - CTX, _r = _lt >> 6, _c = _lt & 63;                                                      \
        const u16* _q = _b + (long)(CTX + _lt) * 3072;                                                         \
        bool _u = _r > 0, _d = _r < 31, _l = _c > 0, _rr = _c < 63;                                            \
        if (_u && _l) nx0 = *(const uint4*)(_q - 65 * 3072);                                                   \
        if (_u) nx1 = *(const uint4*)(_q - 64 * 3072);                                                         \
        if (_u && _rr) nx2 = *(const uint4*)(_q - 63 * 3072);                                                  \
        if (_l) nx3 = *(const uint4*)(_q - 1 * 3072);                                                          \
        nx4 = *(const uint4*)(_q);                                                                             \
        if (_rr) nx5 = *(const uint4*)(_q + 1 * 3072);                                                         \
        if (_d && _l) nx6 = *(const uint4*)(_q + 63 * 3072);                                                   \
        if (_d) nx7 = *(const uint4*)(_q + 64 * 3072);                                                         \
        if (_d && _rr) nx8 = *(const uint4*)(_q + 65 * 3072);                                                  \
      }                                                                                                        \
    }                                                                                                          \
  }
#define CONV_TAP(R, K)                                                                                         \
  {                                                                                                            \
    float xv[8]; unpack8(R, xv);                                                                               \
    val[0] += xv[0] * wa[K].x; val[1] += xv[1] * wa[K].y; val[2] += xv[2] * wa[K].z; val[3] += xv[3] * wa[K].w; \
    val[4] += xv[4] * wb[K].x; val[5] += xv[5] * wb[K].y; val[6] += xv[6] * wb[K].z; val[7] += xv[7] * wb[K].w; \
  }
  CONV_LOAD(gw)
  for (int task = gw; task < ntask; task += nw) {
    const uint4 c0 = nx0, c1 = nx1, c2 = nx2, c3 = nx3, c4 = nx4, c5 = nx5, c6 = nx6, c7 = nx7, c8r = nx8;
    CONV_LOAD(task + nw)
    int row = task >> tshift;
    float val[8];
#pragma unroll
    for (int e = 0; e < 8; ++e) val[e] = 0.f;
    CONV_TAP(c0, 0) CONV_TAP(c1, 1) CONV_TAP(c2, 2) CONV_TAP(c3, 3) CONV_TAP(c4, 4)
    CONV_TAP(c5, 5) CONV_TAP(c6, 6) CONV_TAP(c7, 7) CONV_TAP(c8r, 8)
    float ss = 0.f;
#pragma unroll
    for (int e = 0; e < 8; ++e) { val[e] = siluf_(val[e]); ss += val[e] * val[e]; }
    float scl = 1.f;
    if (MODE == 0) {
      ss += __shfl_xor(ss, 1); ss += __shfl_xor(ss, 2); ss += __shfl_xor(ss, 4); ss += __shfl_xor(ss, 8);
      scl = rsqrtf(ss + 1e-6f) * (isq ? 0.08838834764831845f : 1.f);
    }
    uint4 o;
    o.x = pack2(val[0] * scl, val[1] * scl); o.y = pack2(val[2] * scl, val[3] * scl);
    o.z = pack2(val[4] * scl, val[5] * scl); o.w = pack2(val[6] * scl, val[7] * scl);
    *(uint4*)(p.proj + (long)row * PLD + C_GQ + chn) = o;
  }
#undef CONV_LOAD
#undef CONV_TAP
}

__device__ void ph_conv(const Params& p, int l) {
  const int tid = otid();
  const int lane = tid & 63;
  const int gw = blockIdx.x * 4 + (tid >> 6), nw = gridDim.x * 4;
  conv_pass<0>(p, l, gw, nw, lane);
  conv_pass<1>(p, l, gw, nw, lane);
}

struct ScanSmem {
  float q[TC][128];
  float k[TC][128];
  float f[TC][128];
  float v[TC][64];
  float sc[TC][4];
};

__device__ __forceinline__ int scan_row(int bl, int dir, int pos) {
  int t;
  if (pos < CTX) t = dir ? (CTX - 1 - pos) : pos;
  else { int u = pos - CTX; t = CTX + (dir ? (SEQ - 1 - u) : u); }
  return bl * TPB + t;
}

__device__ void scan_unit(const Params& p, int l, int g, int u, ScanSmem& sm) {
  const int tid = otid(), lane = tid & 63, w = tid >> 6;
  const int j = lane & 15, gq = lane >> 4;
  const int mixer = u / 128, r = u % 128;
  int bl, h, dir, vs;
  bl = r / 32;
  if (mixer < 2) { h = (r % 32) / 4; dir = (r % 4) / 2; vs = r % 2; }
  else { h = (r % 32) / 8; dir = (r % 8) / 4; vs = r % 4; }
  int cq, ck, cv, ocol;
  if (mixer == 0) { cq = C_HGQ + h * 128; ck = C_HGF + dir * 1024 + h * 128; cv = C_HGI + h * 128 + vs * 64; ocol = h * 128 + vs * 64; }
  else if (mixer == 1) { cq = C_GQ + h * 128; ck = C_GK + h * 128; cv = C_GV + h * 128 + vs * 64; ocol = 1024 + h * 128 + vs * 64; }
  else { cq = C_MQ + h * 128; ck = C_MK + h * 128; cv = C_MV + h * 256 + vs * 64; ocol = 2048 + h * 256 + vs * 64; }

  float S[32];
#pragma unroll
  for (int i = 0; i < 32; ++i) S[i] = 0.f;
  float n0 = 0.f, n1 = 0.f;
  float mstate = 0.f;
  float gA = 0.f, gDt = 0.f, ibias = 0.f, fbias = 0.f;
  if (mixer == 1) { gA = -__expf(p.gdn_a_log[l * 16 + dir * 8 + h]); gDt = p.gdn_dt_bias[l * 16 + dir * 8 + h]; }
  if (mixer == 2) { ibias = p.ml_i_bias[l * 8 + dir * 4 + h]; fbias = p.ml_f_bias[l * 8 + dir * 4 + h]; }

  __syncthreads();
  if (mixer == 1) {
    float* cw = &sm.f[0][0];
    for (int i = tid; i < 9 * 320; i += 256) {
      int tap = i / 320, lc = i % 320;
      int ch = lc < 128 ? (h * 128 + lc) : (lc < 256 ? (1024 + h * 128 + lc - 128) : (2048 + h * 128 + vs * 64 + lc - 256));
      cw[i] = p.gdn_conv[((long)l * 9 + tap) * 3072 + ch];
    }
    __syncthreads();
  }

  for (int ch0 = 0; ch0 < TPB / TC; ++ch0) {
    const int pos0 = ch0 * TC;
    const bool is_ctx = pos0 < CTX;
    __syncthreads();
    for (int idx = tid; idx < TC * 40; idx += 256) {
      int tok = idx / 40, cgp = idx % 40;
      int row = scan_row(bl, dir, pos0 + tok);
      int col, lc;
      if (cgp < 16) { col = cq + cgp * 8; lc = cgp * 8; }
      else if (cgp < 32) { col = ck + (cgp - 16) * 8; lc = 128 + (cgp - 16) * 8; }
      else { col = cv + (cgp - 32) * 8; lc = 256 + (cgp - 32) * 8; }
      float val[8];
      if (mixer != 1) {
        uint4 raw = *(const uint4*)(p.proj + (long)row * PLD + col);
        unpack8(raw, val);
      } else {
        const float* cw = &sm.f[0][0];
#pragma unroll
        for (int e = 0; e < 8; ++e) val[e] = 0.f;
        int t = row - bl * TPB;
        if (is_ctx) {
#pragma unroll
          for (int jj = 0; jj < 3; ++jj) {
            int tt = t + jj - 1;
            if (tt >= 0 && tt < CTX) {
              uint4 raw = *(const uint4*)(p.proj + (long)(bl * TPB + tt) * PLD + col);
              float xv[8]; unpack8(raw, xv);
              const float* wv = cw + (3 + jj) * 320 + lc;
#pragma unroll
              for (int e = 0; e < 8; ++e) val[e] += xv[e] * wv[e];
            }
          }
        } else {
          int lt = t - CTX, rr0 = lt >> 6, cc0 = lt & 63;
#pragma unroll
          for (int ii = 0; ii < 3; ++ii) {
            int rr = rr0 + ii - 1;
            if (rr < 0 || rr >= 32) continue;
#pragma unroll
            for (int jj = 0; jj < 3; ++jj) {
              int cc = cc0 + jj - 1;
              if (cc < 0 || cc >= 64) continue;
              uint4 raw = *(const uint4*)(p.proj + (long)(bl * TPB + CTX + rr * 64 + cc) * PLD + col);
              float xv[8]; unpack8(raw, xv);
              const float* wv = cw + (ii * 3 + jj) * 320 + lc;
#pragma unroll
              for (int e = 0; e < 8; ++e) val[e] += xv[e] * wv[e];
            }
          }
        }
#pragma unroll
        for (int e = 0; e < 8; ++e) val[e] = siluf_(val[e]);
      }
      if (cgp < 16) {
        float scl = (mixer == 2) ? 0.08838834764831845f : 1.f;
#pragma unroll
        for (int e = 0; e < 8; ++e) sm.q[tok][lc + e] = val[e] * scl;
      } else if (cgp < 32) {
        int d0 = lc - 128;
        if (mixer == 0) {
#pragma unroll
          for (int e = 0; e < 8; ++e) {
            float lbv = p.lb[l * D + h * 128 + d0 + e];
            float f = lbv + (1.f - lbv) * sigmoidf_(val[e]);
            sm.f[tok][d0 + e] = f;
            sm.k[tok][d0 + e] = 1.f - f;
          }
        } else {
#pragma unroll
          for (int e = 0; e < 8; ++e) sm.k[tok][d0 + e] = val[e];
        }
      } else {
        int c0 = lc - 256;
#pragma unroll
        for (int e = 0; e < 8; ++e) sm.v[tok][c0 + e] = val[e];
      }
    }
    if (mixer == 2 && tid < TC) {
      int row = scan_row(bl, dir, pos0 + tid);
      float ig = p.gates[(long)row * GLD + 32 + dir * 4 + h] + ibias;
      float fx = p.gates[(long)row * GLD + 40 + dir * 4 + h] + fbias;
      sm.sc[tid][0] = ig;
      sm.sc[tid][1] = -softplusf_(-fx);
    }
    __syncthreads();
    if (mixer == 1) {
      for (int tk = w * 8; tk < w * 8 + 8; ++tk) {
        float q0 = sm.q[tk][lane], q1 = sm.q[tk][lane + 64], k0 = sm.k[tk][lane], k1 = sm.k[tk][lane + 64];
        float sq = wave_sum(q0 * q0 + q1 * q1), sk = wave_sum(k0 * k0 + k1 * k1), qk = wave_sum(q0 * k0 + q1 * k1);
        float rq = rsqrtf(sq + 1e-6f) * 0.08838834764831845f, rk = rsqrtf(sk + 1e-6f);
        sm.q[tk][lane] = q0 * rq; sm.q[tk][lane + 64] = q1 * rq;
        sm.k[tk][lane] = k0 * rk; sm.k[tk][lane + 64] = k1 * rk;
        if (lane == 0) {
          int row = scan_row(bl, dir, pos0 + tk);
          float beta = sigmoidf_(p.gates[(long)row * GLD + dir * 8 + h]);
          float gg = gA * softplusf_(p.gates[(long)row * GLD + 16 + dir * 8 + h] + gDt);
          sm.sc[tk][0] = __expf(gg); sm.sc[tk][1] = beta; sm.sc[tk][2] = qk * rq * rk;
        }
      }
      __syncthreads();
    } else if (mixer == 2) {
      if (tid == 0) {
        float m = mstate;
        for (int tk = 0; tk < TC; ++tk) {
          float ig = sm.sc[tk][0], lf = sm.sc[tk][1];
          float mn = fmaxf(lf + m, ig);
          sm.sc[tk][0] = __expf(lf + m - mn);
          sm.sc[tk][1] = __expf(ig - mn);
          sm.sc[tk][2] = __expf(-mn);
          m = mn;
        }
        mstate = m;
      }
      __syncthreads();
    }
    if (mixer == 0) {
      for (int tk = 0; tk < TC; ++tk) {
        float vj = sm.v[tk][w * 16 + j];
        const float4* qp = (const float4*)&sm.q[tk][gq * 32];
        const float4* kp = (const float4*)&sm.k[tk][gq * 32];
        const float4* fp = (const float4*)&sm.f[tk][gq * 32];
        float acc = 0.f;
#pragma unroll
        for (int i = 0; i < 8; ++i) {
          float4 q4 = qp[i], k4 = kp[i], f4 = fp[i];
          S[4 * i + 0] = f4.x * S[4 * i + 0] + k4.x * vj; acc += q4.x * S[4 * i + 0];
          S[4 * i + 1] = f4.y * S[4 * i + 1] + k4.y * vj; acc += q4.y * S[4 * i + 1];
          S[4 * i + 2] = f4.z * S[4 * i + 2] + k4.z * vj; acc += q4.z * S[4 * i + 2];
          S[4 * i + 3] = f4.w * S[4 * i + 3] + k4.w * vj; acc += q4.w * S[4 * i + 3];
        }
        acc += __shfl_xor(acc, 16); acc += __shfl_xor(acc, 32);
        if (gq == 0) sm.v[tk][w * 16 + j] = acc;
      }
    } else if (mixer == 1) {
      for (int tk = 0; tk < TC; ++tk) {
        float vj = sm.v[tk][w * 16 + j];
        float a = sm.sc[tk][0], beta = sm.sc[tk][1], qk = sm.sc[tk][2];
        const float4* qp = (const float4*)&sm.q[tk][gq * 32];
        const float4* kp = (const float4*)&sm.k[tk][gq * 32];
        float kr[32];
        float rr = 0.f, pq = 0.f;
#pragma unroll
        for (int i = 0; i < 8; ++i) {
          float4 q4 = qp[i], k4 = kp[i];
          kr[4 * i + 0] = k4.x; kr[4 * i + 1] = k4.y; kr[4 * i + 2] = k4.z; kr[4 * i + 3] = k4.w;
          rr += k4.x * S[4 * i + 0]; pq += q4.x * S[4 * i + 0];
          rr += k4.y * S[4 * i + 1]; pq += q4.y * S[4 * i + 1];
          rr += k4.z * S[4 * i + 2]; pq += q4.z * S[4 * i + 2];
          rr += k4.w * S[4 * i + 3]; pq += q4.w * S[4 * i + 3];
        }
        rr += __shfl_xor(rr, 16); pq += __shfl_xor(pq, 16);
        rr += __shfl_xor(rr, 32); pq += __shfl_xor(pq, 32);
        float vn = beta * (vj - a * rr);
        float ov = a * pq + qk * vn;
#pragma unroll
        for (int i = 0; i < 32; ++i) S[i] = a * S[i] + kr[i] * vn;
        if (gq == 0) sm.v[tk][w * 16 + j] = ov;
      }
    } else {
      for (int tk = 0; tk < TC; ++tk) {
        float vj = sm.v[tk][w * 16 + j];
        float fd = sm.sc[tk][0], iw = sm.sc[tk][1], em = sm.sc[tk][2];
        float ivj = iw * vj;
        const float4* qp = (const float4*)&sm.q[tk][gq * 32];
        const float4* kp = (const float4*)&sm.k[tk][gq * 32];
        float acc = 0.f;
#pragma unroll
        for (int i = 0; i < 8; ++i) {
          float4 q4 = qp[i], k4 = kp[i];
          S[4 * i + 0] = fd * S[4 * i + 0] + k4.x * ivj; acc += q4.x * S[4 * i + 0];
          S[4 * i + 1] = fd * S[4 * i + 1] + k4.y * ivj; acc += q4.y * S[4 * i + 1];
          S[4 * i + 2] = fd * S[4 * i + 2] + k4.z * ivj; acc += q4.z * S[4 * i + 2];
          S[4 * i + 3] = fd * S[4 * i + 3] + k4.w * ivj; acc += q4.w * S[4 * i + 3];
        }
        float2 kk = *(const float2*)&sm.k[tk][gq * 32 + 2 * j];
        float2 qq = *(const float2*)&sm.q[tk][gq * 32 + 2 * j];
        n0 = fd * n0 + iw * kk.x; n1 = fd * n1 + iw * kk.y;
        float den = n0 * qq.x + n1 * qq.y;
        den = wave_sum(den);
        acc += __shfl_xor(acc, 16); acc += __shfl_xor(acc, 32);
        if (gq == 0) sm.v[tk][w * 16 + j] = acc / fmaxf(fabsf(den), em);
      }
    }
    __syncthreads();
    {
      int tok = tid >> 3, c8 = tid & 7;
      int row = scan_row(bl, dir, pos0 + tok);
      const float* op = &sm.v[tok][c8 * 8];
      uint4 o;
      o.x = pack2(op[0], op[1]); o.y = pack2(op[2], op[3]); o.z = pack2(op[4], op[5]); o.w = pack2(op[6], op[7]);
      *(uint4*)(p.obuf + ((long)dir * TG + row) * 3072 + ocol + c8 * 8) = o;
    }
  }
}

struct CSmem {
  u16 QA[32][136];
  u16 KA[32][136];
  u16 KDT[128][40];
  u16 XT[64][40];
  u16 ATT[32][40];
  u16 ST[64][136];
  float sc[32][8];
  union {
    struct { u16 QD[32][136]; float dec[128]; float hsum[4][128]; } hg;
    struct { u16 YT[64][40]; u16 TM[32][40]; float NM[32][36]; u16 VF[32][72]; float TS[3][16][20]; } gd;
    struct { float nvec[128]; } ml;
  } u;
};

__device__ __forceinline__ f32x4 mfma16(bf16x8 a, bf16x8 b, f32x4 c) { return __builtin_amdgcn_mfma_f32_16x16x32_bf16(a, b, c, 0, 0, 0); }
__device__ __forceinline__ bf16x8 ldf(const u16* base, int ld, int row, int k) { return *(const bf16x8*)(base + row * ld + k); }
__device__ __forceinline__ void st4(u16* dst, float a, float b, float c, float d) { uint2 v; v.x = pack2(a, b); v.y = pack2(c, d); *(uint2*)dst = v; }

__device__ void scan_unit_mma(const Params& p, int l, int g, int u, CSmem& sm) {
  const int tid0 = otid();
  const int mixer = u / 128, r = u % 128;
  int bl, h, dir, vs;
  bl = r / 32;
  if (mixer < 2) { h = (r % 32) / 4; dir = (r % 4) / 2; vs = r % 2; }
  else { h = (r % 32) / 8; dir = (r % 8) / 4; vs = r % 4; }
  int cq, ck, cv, ocol;
  if (mixer == 0) { cq = C_HGQ + h * 128; ck = C_HGF + dir * 1024 + h * 128; cv = C_HGI + h * 128 + vs * 64; ocol = h * 128 + vs * 64; }
  else if (mixer == 1) { cq = C_GQ + h * 128; ck = C_GK + h * 128; cv = C_GV + h * 128 + vs * 64; ocol = 1024 + h * 128 + vs * 64; }
  else { cq = C_MQ + h * 128; ck = C_MK + h * 128; cv = C_MV + h * 256 + vs * 64; ocol = 2048 + h * 256 + vs * 64; }
  const float QS = 0.08838834764831845f;

  f32x4 S[2][4];
#pragma unroll
  for (int a = 0; a < 2; ++a)
#pragma unroll
    for (int b = 0; b < 4; ++b) S[a][b] = f32x4{0.f, 0.f, 0.f, 0.f};
  float mcar = 0.f;
  float gA = 0.f, gDt = 0.f, ibias = 0.f, fbias = 0.f;
  if (mixer == 1) { gA = -__expf(p.gdn_a_log[l * 16 + dir * 8 + h]); gDt = p.gdn_dt_bias[l * 16 + dir * 8 + h]; }
  if (mixer == 2) { ibias = p.ml_i_bias[l * 8 + dir * 4 + h]; fbias = p.ml_f_bias[l * 8 + dir * 4 + h]; }

  __syncthreads();
  for (int i = tid0; i < 64 * 136 / 2; i += 256) ((unsigned*)&sm.ST[0][0])[i] = 0u;
  if (mixer == 2 && tid0 < 128) sm.u.ml.nvec[tid0] = 0.f;
  __syncthreads();


  uint4 pq0, pq1, pk0, pk1, pv, pt = uint4{0u, 0u, 0u, 0u};
  float pg0 = 0.f, pg1 = 0.f, pg2 = 0.f;
  const int ptask0 = ((bl * 8 + h) * 2 + dir) * 72;
  const int mtask0 = ((bl * 4 + h) * 2 + dir) * 72;
  const int gc0 = (mixer == 1) ? (dir * 8 + h) : (32 + dir * 4 + h);
  const int gc1 = (mixer == 1) ? (16 + dir * 8 + h) : (40 + dir * 4 + h);
  const float lbv = (mixer == 0) ? p.lb[l * D + h * 128 + (tid0 & 127)] : 0.f;
#define ISSUE_LOADS(CH, TID)                                                                          \
  {                                                                                                   \
    const int _pos = (CH) * 32;                                                                       \
    {                                                                                                 \
      int _idx = (TID), _tok = _idx >> 4, _c = _idx & 15;                                             \
      const u16* _pr = p.proj + (long)scan_row(bl, dir, _pos + _tok) * PLD;                           \
      pq0 = *(const uint4*)(_pr + cq + _c * 8);                                                       \
      pk0 = *(const uint4*)(_pr + ck + _c * 8);                                                       \
    }                                                                                                 \
    {                                                                                                 \
      int _idx = (TID) + 256, _tok = _idx >> 4, _c = _idx & 15;                                       \
      const u16* _pr = p.proj + (long)scan_row(bl, dir, _pos + _tok) * PLD;                           \
      pq1 = *(const uint4*)(_pr + cq + _c * 8);                                                       \
      pk1 = *(const uint4*)(_pr + ck + _c * 8);                                                       \
    }                                                                                                 \
    {                                                                                                 \
      int _tok = (TID) >> 3, _c8 = (TID) & 7;                                                         \
      pv = *(const uint4*)(p.proj + (long)scan_row(bl, dir, _pos + _tok) * PLD + cv + _c8 * 8);       \
    }                                                                                                 \
    if (mixer == 2 && (TID) < 64) {                                                                   \
      const float* _gs = p.mprep + ((long)mtask0 + (CH)) * 96;                                        \
      pg0 = _gs[(TID) & 31]; pg1 = _gs[32 + ((TID) & 31)]; pg2 = _gs[64 + ((TID) & 31)];             \
    }                                                                                                 \
    if (mixer == 1) {                                                                                 \
      const u16* _gq = p.gprep + ((long)ptask0 + (CH)) * 2176;                                        \
      pt = *(const uint4*)(_gq + (TID) * 8);                                                          \
      if ((TID) < 64) { const float* _gs = (const float*)(_gq + 2048); pg0 = _gs[(TID) & 31]; pg1 = _gs[32 + ((TID) & 31)]; } \
    }                                                                                                 \
  }
  ISSUE_LOADS(0, tid0)

  for (int ch0 = 0; ch0 < TPB / 32; ++ch0) {
    const int tid = otid(), lane = tid & 63, w = tid >> 6, fr = lane & 15, fq = lane >> 4;
    const int rt_o = w & 1, cp_o = w >> 1;
    const int pos0 = ch0 * 32;
    float mnew = 0.f;
    {
      int tok = tid >> 4, c = tid & 15;
      *(uint4*)&sm.QA[tok][c * 8] = pq0; *(uint4*)&sm.KA[tok][c * 8] = pk0;
      *(uint4*)&sm.QA[tok + 16][c * 8] = pq1; *(uint4*)&sm.KA[tok + 16][c * 8] = pk1;
    }
    {
      int t = tid >> 3, c8 = tid & 7;
      if (mixer == 1) *(uint4*)&sm.u.gd.VF[t][c8 * 8] = pv;
      else {
        sm.XT[c8 * 8 + 0][t] = (u16)(pv.x & 0xffffu); sm.XT[c8 * 8 + 1][t] = (u16)(pv.x >> 16);
        sm.XT[c8 * 8 + 2][t] = (u16)(pv.y & 0xffffu); sm.XT[c8 * 8 + 3][t] = (u16)(pv.y >> 16);
        sm.XT[c8 * 8 + 4][t] = (u16)(pv.z & 0xffffu); sm.XT[c8 * 8 + 5][t] = (u16)(pv.z >> 16);
        sm.XT[c8 * 8 + 6][t] = (u16)(pv.w & 0xffffu); sm.XT[c8 * 8 + 7][t] = (u16)(pv.w >> 16);
      }
    }
    if (mixer == 1) {
      int which = tid >> 7, idx = tid & 127, row = idx >> 2, c8 = (idx & 3) * 8;
      if (which == 0) *(uint4*)&sm.u.gd.TM[row][c8] = pt; else *(uint4*)&sm.ATT[row][c8] = pt;
    }
    const float g0 = pg0, g1 = pg1, g2 = pg2;
    if (ch0 + 1 < TPB / 32) ISSUE_LOADS(ch0 + 1, tid)
    if (mixer == 0) {
      __syncthreads();
      const int dp = lane, d0 = 2 * lane, t0 = w * 8;
      float bb0[8], bb1[8], qv0[8], qv1[8], kv0[8], kv1[8];
      float run0 = 0.f, run1 = 0.f;
#pragma unroll
      for (int i = 0; i < 8; ++i) {
        unsigned lfp = *(const unsigned*)&sm.KA[t0 + i][d0];
        unsigned qp = *(const unsigned*)&sm.QA[t0 + i][d0];
        float lf0 = __uint_as_float(lfp << 16), lf1 = __uint_as_float(lfp & 0xffff0000u);
        qv0[i] = __uint_as_float(qp << 16); qv1[i] = __uint_as_float(qp & 0xffff0000u);
        kv0[i] = 1.f - __expf(lf0); kv1[i] = 1.f - __expf(lf1);
        run0 += lf0; run1 += lf1;
        bb0[i] = run0; bb1[i] = run1;
      }
      *(float2*)&sm.u.hg.hsum[w][d0] = float2{run0, run1};
      __syncthreads();
      float2 h0 = *(const float2*)&sm.u.hg.hsum[0][d0], h1 = *(const float2*)&sm.u.hg.hsum[1][d0];
      float2 h2 = *(const float2*)&sm.u.hg.hsum[2][d0], h3 = *(const float2*)&sm.u.hg.hsum[3][d0];
      const float bref0 = h0.x + h1.x, bref1 = h0.y + h1.y;
      const float bend0 = bref0 + h2.x + h3.x, bend1 = bref1 + h2.y + h3.y;
      const float off0 = (w > 0 ? h0.x : 0.f) + (w > 1 ? h1.x : 0.f) + (w > 2 ? h2.x : 0.f);
      const float off1 = (w > 0 ? h0.y : 0.f) + (w > 1 ? h1.y : 0.f) + (w > 2 ? h2.y : 0.f);
      if (w == 0) *(float2*)&sm.u.hg.dec[d0] = float2{__expf(bend0), __expf(bend1)};
      const float ebref0 = __expf(bref0), ebref1 = __expf(bref1), eber0 = __expf(bend0 - bref0), eber1 = __expf(bend1 - bref1);
      unsigned kda[4], kdb[4];
#pragma unroll
      for (int i = 0; i < 8; ++i) {
        float b0 = bb0[i] + off0, b1 = bb1[i] + off1;
        float qa0 = qv0[i] * __expf(fminf(b0 - bref0, 80.f)), qa1 = qv1[i] * __expf(fminf(b1 - bref1, 80.f));
        float ka0 = kv0[i] * __expf(fminf(bref0 - b0, 80.f)), ka1 = kv1[i] * __expf(fminf(bref1 - b1, 80.f));
        *(unsigned*)&sm.QA[t0 + i][d0] = pack2(qa0, qa1);
        *(unsigned*)&sm.KA[t0 + i][d0] = pack2(ka0, ka1);
        *(unsigned*)&sm.u.hg.QD[t0 + i][d0] = pack2(qa0 * ebref0, qa1 * ebref1);
        unsigned kp = pack2(ka0 * eber0, ka1 * eber1);
        if (i & 1) { kda[i >> 1] |= (kp & 0xffffu) << 16; kdb[i >> 1] |= kp & 0xffff0000u; }
        else { kda[i >> 1] = kp & 0xffffu; kdb[i >> 1] = kp >> 16; }
      }
      *(uint4*)&sm.KDT[d0][t0] = uint4{kda[0], kda[1], kda[2], kda[3]};
      *(uint4*)&sm.KDT[d0 + 1][t0] = uint4{kdb[0], kdb[1], kdb[2], kdb[3]};
      (void)dp;
      __syncthreads();
    } else if (mixer == 1) {
      if (w == 0) {
        const float Gend_ = __shfl(g0, 31);
        if (lane < 32) { sm.sc[lane][0] = g0; sm.sc[lane][1] = g1; sm.sc[lane][3] = __expf(Gend_ - g0); }
      }
    } else {
      if (w == 0) {
        const float Mend_ = fmaxf(mcar, __shfl(g2, 31));
        if (lane < 32) { sm.sc[lane][0] = g0; sm.sc[lane][1] = g1; sm.sc[lane][2] = fmaxf(mcar, g2); sm.sc[lane][3] = __expf(g1 - Mend_); }
      }
      __syncthreads();
      mnew = sm.sc[31][0] + sm.sc[31][2];
      {
        const int d0 = 2 * lane, t0 = w * 8;
        unsigned kda[4], kdb[4];
#pragma unroll
        for (int i = 0; i < 8; ++i) {
          unsigned kk2 = *(const unsigned*)&sm.KA[t0 + i][d0];
          float fct = sm.sc[t0 + i][3];
          unsigned kp = pack2(__uint_as_float(kk2 << 16) * fct, __uint_as_float(kk2 & 0xffff0000u) * fct);
          if (i & 1) { kda[i >> 1] |= (kp & 0xffffu) << 16; kdb[i >> 1] |= kp & 0xffff0000u; }
          else { kda[i >> 1] = kp & 0xffffu; kdb[i >> 1] = kp >> 16; }
        }
        *(uint4*)&sm.KDT[d0][t0] = uint4{kda[0], kda[1], kda[2], kda[3]};
        *(uint4*)&sm.KDT[d0 + 1][t0] = uint4{kdb[0], kdb[1], kdb[2], kdb[3]};
      }
    }
    if (mixer == 1) {
    } else {
      int si, ti; bool doit = true;
      si = w & 1; ti = w >> 1; doit = !(si == 1 && ti == 0);
      if (doit) {
        f32x4 acc = f32x4{0.f, 0.f, 0.f, 0.f};
#pragma unroll
        for (int kk = 0; kk < 4; ++kk)
          acc = mfma16(ldf(&sm.KA[0][0], 136, si * 16 + fr, kk * 32 + fq * 8), ldf(&sm.QA[0][0], 136, ti * 16 + fr, kk * 32 + fq * 8), acc);
        const int t = ti * 16 + fr;
        float o4[4];
        if (mixer == 0) {
#pragma unroll
          for (int j = 0; j < 4; ++j) { int s_ = si * 16 + fq * 4 + j; o4[j] = (s_ <= t) ? acc[j] : 0.f; }
        } else if (mixer == 1) {
          float Gt = sm.sc[t][0];
#pragma unroll
          for (int j = 0; j < 4; ++j) { int s_ = si * 16 + fq * 4 + j; o4[j] = (s_ <= t) ? acc[j] * __expf(Gt - sm.sc[s_][0]) : 0.f; }
        } else {
          float Mt = sm.sc[t][2];
#pragma unroll
          for (int j = 0; j < 4; ++j) { int s_ = si * 16 + fq * 4 + j; o4[j] = (s_ <= t) ? acc[j] * QS * __expf(sm.sc[s_][1] - Mt) : 0.f; }
        }
        st4(&sm.ATT[t][si * 16 + fq * 4], o4[0], o4[1], o4[2], o4[3]);
      } else {
        int t = lane >> 2, s4 = (lane & 3) * 4; *(uint2*)&sm.ATT[t][16 + s4] = uint2{0u, 0u};
      }
    }
    __syncthreads();
    if (mixer == 1) {
      f32x4 acc[2];
      acc[0] = acc[1] = f32x4{0.f, 0.f, 0.f, 0.f};
#pragma unroll
      for (int kk = 0; kk < 4; ++kk) {
        bf16x8 a = ldf(&sm.KA[0][0], 136, rt_o * 16 + fr, kk * 32 + fq * 8);
#pragma unroll
        for (int c = 0; c < 2; ++c) acc[c] = mfma16(a, ldf(&sm.ST[0][0], 136, (cp_o * 2 + c) * 16 + fr, kk * 32 + fq * 8), acc[c]);
      }
#pragma unroll
      for (int c = 0; c < 2; ++c) {
        int v = (cp_o * 2 + c) * 16 + fr;
        float y4[4];
#pragma unroll
        for (int j = 0; j < 4; ++j) {
          int t = rt_o * 16 + fq * 4 + j;
          float kg = __expf(sm.sc[t][0]);
          y4[j] = sm.sc[t][1] * (bf2f(sm.u.gd.VF[t][v]) - kg * acc[c][j]);
        }
        st4(&sm.u.gd.YT[v][rt_o * 16 + fq * 4], y4[0], y4[1], y4[2], y4[3]);
      }
      {
        const int d0 = 2 * lane, t0 = w * 8;
        unsigned kda[4], kdb[4];
#pragma unroll
        for (int i = 0; i < 8; ++i) {
          unsigned kk2 = *(const unsigned*)&sm.KA[t0 + i][d0];
          float fct = sm.sc[t0 + i][3];
          unsigned kp = pack2(__uint_as_float(kk2 << 16) * fct, __uint_as_float(kk2 & 0xffff0000u) * fct);
          if (i & 1) { kda[i >> 1] |= (kp & 0xffffu) << 16; kdb[i >> 1] |= kp & 0xffff0000u; }
          else { kda[i >> 1] = kp & 0xffffu; kdb[i >> 1] = kp >> 16; }
        }
        *(uint4*)&sm.KDT[d0][t0] = uint4{kda[0], kda[1], kda[2], kda[3]};
        *(uint4*)&sm.KDT[d0 + 1][t0] = uint4{kdb[0], kdb[1], kdb[2], kdb[3]};
      }
      __syncthreads();
      {
        bf16x8 a = ldf(&sm.u.gd.TM[0][0], 40, rt_o * 16 + fr, fq * 8);
#pragma unroll
        for (int c = 0; c < 2; ++c) {
          int vt = cp_o * 2 + c;
          f32x4 vn = mfma16(a, ldf(&sm.u.gd.YT[0][0], 40, vt * 16 + fr, fq * 8), f32x4{0.f, 0.f, 0.f, 0.f});
          st4(&sm.XT[vt * 16 + fr][rt_o * 16 + fq * 4], vn[0], vn[1], vn[2], vn[3]);
        }
      }
      __syncthreads();
    } else if (mixer == 2) {
      int t = tid >> 3, part = tid & 7;
      float qn = 0.f;
#pragma unroll
      for (int e = 0; e < 16; ++e) qn += bf2f(sm.QA[t][part * 16 + e]) * sm.u.ml.nvec[part * 16 + e];
      float as = 0.f;
#pragma unroll
      for (int e = 0; e < 4; ++e) as += bf2f(sm.ATT[t][part * 4 + e]);
      float Mt = sm.sc[t][2];
      float den = QS * __expf(mcar - Mt) * qn + as;
      den += __shfl_xor(den, 1); den += __shfl_xor(den, 2); den += __shfl_xor(den, 4);
      if (part == 0) sm.sc[t][4] = 1.f / fmaxf(fabsf(den), __expf(-(sm.sc[t][0] + Mt)));
      __syncthreads();
    }
    {
      f32x4 acc[2];
      acc[0] = acc[1] = f32x4{0.f, 0.f, 0.f, 0.f};
      const u16* Qs = (mixer == 0) ? &sm.u.hg.QD[0][0] : &sm.QA[0][0];
#pragma unroll
      for (int kk = 0; kk < 4; ++kk) {
        bf16x8 qb = ldf(Qs, 136, rt_o * 16 + fr, kk * 32 + fq * 8);
#pragma unroll
        for (int c = 0; c < 2; ++c) acc[c] = mfma16(ldf(&sm.ST[0][0], 136, (cp_o * 2 + c) * 16 + fr, kk * 32 + fq * 8), qb, acc[c]);
      }
      const int t = rt_o * 16 + fr;
      float rs, fs;
      if (mixer == 0) { rs = 1.f; fs = 1.f; }
      else if (mixer == 1) { rs = __expf(sm.sc[t][0]); fs = 1.f; }
      else { rs = QS * __expf(mcar - sm.sc[t][2]); fs = sm.sc[t][4]; }
#pragma unroll
      for (int c = 0; c < 2; ++c)
#pragma unroll
        for (int j = 0; j < 4; ++j) acc[c][j] *= rs;
      {
        bf16x8 ab = ldf(&sm.ATT[0][0], 40, rt_o * 16 + fr, fq * 8);
#pragma unroll
        for (int c = 0; c < 2; ++c) acc[c] = mfma16(ldf(&sm.XT[0][0], 40, (cp_o * 2 + c) * 16 + fr, fq * 8), ab, acc[c]);
      }
      const int row = scan_row(bl, dir, pos0 + t);
      u16* dst = p.obuf + ((long)dir * TG + row) * 3072 + ocol;
#pragma unroll
      for (int c = 0; c < 2; ++c) {
        uint2 o; o.x = pack2(acc[c][0] * fs, acc[c][1] * fs); o.y = pack2(acc[c][2] * fs, acc[c][3] * fs);
        *(uint2*)(dst + (cp_o * 2 + c) * 16 + fq * 4) = o;
      }
    }
    __syncthreads();
    {
      float dsc = 1.f;
      if (mixer == 1) dsc = __expf(sm.sc[31][0]);
      else if (mixer == 2) dsc = __expf(mcar - sm.sc[31][2]);
#pragma unroll
      for (int rt = 0; rt < 2; ++rt) {
        if (mixer == 0) {
          float4 d4 = *(const float4*)&sm.u.hg.dec[w * 32 + rt * 16 + fq * 4];
#pragma unroll
          for (int ct = 0; ct < 4; ++ct) { S[rt][ct][0] *= d4.x; S[rt][ct][1] *= d4.y; S[rt][ct][2] *= d4.z; S[rt][ct][3] *= d4.w; }
        } else {
#pragma unroll
          for (int ct = 0; ct < 4; ++ct) { S[rt][ct][0] *= dsc; S[rt][ct][1] *= dsc; S[rt][ct][2] *= dsc; S[rt][ct][3] *= dsc; }
        }
        bf16x8 a = ldf(&sm.KDT[0][0], 40, w * 32 + rt * 16 + fr, fq * 8);
#pragma unroll
        for (int ct = 0; ct < 4; ++ct) {
          S[rt][ct] = mfma16(a, ldf(&sm.XT[0][0], 40, ct * 16 + fr, fq * 8), S[rt][ct]);
          st4(&sm.ST[ct * 16 + fr][w * 32 + rt * 16 + fq * 4], S[rt][ct][0], S[rt][ct][1], S[rt][ct][2], S[rt][ct][3]);
        }
      }
      if (mixer == 2) {
        if (tid < 128) {
          float sum = 0.f;
#pragma unroll
          for (int e = 0; e < 32; ++e) sum += bf2f(sm.KDT[tid][e]);
          sm.u.ml.nvec[tid] = dsc * sm.u.ml.nvec[tid] + sum;
        }
        mcar = mnew;
      }
    }
    __syncthreads();
  }
}

struct PrepW { float NM[32][36]; float TS[3][16][20]; float G[32]; float B[32]; };
__device__ __forceinline__ bf16x8 asbf(const uint4& u) { return __builtin_bit_cast(bf16x8, u); }
__device__ void ph_gdn_prep(const Params& p, int l, char* smem) {
  const int tid = otid();
  const int lane = tid & 63, w = tid >> 6, fr = lane & 15, fq = lane >> 4;
  PrepW& sw = ((PrepW*)smem)[w];
  const int gw = blockIdx.x * 4 + w, nw = gridDim.x * 4;
  for (int task = gw; task < 2304; task += nw) {
    const int chunk = task % 72, r = task / 72, dir = r & 1, h = (r >> 1) & 3, bl = r >> 3;
    const int tk = lane & 31;
    const float* gp = p.gates + (long)scan_row(bl, dir, chunk * 32 + tk) * GLD;
    float ig = gp[32 + dir * 4 + h] + p.ml_i_bias[l * 8 + dir * 4 + h];
    float F = -softplusf_(-(gp[40 + dir * 4 + h] + p.ml_f_bias[l * 8 + dir * 4 + h]));
#pragma unroll
    for (int o = 1; o < 32; o <<= 1) { float t2 = __shfl_up(F, o); if (tk >= o) F += t2; }
    float a = ig - F;
    float pm = a;
#pragma unroll
    for (int o = 1; o < 32; o <<= 1) { float t2 = __shfl_up(pm, o); if (tk >= o) pm = fmaxf(pm, t2); }
    if (lane < 32) { float* o_ = p.mprep + (long)task * 96; o_[tk] = F; o_[32 + tk] = a; o_[64 + tk] = pm; }
  }
  for (int task = gw; task < 4608; task += nw) {
    const int chunk = task % 72, r = task / 72, dir = r & 1, h = (r >> 1) & 7, bl = r >> 4;
    const int pos0 = chunk * 32;
    const float gA = -__expf(p.gdn_a_log[l * 16 + dir * 8 + h]), gDt = p.gdn_dt_bias[l * 16 + dir * 8 + h];
    uint4 kf[2][4], qf[2][4];
#pragma unroll
    for (int rt = 0; rt < 2; ++rt) {
      const u16* pr = p.proj + (long)scan_row(bl, dir, pos0 + rt * 16 + fr) * PLD + h * 128 + fq * 8;
#pragma unroll
      for (int kk = 0; kk < 4; ++kk) { kf[rt][kk] = *(const uint4*)(pr + C_GK + kk * 32); qf[rt][kk] = *(const uint4*)(pr + C_GQ + kk * 32); }
    }
    const int tk = lane & 31;
    float beta, G;
    {
      const float* gp = p.gates + (long)scan_row(bl, dir, pos0 + tk) * GLD;
      beta = sigmoidf_(gp[dir * 8 + h]);
      G = gA * softplusf_(gp[16 + dir * 8 + h] + gDt);
#pragma unroll
      for (int o = 1; o < 32; o <<= 1) { float t2 = __shfl_up(G, o); if (tk >= o) G += t2; }
      if (lane < 32) { sw.G[tk] = G; sw.B[tk] = beta; }
    }
    u16* outT = p.gprep + (long)task * 2176;
    u16* outA = outT + 1024;
    float* outS = (float*)(outT + 2048);
    if (lane < 32) { outS[tk] = G; outS[32 + tk] = beta; }
#pragma unroll
    for (int ti_ = 0; ti_ < 3; ++ti_) {
      const int ai = ti_ == 0 ? 0 : 1, bi = ti_ == 2 ? 1 : 0;
      f32x4 acc = f32x4{0.f, 0.f, 0.f, 0.f};
#pragma unroll
      for (int kk = 0; kk < 4; ++kk) acc = mfma16(asbf(kf[ai][kk]), asbf(kf[bi][kk]), acc);
      const int b = bi * 16 + fr;
      const float Gb = sw.G[b];
#pragma unroll
      for (int j = 0; j < 4; ++j) {
        int a = ai * 16 + fq * 4 + j;
        if (a > b) sw.NM[a][b] = sw.B[a] * acc[j] * __expf(sw.G[a] - Gb);
      }
    }
#pragma unroll
    for (int ti_ = 0; ti_ < 3; ++ti_) {
      const int si = ti_ == 2 ? 1 : 0, ti = ti_ == 0 ? 0 : 1;
      f32x4 acc = f32x4{0.f, 0.f, 0.f, 0.f};
#pragma unroll
      for (int kk = 0; kk < 4; ++kk) acc = mfma16(asbf(kf[si][kk]), asbf(qf[ti][kk]), acc);
      const int t = ti * 16 + fr;
      const float Gt = sw.G[t];
      float o4[4];
#pragma unroll
      for (int j = 0; j < 4; ++j) { int s_ = si * 16 + fq * 4 + j; o4[j] = (s_ <= t) ? acc[j] * __expf(Gt - sw.G[s_]) : 0.f; }
      st4(outA + t * 32 + si * 16 + fq * 4, o4[0], o4[1], o4[2], o4[3]);
    }
    { int t = lane >> 2, s4 = (lane & 3) * 4; *(uint2*)(outA + t * 32 + 16 + s4) = uint2{0u, 0u}; }
    {
      const int blk = (lane >> 4) & 1, c = lane & 15;
      float Tc[16];
#pragma unroll
      for (int t = 0; t < 16; ++t) {
        float v = (t == c) ? 1.f : 0.f;
#pragma unroll
        for (int s4 = 0; s4 < (t + 3) / 4; ++s4) {
          float4 n4 = *(const float4*)&sw.NM[blk * 16 + t][blk * 16 + s4 * 4];
          if (s4 * 4 + 0 < t) v -= n4.x * Tc[s4 * 4 + 0];
          if (s4 * 4 + 1 < t) v -= n4.y * Tc[s4 * 4 + 1];
          if (s4 * 4 + 2 < t) v -= n4.z * Tc[s4 * 4 + 2];
          if (s4 * 4 + 3 < t) v -= n4.w * Tc[s4 * 4 + 3];
        }
        Tc[t] = v;
        if (lane < 32) {
          sw.TS[blk][t][c] = v;
          outT[(blk * 16 + t) * 32 + blk * 16 + c] = f2bf(v);
          if (blk == 0) outT[t * 32 + 16 + c] = 0;
        }
        __builtin_amdgcn_sched_barrier(0);
      }
    }
    {
      const int a = lane >> 2, c4 = (lane & 3) * 4;
      float w0 = 0.f, w1 = 0.f, w2 = 0.f, w3 = 0.f;
#pragma unroll
      for (int s4 = 0; s4 < 4; ++s4) {
        float4 n4 = *(const float4*)&sw.NM[16 + a][s4 * 4];
        float nn[4] = {n4.x, n4.y, n4.z, n4.w};
#pragma unroll
        for (int k = 0; k < 4; ++k) {
          float4 t4 = *(const float4*)&sw.TS[0][s4 * 4 + k][c4];
          w0 += nn[k] * t4.x; w1 += nn[k] * t4.y; w2 += nn[k] * t4.z; w3 += nn[k] * t4.w;
        }
      }
      *(float4*)&sw.TS[2][a][c4] = float4{w0, w1, w2, w3};
    }
    {
      const int t = lane >> 2, c4 = (lane & 3) * 4;
      float r0 = 0.f, r1 = 0.f, r2 = 0.f, r3 = 0.f;
#pragma unroll
      for (int a4 = 0; a4 < 4; ++a4) {
        float4 q4 = *(const float4*)&sw.TS[1][t][a4 * 4];
        float qq[4] = {q4.x, q4.y, q4.z, q4.w};
#pragma unroll
        for (int k = 0; k < 4; ++k) {
          float4 w4 = *(const float4*)&sw.TS[2][a4 * 4 + k][c4];
          r0 += qq[k] * w4.x; r1 += qq[k] * w4.y; r2 += qq[k] * w4.z; r3 += qq[k] * w4.w;
        }
      }
      st4(outT + (16 + t) * 32 + c4, -r0, -r1, -r2, -r3);
    }
  }
}

__device__ void ph_scan(const Params& p, int l, int g, char* smem) {
  const int b = blockIdx.x;
  __shared__ int tb_s[2];
  int u0, ustep;
  if (gridDim.x == 512) {
    ustep = 512;
    u0 = b < 128 ? 128 + b : (b < 256 ? b - 128 : (b < 384 ? b : 384));
  } else { u0 = b; ustep = gridDim.x; }
  for (int u = u0; u < 384; u += ustep) scan_unit_mma(p, l, g, u, *(CSmem*)smem);
  __syncthreads();
  unsigned* ctr = p.bar + XB_CTR(l * 4 + g);
  for (int it = 0;; ++it) {
    if (threadIdx.x == 0) tb_s[it & 1] = (int)atomicAdd(ctr, 1u);
    __syncthreads();
    const int tb = tb_s[it & 1];
    if (tb >= QB_END) break;
    gemm_in_b_tile(p, l, smem, tb);
  }
}

__device__ void ph_brfin(const Params& p, int l, int g) {
  const int tid = otid();
  const int lane = tid & 63;
  const int gw = blockIdx.x * 4 + (tid >> 6), nw = gridDim.x * 4;
  uint4 na0, na1, nb0, nb1, nz0, nz1, ng0, ng1;
  float4 no0, no1, no2, no3;
  const uint4 zz = uint4{0u, 0u, 0u, 0u};
  na0 = na1 = nb0 = nb1 = nz0 = nz1 = ng0 = ng1 = zz;
  no0 = no1 = no2 = no3 = float4{0.f, 0.f, 0.f, 0.f};
#define BR_LOAD(J)                                                                                           \
  if ((J) < TG * 3) {                                                                                        \
    const int _mx = (J) / TG, _row = (J) % TG;                                                               \
    if (!(l == 1 && (_row % TPB) < CTX)) {                                                                   \
      const u16* _of = p.obuf + (long)_row * 3072 + _mx * 1024 + lane * 16;                                  \
      const u16* _ob = _of + (long)TG * 3072;                                                                \
      na0 = *(const uint4*)_of; na1 = *(const uint4*)(_of + 8);                                              \
      nb0 = *(const uint4*)_ob; nb1 = *(const uint4*)(_ob + 8);                                              \
      const int _zc = _mx == 0 ? C_HGZ : (_mx == 1 ? C_GZ : C_MZ);                                           \
      const u16* _zp = p.proj + (long)_row * PLD + _zc + lane * 16;                                          \
      nz0 = *(const uint4*)_zp; nz1 = *(const uint4*)(_zp + 8);                                              \
      if (_mx == 2) { const u16* _gp = p.proj + (long)_row * PLD + C_MO + lane * 16;                         \
                      ng0 = *(const uint4*)_gp; ng1 = *(const uint4*)(_gp + 8); }                            \
      const float4* _on = (const float4*)((_mx == 0 ? p.hg_onorm : (_mx == 1 ? p.gdn_onorm : p.ml_onorm)) + l * D + lane * 16); \
      no0 = _on[0]; no1 = _on[1]; no2 = _on[2]; no3 = _on[3];                                                \
    }                                                                                                        \
  }
  BR_LOAD(gw)
  for (int j = gw; j < TG * 3; j += nw) {
    const uint4 a0 = na0, a1 = na1, b0 = nb0, b1 = nb1, z0 = nz0, z1 = nz1, g0 = ng0, g1 = ng1;
    const float4 o0 = no0, o1 = no1, o2 = no2, o3 = no3;
    BR_LOAD(j + nw)
    const int mixer = j / TG, row = j % TG;
    if (l == 1 && (row % TPB) < CTX) continue;
    float o[16], t8[8];
    unpack8(a0, o); unpack8(a1, o + 8);
    unpack8(b0, t8);
#pragma unroll
    for (int e = 0; e < 8; ++e) o[e] += t8[e];
    unpack8(b1, t8);
#pragma unroll
    for (int e = 0; e < 8; ++e) o[8 + e] += t8[e];
    float ss = 0.f;
#pragma unroll
    for (int e = 0; e < 16; ++e) ss += o[e] * o[e];
    ss += __shfl_xor(ss, 1); ss += __shfl_xor(ss, 2); ss += __shfl_xor(ss, 4);
    float hd = 128.f;
    if (mixer == 2) { ss += __shfl_xor(ss, 8); hd = 256.f; }
    float rs = rsqrtf(ss / hd + 1e-6f);
    const float on[16] = {o0.x, o0.y, o0.z, o0.w, o1.x, o1.y, o1.z, o1.w, o2.x, o2.y, o2.z, o2.w, o3.x, o3.y, o3.z, o3.w};
    float z[16];
    unpack8(z0, z); unpack8(z1, z + 8);
    float res[16];
#pragma unroll
    for (int e = 0; e < 16; ++e) res[e] = o[e] * rs * on[e] * siluf_(z[e]);
    if (mixer == 2) {
      unpack8(g0, z); unpack8(g1, z + 8);
#pragma unroll
      for (int e = 0; e < 16; ++e) res[e] *= sigmoidf_(z[e]);
    }
    uint4 w0, w1;
    w0.x = pack2(res[0], res[1]); w0.y = pack2(res[2], res[3]); w0.z = pack2(res[4], res[5]); w0.w = pack2(res[6], res[7]);
    w1.x = pack2(res[8], res[9]); w1.y = pack2(res[10], res[11]); w1.z = pack2(res[12], res[13]); w1.w = pack2(res[14], res[15]);
    u16* dst = p.obuf + (long)row * 3072 + mixer * 1024 + lane * 16;
    *(uint4*)dst = w0; *(uint4*)(dst + 8) = w1;
  }
#undef BR_LOAD
}

__device__ void ph_gemm_merge(const Params& p, int l, char* smem) {
  for (int t = blockIdx.x; t < 72 * 8; t += gridDim.x) {
    int nt = t / 72, mt = t % 72;
    if (l == 1 && (mt % 18) < 2) continue;
    f32x4 tot[4][4];
#pragma unroll
    for (int m = 0; m < 4; ++m)
#pragma unroll
      for (int n = 0; n < 4; ++n) tot[m][n] = f32x4{0.f, 0.f, 0.f, 0.f};
    for (int i = 0; i < 3; ++i) {
      f32x4 acc[4][4];
#pragma unroll
      for (int m = 0; m < 4; ++m)
#pragma unroll
        for (int n = 0; n < 4; ++n) acc[m][n] = f32x4{0.f, 0.f, 0.f, 0.f};
      gemm_kloopT<4, 4>(p.obuf + (long)mt * 128 * 3072 + i * 1024, 3072, 32, p.WbrT + (long)i * D * D + (long)nt * 128 * 32, 32, (long)D * 32, D, smem, acc);
      const int tid2 = otid();
      const int wr = (tid2 >> 7) & 1, wc = (tid2 >> 6) & 1, fr = tid2 & 15, fq = (tid2 >> 4) & 3;
#pragma unroll
      for (int m = 0; m < 4; ++m) {
        int row = mt * 128 + wr * 64 + m * 16 + fr;
#pragma unroll
        for (int n = 0; n < 4; ++n) {
          int col = nt * 128 + wc * 64 + n * 16 + fq * 4;
          uint2 gr = *(const uint2*)(p.proj + (long)row * PLD + C_GATE + i * 1024 + col);
          tot[m][n][0] += sigmoidf_(__uint_as_float(gr.x << 16)) * acc[m][n][0];
          tot[m][n][1] += sigmoidf_(__uint_as_float(gr.x & 0xffff0000u)) * acc[m][n][1];
          tot[m][n][2] += sigmoidf_(__uint_as_float(gr.y << 16)) * acc[m][n][2];
          tot[m][n][3] += sigmoidf_(__uint_as_float(gr.y & 0xffff0000u)) * acc[m][n][3];
        }
      }
    }
    const int tid3 = otid();
    const int wr = (tid3 >> 7) & 1, wc = (tid3 >> 6) & 1, fr = tid3 & 15, fq = (tid3 >> 4) & 3;
#pragma unroll
    for (int m = 0; m < 4; ++m) {
      int row = mt * 128 + wr * 64 + m * 16 + fr;
#pragma unroll
      for (int n = 0; n < 4; ++n) {
        int col = nt * 128 + wc * 64 + n * 16 + fq * 4;
        uint2 o; o.x = pack2(tot[m][n][0], tot[m][n][1]); o.y = pack2(tot[m][n][2], tot[m][n][3]);
        *(uint2*)(p.obuf + (long)TG * 3072 + (long)row * D + col) = o;
      }
    }
  }
}

__device__ void ph_gemm_out(const Params& p, int l, int g, char* smem) {
  for (int t = (int)gridDim.x - 1 - (int)blockIdx.x; t < 72 * 8; t += gridDim.x) {
    int nt = t / 72, mt = t % 72;
    if (l == 1 && (mt % 18) < 2) continue;
    f32x4 acc[4][4];
#pragma unroll
    for (int m = 0; m < 4; ++m)
#pragma unroll
      for (int n = 0; n < 4; ++n) acc[m][n] = f32x4{0.f, 0.f, 0.f, 0.f};
    gemm_kloopT<4, 4>(p.obuf + (long)TG * 3072 + (long)mt * 128 * D, D, 32, p.WoT + (long)nt * 128 * 32, 32, (long)D * 32, D, smem, acc);
    const int tid = otid();
    const int wr = (tid >> 7) & 1, wc = (tid >> 6) & 1, fr = tid & 15, fq = (tid >> 4) & 3;
#pragma unroll
    for (int m = 0; m < 4; ++m) {
      int row = mt * 128 + wr * 64 + m * 16 + fr;
      int bl = row / TPB, pp = row % TPB, b = g * GB + bl;
      const float* src; float* dst; int mrow;
      if (pp < CTX) { src = p.ctx + ((long)b * CTX + pp) * D; dst = p.ctxs + ((long)b * CTX + pp) * D; mrow = 16; }
      else { long off = ((long)b * SEQ + (pp - CTX)) * D; src = (l == 0 ? p.x : p.out) + off; dst = p.out + off; mrow = b; }
      const float* gt = p.mod + ((long)l * 17 + mrow) * 3072 + 2048;
#pragma unroll
      for (int n = 0; n < 4; ++n) {
        int col = nt * 128 + wc * 64 + n * 16 + fq * 4;
        float4 xv = *(const float4*)(src + col), gv = *(const float4*)(gt + col);
        float4 o;
        o.x = xv.x + gv.x * acc[m][n][0]; o.y = xv.y + gv.y * acc[m][n][1];
        o.z = xv.z + gv.z * acc[m][n][2]; o.w = xv.w + gv.w * acc[m][n][3];
        *(float4*)(dst + col) = o;
      }
    }
  }
}

__device__ void ph_final(const Params& p) {
  const int tid = otid();
  const int lane = tid & 63;
  const int gw = blockIdx.x * 4 + (tid >> 6), nw = gridDim.x * 4;
  for (int row = gw; row < NB * SEQ; row += nw) {
    float4* src = (float4*)(p.out + (long)row * D);
    float4 v[4]; float ss = 0.f;
#pragma unroll
    for (int i = 0; i < 4; ++i) {
      v[i] = src[lane + 64 * i];
      ss += v[i].x * v[i].x + v[i].y * v[i].y + v[i].z * v[i].z + v[i].w * v[i].w;
    }
    ss = wave_sum(ss);
    float rs = rsqrtf(ss * (1.f / D) + 1e-6f);
#pragma unroll
    for (int i = 0; i < 4; ++i) {
      float4 g4 = ((const float4*)p.final_g)[lane + 64 * i];
      float4 o; o.x = v[i].x * rs * g4.x; o.y = v[i].y * rs * g4.y; o.z = v[i].z * rs * g4.z; o.w = v[i].w * rs * g4.w;
      src[lane + 64 * i] = o;
    }
  }
}


#define XB_TMO      128
#define XB_XCNT(j)  (256  + 64 * (j))
#define XB_XSUB(j)  (1280 + 64 * (j))
#define XB_XGEN(j)  (2304 + 64 * (j))
#define XB_TOP      3328
#define XB_TOPGEN   3392
#define XCD_BAR_WORDS 3456
#define XB_SPIN_CAP (1u << 22)
#define LAS __attribute__((address_space(3)))
__device__ __forceinline__ unsigned xb_ld(unsigned* p) { return __hip_atomic_load(p, __ATOMIC_RELAXED, __HIP_MEMORY_SCOPE_AGENT); }
__device__ __forceinline__ unsigned xb_add(unsigned* p, unsigned v) { return __hip_atomic_fetch_add(p, v, __ATOMIC_RELAXED, __HIP_MEMORY_SCOPE_AGENT); }
__device__ __forceinline__ unsigned xb_xcc_id() { return (unsigned)__builtin_amdgcn_s_getreg((3 << 11) | 20) & 0xFu; }
#define XB_SPIN(cond, bar) do { unsigned _sp = 0; while (cond) { __builtin_amdgcn_s_sleep(1); \
    if ((++_sp & 255u) == 0u) { if (xb_ld(&(bar)[XB_TMO])) break; if (_sp > XB_SPIN_CAP) { atomicAdd(&(bar)[XB_TMO], 1u); break; } } } } while (0)
struct XcdBarrier { unsigned* bar; unsigned x; volatile LAS unsigned* st; };
__device__ __forceinline__ XcdBarrier xcd_barrier_post(unsigned* bar, volatile LAS unsigned* st) {
  XcdBarrier b; b.bar = bar; b.x = xb_xcc_id(); b.st = st;
  if (threadIdx.x == 0) (void)xb_add(&bar[XB_XCNT(b.x)], 1u);
  return b;
}
__device__ __forceinline__ void xcd_barrier_complete(unsigned* bar, unsigned x, unsigned& nloc, unsigned& nx) {
  const unsigned G = gridDim.x * gridDim.y * gridDim.z;
  unsigned sum, cnt, mine, sp = 0u;
  for (;;) {
    sum = 0u; cnt = 0u; mine = 0u;
#pragma unroll
    for (unsigned j = 0; j < 16; ++j) { const unsigned c = xb_ld(&bar[XB_XCNT(j)]); sum += c; cnt += (c > 0u) ? 1u : 0u; mine = (j == x) ? c : mine; }
    if (sum == G) break;
    __builtin_amdgcn_s_sleep(1);
    if ((++sp & 255u) == 0u) { if (xb_ld(&bar[XB_TMO])) break; if (sp > XB_SPIN_CAP) { atomicAdd(&bar[XB_TMO], 1u); break; } }
  }
  nloc = mine > 0u ? mine : 1u; nx = cnt > 0u ? cnt : 1u;
}
__device__ __forceinline__ void xcd_barrier(const XcdBarrier& b) {
  asm volatile("s_waitcnt vmcnt(0)" ::: "memory");
  __syncthreads();
  if (threadIdx.x == 0) {
    unsigned* bar = b.bar;
    __builtin_amdgcn_s_waitcnt(0);
    unsigned nloc = b.st[0], nx = b.st[1];
    if (nloc == 0u) { xcd_barrier_complete(bar, b.x, nloc, nx); b.st[0] = nloc; b.st[1] = nx; }
    const unsigned old = xb_add(&bar[XB_XSUB(b.x)], 1u);
    const unsigned gen = old / nloc;
    if (old + 1u == (gen + 1u) * nloc) {
      __builtin_amdgcn_fence(__ATOMIC_RELEASE, "agent");
      asm volatile("s_waitcnt vmcnt(0)" ::: "memory");
      const unsigned og = xb_add(&bar[XB_TOP], 1u);
      const unsigned tg = og / nx;
      if (og + 1u == (tg + 1u) * nx) xb_add(&bar[XB_TOPGEN], 1u);
      else XB_SPIN(xb_ld(&bar[XB_TOPGEN]) == tg, bar);
      __builtin_amdgcn_fence(__ATOMIC_ACQUIRE, "agent");
      xb_add(&bar[XB_XGEN(b.x)], 1u);
      asm volatile("s_waitcnt vmcnt(0)" ::: "memory");
    } else {
      XB_SPIN(xb_ld(&bar[XB_XGEN(b.x)]) == gen, bar);
      __builtin_amdgcn_fence(__ATOMIC_ACQUIRE, "agent");
      asm volatile("s_waitcnt vmcnt(0)" ::: "memory");
    }
  }
  __syncthreads();
}

#if !COOP
#error multi-launch path removed
#else
__global__ void __launch_bounds__(256, 2) k_mega(Params p) {
  __shared__ __attribute__((aligned(16))) char smem[74240];
  __shared__ uint4 xb_words;
  cg::grid_group grid = cg::this_grid();
  if (threadIdx.x == 0) xb_words = make_uint4(0u, 0u, 0u, 0u);
  __syncthreads();
  XcdBarrier xb = xcd_barrier_post(p.bar, (volatile LAS unsigned*)&xb_words);
#define GSYNC() xcd_barrier(xb)
  ph_prep_small(p);
  ph_mod(p, smem);
  if (xb_ld(&p.bar[XB_TMO]) == 0x7fffffffu) grid.sync();
#pragma unroll 1
  for (int l = 0; l < 2; ++l) {
    ph_convert(p, l, smem);
    GSYNC();
#pragma unroll 1
    for (int g = 0; g < NGRP; ++g) {
      if (l == 0 && g == 0) { ph_prenorm(p, 0, 0); GSYNC(); }
      if (g == 0) { ph_gemm_in_a(p, l, smem); GSYNC(); }
      ph_conv(p, l); GSYNC();
      ph_gdn_prep(p, l, smem); GSYNC();
      ph_scan(p, l, g, smem); GSYNC();
      ph_brfin(p, l, g);
      if (g + 1 < NGRP) ph_prenorm(p, l, g + 1); else if (l == 0) ph_prenorm(p, 1, 0);
      GSYNC();
      ph_gemm_merge(p, l, smem); GSYNC();
      ph_gemm_out(p, l, g, smem);
      if (g + 1 < NGRP) ph_gemm_in_a(p, l, smem);
      GSYNC();
    }
  }
  ph_final(p);
}
#endif

extern "C" void kernel_launch(void* const* d_in, const int* in_sizes, int n_in, void* d_out, int out_size, void* d_ws,
                              size_t ws_size, hipStream_t stream) {
  Params p{};
  p.x = (const float*)d_in[0]; p.c = (const float*)d_in[1]; p.ctx = (const float*)d_in[2]; p.c_ctx = (const float*)d_in[3];
  p.ada_w = (const float*)d_in[4]; p.ada_b = (const float*)d_in[5]; p.norm_g = (const float*)d_in[6]; p.w_in = (const float*)d_in[7];
  p.hg_lb = (const float*)d_in[8]; p.hg_onorm = (const float*)d_in[9]; p.gdn_conv = (const float*)d_in[10];
  p.gdn_a_log = (const float*)d_in[11]; p.gdn_dt_bias = (const float*)d_in[12]; p.gdn_onorm = (const float*)d_in[13];
  p.ml_i_bias = (const float*)d_in[14]; p.ml_f_bias = (const float*)d_in[15]; p.ml_onorm = (const float*)d_in[16];
  p.w_branch = (const float*)d_in[17]; p.w_out = (const float*)d_in[18]; p.final_g = (const float*)d_in[19];
  p.out = (float*)d_out;
  char* ws = (char*)d_ws;
  size_t off = 0;
  auto take = [&](size_t bytes) { char* r = ws + off; off += (bytes + 255) & ~(size_t)255; return r; };
  p.WinT = (u16*)take((size_t)NPAD * D * 2);
  p.WbrT = (u16*)take((size_t)3 * D * D * 2);
  p.WoT = (u16*)take((size_t)D * D * 2);
  p.hbuf = (u16*)take((size_t)TG * D * 2);
  p.proj = (u16*)take((size_t)TG * PLD * 2);
  p.obuf = (u16*)take((size_t)2 * TG * 3072 * 2);
  p.mod = (float*)take((size_t)2 * 17 * 3072 * 4);
  p.lb = (float*)take((size_t)2 * D * 4);
  p.silc = (float*)take((size_t)17 * D * 4);
  p.gates = (float*)take((size_t)TG * GLD * 4);
  p.ctxs = (float*)take((size_t)NB * CTX * D * 4);
  p.bar = (unsigned*)take((size_t)BAR_TOTAL_WORDS * 4);
  p.gprep = (u16*)take((size_t)4608 * 4352);
  p.mprep = (float*)take((size_t)2304 * 96 * 4);
  if (off > ws_size) { fprintf(stderr, "workspace too small: need %zu have %zu\n", off, ws_size); return; }

  static int grid_blocks = 0;
  if (!grid_blocks) {
    int dev = 0, cus = 0, per_cu = 0;
    hipGetDevice(&dev);
    hipDeviceGetAttribute(&cus, hipDeviceAttributeMultiprocessorCount, dev);
#if COOP
    hipOccupancyMaxActiveBlocksPerMultiprocessor(&per_cu, k_mega, 256, 0);
#else
    hipOccupancyMaxActiveBlocksPerMultiprocessor(&per_cu, k_step, 256, 0);
#endif
    if (per_cu < 1) per_cu = 1;
    if (per_cu > 2) per_cu = 2;
    grid_blocks = cus * per_cu;
  }
#if COOP
  hipMemsetAsync(p.bar, 0, (size_t)BAR_TOTAL_WORDS * 4, stream);
  void* args[] = {&p};
  hipError_t e = hipLaunchCooperativeKernel((void*)k_mega, dim3(grid_blocks), dim3(256), args, 0, stream);
  if (e != hipSuccess) fprintf(stderr, "cooperative launch failed: %s (grid %d)\n", hipGetErrorString(e), grid_blocks);
#else
  for (int s = 0; s < NSTEPS; ++s) k_step<<<grid_blocks, 256, 0, stream>>>(p, s);
#endif
}
```

```cpp
#include <hip/hip_runtime.h>
#include <hip/hip_bf16.h>
#include <hip/hip_cooperative_groups.h>
#include <cstdio>
namespace cg = cooperative_groups;

#define REP_PRE 1
#define REP_GIN 1
#define REP_SCAN 1
#define REP_MRG 1
#define REP_SYNC 0
#define SPL_G 3
#define SPL_H 3
#define SPL_M 1
#define SPL_F 9
#define XB_CTR(j)  (3456 + 64 * (j))
#define BAR_TOTAL_WORDS (3456 + 8 * 64)
#ifndef COOP
#define COOP 1
#endif

typedef unsigned short u16;
using bf16x8 = __attribute__((ext_vector_type(8))) short;
using f32x4 = __attribute__((ext_vector_type(4))) float;

constexpr int D = 1024;
constexpr int NB = 16;
constexpr int SEQ = 2048;
constexpr int CTX = 256;
constexpr int TPB = SEQ + CTX;
constexpr int GB = 4;
constexpr int NGRP = NB / GB;
constexpr int TG = GB * TPB;
constexpr int IN_DIM = 16432;
constexpr int NPAD = 16512;
constexpr int PLD = 16384;
constexpr int GLD = 64;
constexpr int TC = 32;
constexpr int C_HGQ = 0, C_HGI = 1024, C_HGF = 2048, C_HGZ = 4096;
constexpr int C_GQ = 5120, C_GK = 6144, C_GV = 7168, C_GZ = 8192;
constexpr int C_MQ = 9216, C_MK = 9728, C_MV = 10240, C_MO = 11264, C_MZ = 12288;
constexpr int C_GATE = 13312;

struct Params {
  const float *x, *c, *ctx, *c_ctx, *ada_w, *ada_b, *norm_g, *w_in, *hg_lb, *hg_onorm, *gdn_conv,
      *gdn_a_log, *gdn_dt_bias, *gdn_onorm, *ml_i_bias, *ml_f_bias, *ml_onorm, *w_branch, *w_out, *final_g;
  float* out;
  u16 *WinT, *WbrT, *WoT, *hbuf, *proj, *obuf;
  float *mod, *lb, *silc, *gates, *ctxs;
  unsigned* bar;
  u16* gprep;
  float* mprep;
};

typedef __bf16 bf16v2 __attribute__((ext_vector_type(2)));
typedef float f32v2 __attribute__((ext_vector_type(2)));
__device__ __forceinline__ unsigned pack2(float a, float b) {
  f32v2 v = {a, b};
  return __builtin_bit_cast(unsigned, __builtin_convertvector(v, bf16v2));
}
__device__ __forceinline__ u16 f2bf(float f) { return (u16)(pack2(f, 0.f) & 0xffffu); }
__device__ __forceinline__ float bf2f(u16 h) { return __uint_as_float(((unsigned)h) << 16); }
__device__ __forceinline__ float sigmoidf_(float x) { return __builtin_amdgcn_rcpf(1.f + __expf(-x)); }
__device__ __forceinline__ float siluf_(float x) { return x * __builtin_amdgcn_rcpf(1.f + __expf(-x)); }
__device__ __forceinline__ float softplusf_(float y) { return fmaxf(y, 0.f) + log1pf(__expf(-fabsf(y))); }
__device__ __forceinline__ float wave_sum(float v) {
#pragma unroll
  for (int o = 32; o >= 1; o >>= 1) v += __shfl_xor(v, o);
  return v;
}
__device__ __forceinline__ void unpack8(const uint4& u, float* f) {
  f[0] = __uint_as_float(u.x << 16); f[1] = __uint_as_float(u.x & 0xffff0000u);
  f[2] = __uint_as_float(u.y << 16); f[3] = __uint_as_float(u.y & 0xffff0000u);
  f[4] = __uint_as_float(u.z << 16); f[5] = __uint_as_float(u.z & 0xffff0000u);
  f[6] = __uint_as_float(u.w << 16); f[7] = __uint_as_float(u.w & 0xffff0000u);
}

__device__ __forceinline__ int otid() { int t = threadIdx.x; asm volatile("" : "+v"(t)); return t; }
__device__ __forceinline__ int win_src_col(int np) {
  if (np < 9216) return np;
  if (np < 13312) return np + 32;
  if (np < 16384) return np + 48;
  if (np < 16416) return 9216 + (np - 16384);
  if (np < 16432) return 13344 + (np - 16416);
  return -1;
}

__device__ void ph_convert(const Params& p, int l, char* smem) {
  float (*tile)[65] = (float (*)[65])smem;
  const int tid = otid();
  for (int t = blockIdx.x; t < 5152; t += gridDim.x) {
    const float* src; long sld; u16* dst; int n0, k0, kind; long ntot = D;
    if (t < 4128) { kind = 0; ntot = NPAD; n0 = (t / 16) * 64; k0 = (t % 16) * 64; src = p.w_in + (long)l * D * IN_DIM; sld = IN_DIM; dst = p.WinT; }
    else if (t < 4896) { int u = t - 4128; int i = u / 256; u %= 256; kind = 1; n0 = (u / 16) * 64; k0 = (u % 16) * 64;
      src = p.w_branch + ((long)l * 3 + i) * D * D; sld = D; dst = p.WbrT + (long)i * D * D; }
    else { int u = t - 4896; kind = 1; n0 = (u / 16) * 64; k0 = (u % 16) * 64; src = p.w_out + (long)l * D * D; sld = D; dst = p.WoT; }
#pragma unroll 4
    for (int i = 0; i < 16; ++i) {
      int kk = (tid >> 6) + 4 * i, nn = tid & 63;
      int np = n0 + nn;
      int ns = kind == 0 ? win_src_col(np) : np;
      tile[kk][nn] = ns >= 0 ? src[(long)(k0 + kk) * sld + ns] : 0.f;
    }
    __syncthreads();
#pragma unroll 4
    for (int i = 0; i < 16; ++i) {
      int nn = (tid >> 6) + 4 * i, kk = tid & 63;
      dst[((long)((k0 + kk) >> 5) * ntot + (n0 + nn)) * 32 + ((k0 + kk) & 31)] = f2bf(tile[kk][nn]);
    }
    __syncthreads();
  }
}

__device__ void ph_prep_small(const Params& p) {
  int gt = blockIdx.x * blockDim.x + otid(), gs = gridDim.x * blockDim.x;
  for (int j = gt; j < 2 * D; j += gs) {
    if (j < D) p.lb[j] = 0.f;
    else { int ch = j - D; p.lb[j] = sigmoidf_(p.hg_lb[D + ch] - p.hg_lb[ch]); }
  }
}

__device__ void ph_mod(const Params& p, char* smem) {
  float (*sl)[D] = (float (*)[D])smem;
  float (*red)[17][64] = (float (*)[17][64])smem;
  const int tid = otid();
  const int kq = __builtin_amdgcn_readfirstlane(tid >> 6), cc = tid & 63;
  for (int u = blockIdx.x; u < 96; u += gridDim.x) {
    for (int i = tid; i < 17 * D; i += 256) sl[0][i] = siluf_(i < 16 * D ? p.c[i] : p.c_ctx[i - 16 * D]);
    __syncthreads();
    int l = u / 48, col = (u % 48) * 64 + cc;
    float acc[17];
#pragma unroll
    for (int r = 0; r < 17; ++r) acc[r] = 0.f;
    const float* w = p.ada_w + (long)l * D * 3072 + col;
#pragma unroll 4
    for (int k = kq * 256; k < kq * 256 + 256; ++k) {
      float wv = w[(long)k * 3072];
#pragma unroll
      for (int r = 0; r < 17; ++r) acc[r] += sl[r][k] * wv;
    }
    __syncthreads();
#pragma unroll
    for (int r = 0; r < 17; ++r) red[kq][r][cc] = acc[r];
    __syncthreads();
    for (int i = tid; i < 17 * 64; i += 256) {
      int r = i / 64, c2 = i % 64;
      int colo = (u % 48) * 64 + c2;
      float s_ = red[0][r][c2] + red[1][r][c2] + red[2][r][c2] + red[3][r][c2] + p.ada_b[l * 3072 + colo];
      p.mod[((long)l * 17 + r) * 3072 + colo] = s_;
    }
    __syncthreads();
  }
}

__device__ void ph_prenorm(const Params& p, int l, int g) {
  const int tid = otid();
  const int lane = tid & 63;
  const int gw = blockIdx.x * 4 + (tid >> 6), nw = gridDim.x * 4;
  for (int row = gw; row < TG; row += nw) {
    int bl = row / TPB, pp = row % TPB, b = g * GB + bl;
    const float* src; int mrow;
    if (pp < CTX) { src = (l == 0 ? p.ctx : p.ctxs) + ((long)b * CTX + pp) * D; mrow = 16; }
    else { src = (l == 0 ? p.x : p.out) + ((long)b * SEQ + (pp - CTX)) * D; mrow = b; }
    const float* md = p.mod + ((long)l * 17 + mrow) * 3072;
    float4 v[4]; float ss = 0.f;
#pragma unroll
    for (int i = 0; i < 4; ++i) {
      v[i] = ((const float4*)src)[lane + 64 * i];
      ss += v[i].x * v[i].x + v[i].y * v[i].y + v[i].z * v[i].z + v[i].w * v[i].w;
    }
    ss = wave_sum(ss);
    float rs = rsqrtf(ss * (1.f / D) + 1e-6f);
#pragma unroll
    for (int i = 0; i < 4; ++i) {
      int idx = (lane + 64 * i) * 4;
      float4 g4 = *(const float4*)(p.norm_g + l * D + idx);
      float4 sh = *(const float4*)(md + idx);
      float4 sc = *(const float4*)(md + D + idx);
      float h0 = v[i].x * rs * g4.x * (1.f + sc.x) + sh.x;
      float h1 = v[i].y * rs * g4.y * (1.f + sc.y) + sh.y;
      float h2 = v[i].z * rs * g4.z * (1.f + sc.z) + sh.z;
      float h3 = v[i].w * rs * g4.w * (1.f + sc.w) + sh.w;
      uint2 o; o.x = pack2(h0, h1); o.y = pack2(h2, h3);
      *(uint2*)(p.hbuf + ((long)(idx >> 5) * TG + row) * 32 + (idx & 31)) = o;
    }
  }
}

template <int MF, int NF>
__device__ __forceinline__ void gemm_kloopT(const u16* Ag, long lda, long aks, const u16* Bg, long ldb, long bks, int K, char* smem, f32x4 (&acc)[MF][NF]) {
  const int tid = otid();
  const int wid = tid >> 6, lane = tid & 63, wr = wid >> 1, wc = wid & 1, fr = lane & 15, fq = lane >> 4;
  constexpr int ASZ = MF * 32 * 64;
  constexpr int BSZ = NF * 32 * 64;
  constexpr int SSZ = ASZ + BSZ;
  constexpr int NLD = MF / 2 + NF / 2;
  const int lrow = tid >> 2, cs = tid & 3;
  const int cgl = cs ^ (((lrow >> 3) & 1) << 1);
  const u16* Ap = Ag + (long)lrow * lda + cgl * 8;
  const u16* Bp = Bg + (long)lrow * ldb + cgl * 8;
  const int nt = K / 32;
#define GK_ISSUE(T, S)                                                                                                   \
  {                                                                                                                      \
    char* _SA = smem + (S) * SSZ; char* _SB = _SA + ASZ;                                                                 \
    _Pragma("unroll") for (int _i = 0; _i < MF / 2; ++_i)                                                                \
      __builtin_amdgcn_global_load_lds((const unsigned*)(Ap + (long)_i * 64 * lda + (long)(T) * aks),                           \
                                       (__attribute__((address_space(3))) unsigned*)(_SA + _i * 4096 + tid * 16), 16, 0, 0); \
    _Pragma("unroll") for (int _i = 0; _i < NF / 2; ++_i)                                                                \
      __builtin_amdgcn_global_load_lds((const unsigned*)(Bp + (long)_i * 64 * ldb + (long)(T) * bks),                           \
                                       (__attribute__((address_space(3))) unsigned*)(_SB + _i * 4096 + tid * 16), 16, 0, 0); \
  }
  GK_ISSUE(0, 0)
  GK_ISSUE(1, 1)
  const int co = (fq ^ (((fr >> 3) & 1) << 1)) * 16;
#define GK_STEP(T, ST, S2, LAST1, LAST2)                                                                                 \
  {                                                                                                                      \
    if (!(LAST1)) asm volatile("s_waitcnt vmcnt(%0)" ::"n"(NLD) : "memory");                                             \
    else asm volatile("s_waitcnt vmcnt(0)" ::: "memory");                                                                \
    __builtin_amdgcn_s_barrier();                                                                                        \
    if (!(LAST2)) GK_ISSUE((T) + 2, S2)                                                                                  \
    bf16x8 At[MF], Bl[NF];                                                                                               \
    _Pragma("unroll") for (int m = 0; m < MF; ++m)                                                                       \
      asm volatile("ds_read_b128 %0, %1 offset:%2" : "=v"(At[m]) : "v"(aA), "n"((ST) * SSZ + m * 1024));                  \
    _Pragma("unroll") for (int n = 0; n < NF; ++n)                                                                       \
      asm volatile("ds_read_b128 %0, %1 offset:%2" : "=v"(Bl[n]) : "v"(aB), "n"((ST) * SSZ + n * 1024));                  \
    if (MF == 8 && NF == 4)                                                                                              \
      asm volatile("s_waitcnt lgkmcnt(0)" : "+v"(At[0]), "+v"(At[1]), "+v"(At[2]), "+v"(At[3]), "+v"(At[MF - 4]), "+v"(At[MF - 3]), \
                   "+v"(At[MF - 2]), "+v"(At[MF - 1]), "+v"(Bl[0]), "+v"(Bl[1]), "+v"(Bl[NF - 2]), "+v"(Bl[NF - 1]));    \
    else if (MF == 8)                                                                                                    \
      asm volatile("s_waitcnt lgkmcnt(0)" : "+v"(At[0]), "+v"(At[1]), "+v"(At[2]), "+v"(At[3]), "+v"(At[MF - 4]), "+v"(At[MF - 3]), \
                   "+v"(At[MF - 2]), "+v"(At[MF - 1]), "+v"(Bl[0]), "+v"(Bl[1]));                                        \
    else                                                                                                                 \
      asm volatile("s_waitcnt lgkmcnt(0)" : "+v"(At[0]), "+v"(At[1]), "+v"(At[2]), "+v"(At[3]),                          \
                   "+v"(Bl[0]), "+v"(Bl[1]), "+v"(Bl[NF - 2]), "+v"(Bl[NF - 1]));                                        \
    _Pragma("unroll") for (int m = 0; m < MF; ++m)                                                                       \
      _Pragma("unroll") for (int n = 0; n < NF; ++n)                                                                     \
        acc[m][n] = __builtin_amdgcn_mfma_f32_16x16x32_bf16(Bl[n], At[m], acc[m][n], 0, 0, 0);                           \
  }
  const unsigned lds0 = (unsigned)(unsigned long)(__attribute__((address_space(3))) const char*)smem;
  const unsigned aA = lds0 + (wr * MF * 16 + fr) * 64 + co;
  const unsigned aB = lds0 + ASZ + (wc * NF * 16 + fr) * 64 + co;
  for (int t = 0; t < nt - 2; t += 3) {
    GK_STEP(t, 0, 2, false, false)
    GK_STEP(t + 1, 1, 0, false, false)
    GK_STEP(t + 2, 2, 1, false, false)
  }
  GK_STEP(nt - 2, 0, 2, false, true)
  GK_STEP(nt - 1, 1, 0, true, true)
#undef GK_STEP
  __builtin_amdgcn_s_barrier();
#undef GK_ISSUE
}

template <int MF>
__device__ __forceinline__ void gemm_in_tile(const Params& p, int l, char* smem, int mt, int nt) {
  f32x4 acc[MF][4];
#pragma unroll
  for (int m = 0; m < MF; ++m)
#pragma unroll
    for (int n = 0; n < 4; ++n) acc[m][n] = f32x4{0.f, 0.f, 0.f, 0.f};
  gemm_kloopT<MF, 4>(p.hbuf + (long)mt * (MF * 32) * 32, 32, (long)TG * 32, p.WinT + (long)nt * 128 * 32, 32, (long)NPAD * 32, D, smem, acc);
  const int tid = otid();
  const int wr = (tid >> 7) & 1, wc = (tid >> 6) & 1, fr = tid & 15, fq = (tid >> 4) & 3;
  if (nt < 128) {
    u16* dbase; long dld; int cb;
    if (nt >= 40 && nt < 64) { dbase = p.obuf; dld = 3072; cb = (nt - 40) * 128; }
    else { dbase = p.proj; dld = PLD; cb = nt * 128; }
#pragma unroll
    for (int m = 0; m < MF; ++m) {
      int row = mt * (MF * 32) + wr * (MF * 16) + m * 16 + fr;
#pragma unroll
      for (int n = 0; n < 4; ++n) {
        int col = cb + wc * 64 + n * 16 + fq * 4;
        if (nt >= 16 && nt < 32) {
          float4 lb4 = *(const float4*)(p.lb + l * D + ((col - C_HGF) & 1023));
          acc[m][n][0] = __logf(lb4.x + (1.f - lb4.x) * sigmoidf_(acc[m][n][0]));
          acc[m][n][1] = __logf(lb4.y + (1.f - lb4.y) * sigmoidf_(acc[m][n][1]));
          acc[m][n][2] = __logf(lb4.z + (1.f - lb4.z) * sigmoidf_(acc[m][n][2]));
          acc[m][n][3] = __logf(lb4.w + (1.f - lb4.w) * sigmoidf_(acc[m][n][3]));
        }
        uint2 o; o.x = pack2(acc[m][n][0], acc[m][n][1]); o.y = pack2(acc[m][n][2], acc[m][n][3]);
        *(uint2*)(dbase + (long)row * dld + col) = o;
      }
    }
  } else if (wc == 0) {
#pragma unroll
    for (int m = 0; m < MF; ++m) {
      int row = mt * (MF * 32) + wr * (MF * 16) + m * 16 + fr;
#pragma unroll
      for (int n = 0; n < 4; ++n) {
        int col = n * 16 + fq * 4;
        *(float4*)(p.gates + (long)row * GLD + col) = float4{acc[m][n][0], acc[m][n][1], acc[m][n][2], acc[m][n][3]};
      }
    }
  }
}

__device__ void ph_gemm_in_a(const Params& p, int l, char* smem) {
  for (int t = blockIdx.x; t < 36 * 73; t += gridDim.x) {
    int i = t / 36, mt = t % 36;
    int nt = i < 32 ? i : (i < 56 ? 40 + (i - 32) : (i < 72 ? 72 + (i - 56) : 128));
    gemm_in_tile<8>(p, l, smem, mt, nt);
  }
}
__device__ __forceinline__ void gemm_in_b_tile(const Params& p, int l, char* smem, int tb) {
  constexpr int QB_ALL = 36 * 56, QB_TAIL = 256, QB_BIG = QB_ALL - QB_TAIL;
  int half = -1;
  if (tb >= QB_BIG) { int hb = tb - QB_BIG; tb = QB_BIG + (hb >> 1); half = hb & 1; }
  int i = tb / 36, mt = tb % 36;
  if (l == 1 && (mt % 9) == 0) return;
  int nt = i < 8 ? 32 + i : (i < 16 ? 64 + (i - 8) : 88 + (i - 16));
  if (half < 0) gemm_in_tile<8>(p, l, smem, mt, nt);
  else gemm_in_tile<4>(p, l, smem, mt * 2 + half, nt);
}
constexpr int QB_END = 36 * 56 + 256;

template <int MODE>
__device__ __forceinline__ void conv_pass(const Params& p, int l, int gw, int nw, int lane) {
  const u16* stg = p.obuf;
  const int c8 = lane & 15;
  int chn, ntask, tshift;
  bool isq = false;
  if (MODE == 0) {
    const int hp = gw & 3, sub = lane >> 5, part = (lane >> 4) & 1;
    chn = part * 1024 + (hp * 2 + sub) * 128 + c8 * 8; ntask = TG * 4; tshift = 2; isq = (part == 0);
  } else {
    const int hq = gw & 1, sub = lane >> 4;
    chn = 2048 + (hq * 4 + sub) * 128 + c8 * 8; ntask = TG * 2; tshift = 1;
  }
  float4 wa[9], wb[9];
  {
    const float* cwb = p.gdn_conv + (long)l * 9 * 3072 + chn;
#pragma unroll
    for (int k = 0; k < 9; ++k) { wa[k] = *(const float4*)(cwb + k * 3072); wb[k] = *(const float4*)(cwb + k * 3072 + 4); }
  }
  uint4 nx0, nx1, nx2, nx3, nx4, nx5, nx6, nx7, nx8;
#define CONV_LOAD(TASK)                                                                                        \
  {                                                                                                            \
    const uint4 _z = uint4{0u, 0u, 0u, 0u};                                                                    \
    nx0 = nx1 = nx2 = nx3 = nx4 = nx5 = nx6 = nx7 = nx8 = _z;                                                  \
    if ((TASK) < ntask) {                                                                                      \
      int _row = (TASK) >> tshift, _bl = _row / TPB, _t = _row % TPB;                                          \
      const u16* _b = stg + (long)_bl * TPB * 3072 + chn;                                                      \
      if (_t < CTX) {                                                                                          \
        if (_t > 0) nx3 = *(const uint4*)(_b + (long)(_t - 1) * 3072);                                         \
        nx4 = *(const uint4*)(_b + (long)_t * 3072);                                                           \
        if (_t < CTX - 1) nx5 = *(const uint4*)(_b + (long)(_t + 1) * 3072);                                   \
      } else {                                                                                                 \
        int _lt = _t - CTX, _r = _lt >> 6, _c = _lt & 63;                                                      \
        const u16* _q = _b + (long)(CTX + _lt) * 3072;                                                         \
        bool _u = _r > 0, _d = _r < 31, _l = _c > 0, _rr = _c < 63;                                            \
        if (_u && _l) nx0 = *(const uint4*)(_q - 65 * 3072);                                                   \
        if (_u) nx1 = *(const uint4*)(_q - 64 * 3072);                                                         \
        if (_u && _rr) nx2 = *(const uint4*)(_q - 63 * 3072);                                                  \
        if (_l) nx3 = *(const uint4*)(_q - 1 * 3072);                                                          \
        nx4 = *(const uint4*)(_q);                                                                             \
        if (_rr) nx5 = *(const uint4*)(_q + 1 * 3072);                                                         \
        if (_d && _l) nx6 = *(const uint4*)(_q + 63 * 3072);                                                   \
        if (_d) nx7 = *(const uint4*)(_q + 64 * 3072);                                                         \
        if (_d && _rr) nx8 = *(const uint4*)(_q + 65 * 3072);                                                  \
      }                                                                                                        \
    }                                                                                                          \
  }
#define CONV_TAP(R, K)                                                                                         \
  {                                                                                                            \
    float xv[8]; unpack8(R, xv);                                                                               \
    val[0] += xv[0] * wa[K].x; val[1] += xv[1] * wa[K].y; val[2] += xv[2] * wa[K].z; val[3] += xv[3] * wa[K].w; \
    val[4] += xv[4] * wb[K].x; val[5] += xv[5] * wb[K].y; val[6] += xv[6] * wb[K].z; val[7] += xv[7] * wb[K].w; \
  }
  CONV_LOAD(gw)
  for (int task = gw; task < ntask; task += nw) {
    const uint4 c0 = nx0, c1 = nx1, c2 = nx2, c3 = nx3, c4 = nx4, c5 = nx5, c6 = nx6, c7 = nx7, c8r = nx8;
    CONV_LOAD(task + nw)
    int row = task >> tshift;
    float val[8];
#pragma unroll
    for (int e = 0; e < 8; ++e) val[e] = 0.f;
    CONV_TAP(c0, 0) CONV_TAP(c1, 1) CONV_TAP(c2, 2) CONV_TAP(c3, 3) CONV_TAP(c4, 4)
    CONV_TAP(c5, 5) CONV_TAP(c6, 6) CONV_TAP(c7, 7) CONV_TAP(c8r, 8)
    float ss = 0.f;
#pragma unroll
    for (int e = 0; e < 8; ++e) { val[e] = siluf_(val[e]); ss += val[e] * val[e]; }
    float scl = 1.f;
    if (MODE == 0) {
      ss += __shfl_xor(ss, 1); ss += __shfl_xor(ss, 2); ss += __shfl_xor(ss, 4); ss += __shfl_xor(ss, 8);
      scl = rsqrtf(ss + 1e-6f) * (isq ? 0.08838834764831845f : 1.f);
    }
    uint4 o;
    o.x = pack2(val[0] * scl, val[1] * scl); o.y = pack2(val[2] * scl, val[3] * scl);
    o.z = pack2(val[4] * scl, val[5] * scl); o.w = pack2(val[6] * scl, val[7] * scl);
    *(uint4*)(p.proj + (long)row * PLD + C_GQ + chn) = o;
  }
#undef CONV_LOAD
#undef CONV_TAP
}

__device__ void ph_conv(const Params& p, int l) {
  const int tid = otid();
  const int lane = tid & 63;
  const int gw = blockIdx.x * 4 + (tid >> 6), nw = gridDim.x * 4;
  conv_pass<0>(p, l, gw, nw, lane);
  conv_pass<1>(p, l, gw, nw, lane);
}

struct ScanSmem {
  float q[TC][128];
  float k[TC][128];
  float f[TC][128];
  float v[TC][64];
  float sc[TC][4];
};

__device__ __forceinline__ int scan_row(int bl, int dir, int pos) {
  int t;
  if (pos < CTX) t = dir ? (CTX - 1 - pos) : pos;
  else { int u = pos - CTX; t = CTX + (dir ? (SEQ - 1 - u) : u); }
  return bl * TPB + t;
}

__device__ void scan_unit(const Params& p, int l, int g, int u, ScanSmem& sm) {
  const int tid = otid(), lane = tid & 63, w = tid >> 6;
  const int j = lane & 15, gq = lane >> 4;
  const int mixer = u / 128, r = u % 128;
  int bl, h, dir, vs;
  bl = r / 32;
  if (mixer < 2) { h = (r % 32) / 4; dir = (r % 4) / 2; vs = r % 2; }
  else { h = (r % 32) / 8; dir = (r % 8) / 4; vs = r % 4; }
  int cq, ck, cv, ocol;
  if (mixer == 0) { cq = C_HGQ + h * 128; ck = C_HGF + dir * 1024 + h * 128; cv = C_HGI + h * 128 + vs * 64; ocol = h * 128 + vs * 64; }
  else if (mixer == 1) { cq = C_GQ + h * 128; ck = C_GK + h * 128; cv = C_GV + h * 128 + vs * 64; ocol = 1024 + h * 128 + vs * 64; }
  else { cq = C_MQ + h * 128; ck = C_MK + h * 128; cv = C_MV + h * 256 + vs * 64; ocol = 2048 + h * 256 + vs * 64; }

  float S[32];
#pragma unroll
  for (int i = 0; i < 32; ++i) S[i] = 0.f;
  float n0 = 0.f, n1 = 0.f;
  float mstate = 0.f;
  float gA = 0.f, gDt = 0.f, ibias = 0.f, fbias = 0.f;
  if (mixer == 1) { gA = -__expf(p.gdn_a_log[l * 16 + dir * 8 + h]); gDt = p.gdn_dt_bias[l * 16 + dir * 8 + h]; }
  if (mixer == 2) { ibias = p.ml_i_bias[l * 8 + dir * 4 + h]; fbias = p.ml_f_bias[l * 8 + dir * 4 + h]; }

  __syncthreads();
  if (mixer == 1) {
    float* cw = &sm.f[0][0];
    for (int i = tid; i < 9 * 320; i += 256) {
      int tap = i / 320, lc = i % 320;
      int ch = lc < 128 ? (h * 128 + lc) : (lc < 256 ? (1024 + h * 128 + lc - 128) : (2048 + h * 128 + vs * 64 + lc - 256));
      cw[i] = p.gdn_conv[((long)l * 9 + tap) * 3072 + ch];
    }
    __syncthreads();
  }

  for (int ch0 = 0; ch0 < TPB / TC; ++ch0) {
    const int pos0 = ch0 * TC;
    const bool is_ctx = pos0 < CTX;
    __syncthreads();
    for (int idx = tid; idx < TC * 40; idx += 256) {
      int tok = idx / 40, cgp = idx % 40;
      int row = scan_row(bl, dir, pos0 + tok);
      int col, lc;
      if (cgp < 16) { col = cq + cgp * 8; lc = cgp * 8; }
      else if (cgp < 32) { col = ck + (cgp - 16) * 8; lc = 128 + (cgp - 16) * 8; }
      else { col = cv + (cgp - 32) * 8; lc = 256 + (cgp - 32) * 8; }
      float val[8];
      if (mixer != 1) {
        uint4 raw = *(const uint4*)(p.proj + (long)row * PLD + col);
        unpack8(raw, val);
      } else {
        const float* cw = &sm.f[0][0];
#pragma unroll
        for (int e = 0; e < 8; ++e) val[e] = 0.f;
        int t = row - bl * TPB;
        if (is_ctx) {
#pragma unroll
          for (int jj = 0; jj < 3; ++jj) {
            int tt = t + jj - 1;
            if (tt >= 0 && tt < CTX) {
              uint4 raw = *(const uint4*)(p.proj + (long)(bl * TPB + tt) * PLD + col);
              float xv[8]; unpack8(raw, xv);
              const float* wv = cw + (3 + jj) * 320 + lc;
#pragma unroll
              for (int e = 0; e < 8; ++e) val[e] += xv[e] * wv[e];
            }
          }
        } else {
          int lt = t - CTX, rr0 = lt >> 6, cc0 = lt & 63;
#pragma unroll
          for (int ii = 0; ii < 3; ++ii) {
            int rr = rr0 + ii - 1;
            if (rr < 0 || rr >= 32) continue;
#pragma unroll
            for (int jj = 0; jj < 3; ++jj) {
              int cc = cc0 + jj - 1;
              if (cc < 0 || cc >= 64) continue;
              uint4 raw = *(const uint4*)(p.proj + (long)(bl * TPB + CTX + rr * 64 + cc) * PLD + col);
              float xv[8]; unpack8(raw, xv);
              const float* wv = cw + (ii * 3 + jj) * 320 + lc;
#pragma unroll
              for (int e = 0; e < 8; ++e) val[e] += xv[e] * wv[e];
            }
          }
        }
#pragma unroll
        for (int e = 0; e < 8; ++e) val[e] = siluf_(val[e]);
      }
      if (cgp < 16) {
        float scl = (mixer == 2) ? 0.08838834764831845f : 1.f;
#pragma unroll
        for (int e = 0; e < 8; ++e) sm.q[tok][lc + e] = val[e] * scl;
      } else if (cgp < 32) {
        int d0 = lc - 128;
        if (mixer == 0) {
#pragma unroll
          for (int e = 0; e < 8; ++e) {
            float lbv = p.lb[l * D + h * 128 + d0 + e];
            float f = lbv + (1.f - lbv) * sigmoidf_(val[e]);
            sm.f[tok][d0 + e] = f;
            sm.k[tok][d0 + e] = 1.f - f;
          }
        } else {
#pragma unroll
          for (int e = 0; e < 8; ++e) sm.k[tok][d0 + e] = val[e];
        }
      } else {
        int c0 = lc - 256;
#pragma unroll
        for (int e = 0; e < 8; ++e) sm.v[tok][c0 + e] = val[e];
      }
    }
    if (mixer == 2 && tid < TC) {
      int row = scan_row(bl, dir, pos0 + tid);
      float ig = p.gates[(long)row * GLD + 32 + dir * 4 + h] + ibias;
      float fx = p.gates[(long)row * GLD + 40 + dir * 4 + h] + fbias;
      sm.sc[tid][0] = ig;
      sm.sc[tid][1] = -softplusf_(-fx);
    }
    __syncthreads();
    if (mixer == 1) {
      for (int tk = w * 8; tk < w * 8 + 8; ++tk) {
        float q0 = sm.q[tk][lane], q1 = sm.q[tk][lane + 64], k0 = sm.k[tk][lane], k1 = sm.k[tk][lane + 64];
        float sq = wave_sum(q0 * q0 + q1 * q1), sk = wave_sum(k0 * k0 + k1 * k1), qk = wave_sum(q0 * k0 + q1 * k1);
        float rq = rsqrtf(sq + 1e-6f) * 0.08838834764831845f, rk = rsqrtf(sk + 1e-6f);
        sm.q[tk][lane] = q0 * rq; sm.q[tk][lane + 64] = q1 * rq;
        sm.k[tk][lane] = k0 * rk; sm.k[tk][lane + 64] = k1 * rk;
        if (lane == 0) {
          int row = scan_row(bl, dir, pos0 + tk);
          float beta = sigmoidf_(p.gates[(long)row * GLD + dir * 8 + h]);
          float gg = gA * softplusf_(p.gates[(long)row * GLD + 16 + dir * 8 + h] + gDt);
          sm.sc[tk][0] = __expf(gg); sm.sc[tk][1] = beta; sm.sc[tk][2] = qk * rq * rk;
        }
      }
      __syncthreads();
    } else if (mixer == 2) {
      if (tid == 0) {
        float m = mstate;
        for (int tk = 0; tk < TC; ++tk) {
          float ig = sm.sc[tk][0], lf = sm.sc[tk][1];
          float mn = fmaxf(lf + m, ig);
          sm.sc[tk][0] = __expf(lf + m - mn);
          sm.sc[tk][1] = __expf(ig - mn);
          sm.sc[tk][2] = __expf(-mn);
          m = mn;
        }
        mstate = m;
      }
      __syncthreads();
    }
    if (mixer == 0) {
      for (int tk = 0; tk < TC; ++tk) {
        float vj = sm.v[tk][w * 16 + j];
        const float4* qp = (const float4*)&sm.q[tk][gq * 32];
        const float4* kp = (const float4*)&sm.k[tk][gq * 32];
        const float4* fp = (const float4*)&sm.f[tk][gq * 32];
        float acc = 0.f;
#pragma unroll
        for (int i = 0; i < 8; ++i) {
          float4 q4 = qp[i], k4 = kp[i], f4 = fp[i];
          S[4 * i + 0] = f4.x * S[4 * i + 0] + k4.x * vj; acc += q4.x * S[4 * i + 0];
          S[4 * i + 1] = f4.y * S[4 * i + 1] + k4.y * vj; acc += q4.y * S[4 * i + 1];
          S[4 * i + 2] = f4.z * S[4 * i + 2] + k4.z * vj; acc += q4.z * S[4 * i + 2];
          S[4 * i + 3] = f4.w * S[4 * i + 3] + k4.w * vj; acc += q4.w * S[4 * i + 3];
        }
        acc += __shfl_xor(acc, 16); acc += __shfl_xor(acc, 32);
        if (gq == 0) sm.v[tk][w * 16 + j] = acc;
      }
    } else if (mixer == 1) {
      for (int tk = 0; tk < TC; ++tk) {
        float vj = sm.v[tk][w * 16 + j];
        float a = sm.sc[tk][0], beta = sm.sc[tk][1], qk = sm.sc[tk][2];
        const float4* qp = (const float4*)&sm.q[tk][gq * 32];
        const float4* kp = (const float4*)&sm.k[tk][gq * 32];
        float kr[32];
        float rr = 0.f, pq = 0.f;
#pragma unroll
        for (int i = 0; i < 8; ++i) {
          float4 q4 = qp[i], k4 = kp[i];
          kr[4 * i + 0] = k4.x; kr[4 * i + 1] = k4.y; kr[4 * i + 2] = k4.z; kr[4 * i + 3] = k4.w;
          rr += k4.x * S[4 * i + 0]; pq += q4.x * S[4 * i + 0];
          rr += k4.y * S[4 * i + 1]; pq += q4.y * S[4 * i + 1];
          rr += k4.z * S[4 * i + 2]; pq += q4.z * S[4 * i + 2];
          rr += k4.w * S[4 * i + 3]; pq += q4.w * S[4 * i + 3];
        }
        rr += __shfl_xor(rr, 16); pq += __shfl_xor(pq, 16);
        rr += __shfl_xor(rr, 32); pq += __shfl_xor(pq, 32);
        float vn = beta * (vj - a * rr);
        float ov = a * pq + qk * vn;
#pragma unroll
        for (int i = 0; i < 32; ++i) S[i] = a * S[i] + kr[i] * vn;
        if (gq == 0) sm.v[tk][w * 16 + j] = ov;
      }
    } else {
      for (int tk = 0; tk < TC; ++tk) {
        float vj = sm.v[tk][w * 16 + j];
        float fd = sm.sc[tk][0], iw = sm.sc[tk][1], em = sm.sc[tk][2];
        float ivj = iw * vj;
        const float4* qp = (const float4*)&sm.q[tk][gq * 32];
        const float4* kp = (const float4*)&sm.k[tk][gq * 32];
        float acc = 0.f;
#pragma unroll
        for (int i = 0; i < 8; ++i) {
          float4 q4 = qp[i], k4 = kp[i];
          S[4 * i + 0] = fd * S[4 * i + 0] + k4.x * ivj; acc += q4.x * S[4 * i + 0];
          S[4 * i + 1] = fd * S[4 * i + 1] + k4.y * ivj; acc += q4.y * S[4 * i + 1];
          S[4 * i + 2] = fd * S[4 * i + 2] + k4.z * ivj; acc += q4.z * S[4 * i + 2];
          S[4 * i + 3] = fd * S[4 * i + 3] + k4.w * ivj; acc += q4.w * S[4 * i + 3];
        }
        float2 kk = *(const float2*)&sm.k[tk][gq * 32 + 2 * j];
        float2 qq = *(const float2*)&sm.q[tk][gq * 32 + 2 * j];
        n0 = fd * n0 + iw * kk.x; n1 = fd * n1 + iw * kk.y;
        float den = n0 * qq.x + n1 * qq.y;
        den = wave_sum(den);
        acc += __shfl_xor(acc, 16); acc += __shfl_xor(acc, 32);
        if (gq == 0) sm.v[tk][w * 16 + j] = acc / fmaxf(fabsf(den), em);
      }
    }
    __syncthreads();
    {
      int tok = tid >> 3, c8 = tid & 7;
      int row = scan_row(bl, dir, pos0 + tok);
      const float* op = &sm.v[tok][c8 * 8];
      uint4 o;
      o.x = pack2(op[0], op[1]); o.y = pack2(op[2], op[3]); o.z = pack2(op[4], op[5]); o.w = pack2(op[6], op[7]);
      *(uint4*)(p.obuf + ((long)dir * TG + row) * 3072 + ocol + c8 * 8) = o;
    }
  }
}

struct CSmem {
  u16 QA[32][136];
  u16 KA[32][136];
  u16 KDT[128][40];
  u16 XT[64][40];
  u16 ATT[32][40];
  u16 ST[64][136];
  float sc[32][8];
  union {
    struct { u16 QD[32][136]; float dec[128]; float hsum[4][128]; } hg;
    struct { u16 YT[64][40]; u16 TM[32][40]; float NM[32][36]; u16 VF[32][72]; float TS[3][16][20]; } gd;
    struct { float nvec[128]; } ml;
  } u;
};

__device__ __forceinline__ f32x4 mfma16(bf16x8 a, bf16x8 b, f32x4 c) { return __builtin_amdgcn_mfma_f32_16x16x32_bf16(a, b, c, 0, 0, 0); }
__device__ __forceinline__ bf16x8 ldf(const u16* base, int ld, int row, int k) { return *(const bf16x8*)(base + row * ld + k); }
__device__ __forceinline__ void st4(u16* dst, float a, float b, float c, float d) { uint2 v; v.x = pack2(a, b); v.y = pack2(c, d); *(uint2*)dst = v; }

__device__ void scan_unit_mma(const Params& p, int l, int g, int u, CSmem& sm) {
  const int tid0 = otid();
  const int mixer = u / 128, r = u % 128;
  int bl, h, dir, vs;
  bl = r / 32;
  if (mixer < 2) { h = (r % 32) / 4; dir = (r % 4) / 2; vs = r % 2; }
  else { h = (r % 32) / 8; dir = (r % 8) / 4; vs = r % 4; }
  int cq, ck, cv, ocol;
  if (mixer == 0) { cq = C_HGQ + h * 128; ck = C_HGF + dir * 1024 + h * 128; cv = C_HGI + h * 128 + vs * 64; ocol = h * 128 + vs * 64; }
  else if (mixer == 1) { cq = C_GQ + h * 128; ck = C_GK + h * 128; cv = C_GV + h * 128 + vs * 64; ocol = 1024 + h * 128 + vs * 64; }
  else { cq = C_MQ + h * 128; ck = C_MK + h * 128; cv = C_MV + h * 256 + vs * 64; ocol = 2048 + h * 256 + vs * 64; }
  const float QS = 0.08838834764831845f;

  f32x4 S[2][4];
#pragma unroll
  for (int a = 0; a < 2; ++a)
#pragma unroll
    for (int b = 0; b < 4; ++b) S[a][b] = f32x4{0.f, 0.f, 0.f, 0.f};
  float mcar = 0.f;
  float gA = 0.f, gDt = 0.f, ibias = 0.f, fbias = 0.f;
  if (mixer == 1) { gA = -__expf(p.gdn_a_log[l * 16 + dir * 8 + h]); gDt = p.gdn_dt_bias[l * 16 + dir * 8 + h]; }
  if (mixer == 2) { ibias = p.ml_i_bias[l * 8 + dir * 4 + h]; fbias = p.ml_f_bias[l * 8 + dir * 4 + h]; }

  __syncthreads();
  for (int i = tid0; i < 64 * 136 / 2; i += 256) ((unsigned*)&sm.ST[0][0])[i] = 0u;
  if (mixer == 2 && tid0 < 128) sm.u.ml.nvec[tid0] = 0.f;
  __syncthreads();


  uint4 pq0, pq1, pk0, pk1, pv, pt = uint4{0u, 0u, 0u, 0u};
  float pg0 = 0.f, pg1 = 0.f, pg2 = 0.f;
  const int ptask0 = ((bl * 8 + h) * 2 + dir) * 72;
  const int mtask0 = ((bl * 4 + h) * 2 + dir) * 72;
  const int gc0 = (mixer == 1) ? (dir * 8 + h) : (32 + dir * 4 + h);
  const int gc1 = (mixer == 1) ? (16 + dir * 8 + h) : (40 + dir * 4 + h);
  const float lbv = (mixer == 0) ? p.lb[l * D + h * 128 + (tid0 & 127)] : 0.f;
#define ISSUE_LOADS(CH, TID)                                                                          \
  {                                                                                                   \
    const int _pos = (CH) * 32;                                                                       \
    {                                                                                                 \
      int _idx = (TID), _tok = _idx >> 4, _c = _idx & 15;                                             \
      const u16* _pr = p.proj + (long)scan_row(bl, dir, _pos + _tok) * PLD;                           \
      pq0 = *(const uint4*)(_pr + cq + _c * 8);                                                       \
      pk0 = *(const uint4*)(_pr + ck + _c * 8);                                                       \
    }                                                                                                 \
    {                                                                                                 \
      int _idx = (TID) + 256, _tok = _idx >> 4, _c = _idx & 15;                                       \
      const u16* _pr = p.proj + (long)scan_row(bl, dir, _pos + _tok) * PLD;                           \
      pq1 = *(const uint4*)(_pr + cq + _c * 8);                                                       \
      pk1 = *(const uint4*)(_pr + ck + _c * 8);                                                       \
    }                                                                                                 \
    {                                                                                                 \
      int _tok = (TID) >> 3, _c8 = (TID) & 7;                                                         \
      pv = *(const uint4*)(p.proj + (long)scan_row(bl, dir, _pos + _tok) * PLD + cv + _c8 * 8);       \
    }                                                                                                 \
    if (mixer == 2 && (TID) < 64) {                                                                   \
      const float* _gs = p.mprep + ((long)mtask0 + (CH)) * 96;                                        \
      pg0 = _gs[(TID) & 31]; pg1 = _gs[32 + ((TID) & 31)]; pg2 = _gs[64 + ((TID) & 31)];             \
    }                                                                                                 \
    if (mixer == 1) {                                                                                 \
      const u16* _gq = p.gprep + ((long)ptask0 + (CH)) * 2176;                                        \
      pt = *(const uint4*)(_gq + (TID) * 8);                                                          \
      if ((TID) < 64) { const float* _gs = (const float*)(_gq + 2048); pg0 = _gs[(TID) & 31]; pg1 = _gs[32 + ((TID) & 31)]; } \
    }                                                                                                 \
  }
  ISSUE_LOADS(0, tid0)

  for (int ch0 = 0; ch0 < TPB / 32; ++ch0) {
    const int tid = otid(), lane = tid & 63, w = tid >> 6, fr = lane & 15, fq = lane >> 4;
    const int rt_o = w & 1, cp_o = w >> 1;
    const int pos0 = ch0 * 32;
    float mnew = 0.f;
    {
      int tok = tid >> 4, c = tid & 15;
      *(uint4*)&sm.QA[tok][c * 8] = pq0; *(uint4*)&sm.KA[tok][c * 8] = pk0;
      *(uint4*)&sm.QA[tok + 16][c * 8] = pq1; *(uint4*)&sm.KA[tok + 16][c * 8] = pk1;
    }
    {
      int t = tid >> 3, c8 = tid & 7;
      if (mixer == 1) *(uint4*)&sm.u.gd.VF[t][c8 * 8] = pv;
      else {
        sm.XT[c8 * 8 + 0][t] = (u16)(pv.x & 0xffffu); sm.XT[c8 * 8 + 1][t] = (u16)(pv.x >> 16);
        sm.XT[c8 * 8 + 2][t] = (u16)(pv.y & 0xffffu); sm.XT[c8 * 8 + 3][t] = (u16)(pv.y >> 16);
        sm.XT[c8 * 8 + 4][t] = (u16)(pv.z & 0xffffu); sm.XT[c8 * 8 + 5][t] = (u16)(pv.z >> 16);
        sm.XT[c8 * 8 + 6][t] = (u16)(pv.w & 0xffffu); sm.XT[c8 * 8 + 7][t] = (u16)(pv.w >> 16);
      }
    }
    if (mixer == 1) {
      int which = tid >> 7, idx = tid & 127, row = idx >> 2, c8 = (idx & 3) * 8;
      if (which == 0) *(uint4*)&sm.u.gd.TM[row][c8] = pt; else *(uint4*)&sm.ATT[row][c8] = pt;
    }
    const float g0 = pg0, g1 = pg1, g2 = pg2;
    if (ch0 + 1 < TPB / 32) ISSUE_LOADS(ch0 + 1, tid)
    if (mixer == 0) {
      __syncthreads();
      const int dp = lane, d0 = 2 * lane, t0 = w * 8;
      float bb0[8], bb1[8], qv0[8], qv1[8], kv0[8], kv1[8];
      float run0 = 0.f, run1 = 0.f;
#pragma unroll
      for (int i = 0; i < 8; ++i) {
        unsigned lfp = *(const unsigned*)&sm.KA[t0 + i][d0];
        unsigned qp = *(const unsigned*)&sm.QA[t0 + i][d0];
        float lf0 = __uint_as_float(lfp << 16), lf1 = __uint_as_float(lfp & 0xffff0000u);
        qv0[i] = __uint_as_float(qp << 16); qv1[i] = __uint_as_float(qp & 0xffff0000u);
        kv0[i] = 1.f - __expf(lf0); kv1[i] = 1.f - __expf(lf1);
        run0 += lf0; run1 += lf1;
        bb0[i] = run0; bb1[i] = run1;
      }
      *(float2*)&sm.u.hg.hsum[w][d0] = float2{run0, run1};
      __syncthreads();
      float2 h0 = *(const float2*)&sm.u.hg.hsum[0][d0], h1 = *(const float2*)&sm.u.hg.hsum[1][d0];
      float2 h2 = *(const float2*)&sm.u.hg.hsum[2][d0], h3 = *(const float2*)&sm.u.hg.hsum[3][d0];
      const float bref0 = h0.x + h1.x, bref1 = h0.y + h1.y;
      const float bend0 = bref0 + h2.x + h3.x, bend1 = bref1 + h2.y + h3.y;
      const float off0 = (w > 0 ? h0.x : 0.f) + (w > 1 ? h1.x : 0.f) + (w > 2 ? h2.x : 0.f);
      const float off1 = (w > 0 ? h0.y : 0.f) + (w > 1 ? h1.y : 0.f) + (w > 2 ? h2.y : 0.f);
      if (w == 0) *(float2*)&sm.u.hg.dec[d0] = float2{__expf(bend0), __expf(bend1)};
      const float ebref0 = __expf(bref0), ebref1 = __expf(bref1), eber0 = __expf(bend0 - bref0), eber1 = __expf(bend1 - bref1);
      unsigned kda[4], kdb[4];
#pragma unroll
      for (int i = 0; i < 8; ++i) {
        float b0 = bb0[i] + off0, b1 = bb1[i] + off1;
        float qa0 = qv0[i] * __expf(fminf(b0 - bref0, 80.f)), qa1 = qv1[i] * __expf(fminf(b1 - bref1, 80.f));
        float ka0 = kv0[i] * __expf(fminf(bref0 - b0, 80.f)), ka1 = kv1[i] * __expf(fminf(bref1 - b1, 80.f));
        *(unsigned*)&sm.QA[t0 + i][d0] = pack2(qa0, qa1);
        *(unsigned*)&sm.KA[t0 + i][d0] = pack2(ka0, ka1);
        *(unsigned*)&sm.u.hg.QD[t0 + i][d0] = pack2(qa0 * ebref0, qa1 * ebref1);
        unsigned kp = pack2(ka0 * eber0, ka1 * eber1);
        if (i & 1) { kda[i >> 1] |= (kp & 0xffffu) << 16; kdb[i >> 1] |= kp & 0xffff0000u; }
        else { kda[i >> 1] = kp & 0xffffu; kdb[i >> 1] = kp >> 16; }
      }
      *(uint4*)&sm.KDT[d0][t0] = uint4{kda[0], kda[1], kda[2], kda[3]};
      *(uint4*)&sm.KDT[d0 + 1][t0] = uint4{kdb[0], kdb[1], kdb[2], kdb[3]};
      (void)dp;
      __syncthreads();
    } else if (mixer == 1) {
      if (w == 0) {
        const float Gend_ = __shfl(g0, 31);
        if (lane < 32) { sm.sc[lane][0] = g0; sm.sc[lane][1] = g1; sm.sc[lane][3] = __expf(Gend_ - g0); }
      }
    } else {
      if (w == 0) {
        const float Mend_ = fmaxf(mcar, __shfl(g2, 31));
        if (lane < 32) { sm.sc[lane][0] = g0; sm.sc[lane][1] = g1; sm.sc[lane][2] = fmaxf(mcar, g2); sm.sc[lane][3] = __expf(g1 - Mend_); }
      }
      __syncthreads();
      mnew = sm.sc[31][0] + sm.sc[31][2];
      {
        const int d0 = 2 * lane, t0 = w * 8;
        unsigned kda[4], kdb[4];
#pragma unroll
        for (int i = 0; i < 8; ++i) {
          unsigned kk2 = *(const unsigned*)&sm.KA[t0 + i][d0];
          float fct = sm.sc[t0 + i][3];
          unsigned kp = pack2(__uint_as_float(kk2 << 16) * fct, __uint_as_float(kk2 & 0xffff0000u) * fct);
          if (i & 1) { kda[i >> 1] |= (kp & 0xffffu) << 16; kdb[i >> 1] |= kp & 0xffff0000u; }
          else { kda[i >> 1] = kp & 0xffffu; kdb[i >> 1] = kp >> 16; }
        }
        *(uint4*)&sm.KDT[d0][t0] = uint4{kda[0], kda[1], kda[2], kda[3]};
        *(uint4*)&sm.KDT[d0 + 1][t0] = uint4{kdb[0], kdb[1], kdb[2], kdb[3]};
      }
    }
    if (mixer == 1) {
    } else {
      int si, ti; bool doit = true;
      si = w & 1; ti = w >> 1; doit = !(si == 1 && ti == 0);
      if (doit) {
        f32x4 acc = f32x4{0.f, 0.f, 0.f, 0.f};
#pragma unroll
        for (int kk = 0; kk < 4; ++kk)
          acc = mfma16(ldf(&sm.KA[0][0], 136, si * 16 + fr, kk * 32 + fq * 8), ldf(&sm.QA[0][0], 136, ti * 16 + fr, kk * 32 + fq * 8), acc);
        const int t = ti * 16 + fr;
        float o4[4];
        if (mixer == 0) {
#pragma unroll
          for (int j = 0; j < 4; ++j) { int s_ = si * 16 + fq * 4 + j; o4[j] = (s_ <= t) ? acc[j] : 0.f; }
        } else if (mixer == 1) {
          float Gt = sm.sc[t][0];
#pragma unroll
          for (int j = 0; j < 4; ++j) { int s_ = si * 16 + fq * 4 + j; o4[j] = (s_ <= t) ? acc[j] * __expf(Gt - sm.sc[s_][0]) : 0.f; }
        } else {
          float Mt = sm.sc[t][2];
#pragma unroll
          for (int j = 0; j < 4; ++j) { int s_ = si * 16 + fq * 4 + j; o4[j] = (s_ <= t) ? acc[j] * QS * __expf(sm.sc[s_][1] - Mt) : 0.f; }
        }
        st4(&sm.ATT[t][si * 16 + fq * 4], o4[0], o4[1], o4[2], o4[3]);
      } else {
        int t = lane >> 2, s4 = (lane & 3) * 4; *(uint2*)&sm.ATT[t][16 + s4] = uint2{0u, 0u};
      }
    }
    __syncthreads();
    if (mixer == 1) {
      f32x4 acc[2];
      acc[0] = acc[1] = f32x4{0.f, 0.f, 0.f, 0.f};
#pragma unroll
      for (int kk = 0; kk < 4; ++kk) {
        bf16x8 a = ldf(&sm.KA[0][0], 136, rt_o * 16 + fr, kk * 32 + fq * 8);
#pragma unroll
        for (int c = 0; c < 2; ++c) acc[c] = mfma16(a, ldf(&sm.ST[0][0], 136, (cp_o * 2 + c) * 16 + fr, kk * 32 + fq * 8), acc[c]);
      }
#pragma unroll
      for (int c = 0; c < 2; ++c) {
        int v = (cp_o * 2 + c) * 16 + fr;
        float y4[4];
#pragma unroll
        for (int j = 0; j < 4; ++j) {
          int t = rt_o * 16 + fq * 4 + j;
          float kg = __expf(sm.sc[t][0]);
          y4[j] = sm.sc[t][1] * (bf2f(sm.u.gd.VF[t][v]) - kg * acc[c][j]);
        }
        st4(&sm.u.gd.YT[v][rt_o * 16 + fq * 4], y4[0], y4[1], y4[2], y4[3]);
      }
      {
        const int d0 = 2 * lane, t0 = w * 8;
        unsigned kda[4], kdb[4];
#pragma unroll
        for (int i = 0; i < 8; ++i) {
          unsigned kk2 = *(const unsigned*)&sm.KA[t0 + i][d0];
          float fct = sm.sc[t0 + i][3];
          unsigned kp = pack2(__uint_as_float(kk2 << 16) * fct, __uint_as_float(kk2 & 0xffff0000u) * fct);
          if (i & 1) { kda[i >> 1] |= (kp & 0xffffu) << 16; kdb[i >> 1] |= kp & 0xffff0000u; }
          else { kda[i >> 1] = kp & 0xffffu; kdb[i >> 1] = kp >> 16; }
        }
        *(uint4*)&sm.KDT[d0][t0] = uint4{kda[0], kda[1], kda[2], kda[3]};
        *(uint4*)&sm.KDT[d0 + 1][t0] = uint4{kdb[0], kdb[1], kdb[2], kdb[3]};
      }
      __syncthreads();
      {
        bf16x8 a = ldf(&sm.u.gd.TM[0][0], 40, rt_o * 16 + fr, fq * 8);
#pragma unroll
        for (int c = 0; c < 2; ++c) {
          int vt = cp_o * 2 + c;
          f32x4 vn = mfma16(a, ldf(&sm.u.gd.YT[0][0], 40, vt * 16 + fr, fq * 8), f32x4{0.f, 0.f, 0.f, 0.f});
          st4(&sm.XT[vt * 16 + fr][rt_o * 16 + fq * 4], vn[0], vn[1], vn[2], vn[3]);
        }
      }
      __syncthreads();
    } else if (mixer == 2) {
      int t = tid >> 3, part = tid & 7;
      float qn = 0.f;
#pragma unroll
      for (int e = 0; e < 16; ++e) qn += bf2f(sm.QA[t][part * 16 + e]) * sm.u.ml.nvec[part * 16 + e];
      float as = 0.f;
#pragma unroll
      for (int e = 0; e < 4; ++e) as += bf2f(sm.ATT[t][part * 4 + e]);
      float Mt = sm.sc[t][2];
      float den = QS * __expf(mcar - Mt) * qn + as;
      den += __shfl_xor(den, 1); den += __shfl_xor(den, 2); den += __shfl_xor(den, 4);
      if (part == 0) sm.sc[t][4] = 1.f / fmaxf(fabsf(den), __expf(-(sm.sc[t][0] + Mt)));
      __syncthreads();
    }
    {
      f32x4 acc[2];
      acc[0] = acc[1] = f32x4{0.f, 0.f, 0.f, 0.f};
      const u16* Qs = (mixer == 0) ? &sm.u.hg.QD[0][0] : &sm.QA[0][0];
#pragma unroll
      for (int kk = 0; kk < 4; ++kk) {
        bf16x8 qb = ldf(Qs, 136, rt_o * 16 + fr, kk * 32 + fq * 8);
#pragma unroll
        for (int c = 0; c < 2; ++c) acc[c] = mfma16(ldf(&sm.ST[0][0], 136, (cp_o * 2 + c) * 16 + fr, kk * 32 + fq * 8), qb, acc[c]);
      }
      const int t = rt_o * 16 + fr;
      float rs, fs;
      if (mixer == 0) { rs = 1.f; fs = 1.f; }
      else if (mixer == 1) { rs = __expf(sm.sc[t][0]); fs = 1.f; }
      else { rs = QS * __expf(mcar - sm.sc[t][2]); fs = sm.sc[t][4]; }
#pragma unroll
      for (int c = 0; c < 2; ++c)
#pragma unroll
        for (int j = 0; j < 4; ++j) acc[c][j] *= rs;
      {
        bf16x8 ab = ldf(&sm.ATT[0][0], 40, rt_o * 16 + fr, fq * 8);
#pragma unroll
        for (int c = 0; c < 2; ++c) acc[c] = mfma16(ldf(&sm.XT[0][0], 40, (cp_o * 2 + c) * 16 + fr, fq * 8), ab, acc[c]);
      }
      const int row = scan_row(bl, dir, pos0 + t);
      u16* dst = p.obuf + ((long)dir * TG + row) * 3072 + ocol;
#pragma unroll
      for (int c = 0; c < 2; ++c) {
        uint2 o; o.x = pack2(acc[c][0] * fs, acc[c][1] * fs); o.y = pack2(acc[c][2] * fs, acc[c][3] * fs);
        *(uint2*)(dst + (cp_o * 2 + c) * 16 + fq * 4) = o;
      }
    }
    __syncthreads();
    {
      float dsc = 1.f;
      if (mixer == 1) dsc = __expf(sm.sc[31][0]);
      else if (mixer == 2) dsc = __expf(mcar - sm.sc[31][2]);
#pragma unroll
      for (int rt = 0; rt < 2; ++rt) {
        if (mixer == 0) {
          float4 d4 = *(const float4*)&sm.u.hg.dec[w * 32 + rt * 16 + fq * 4];
#pragma unroll
          for (int ct = 0; ct < 4; ++ct) { S[rt][ct][0] *= d4.x; S[rt][ct][1] *= d4.y; S[rt][ct][2] *= d4.z; S[rt][ct][3] *= d4.w; }
        } else {
#pragma unroll
          for (int ct = 0; ct < 4; ++ct) { S[rt][ct][0] *= dsc; S[rt][ct][1] *= dsc; S[rt][ct][2] *= dsc; S[rt][ct][3] *= dsc; }
        }
        bf16x8 a = ldf(&sm.KDT[0][0], 40, w * 32 + rt * 16 + fr, fq * 8);
#pragma unroll
        for (int ct = 0; ct < 4; ++ct) {
          S[rt][ct] = mfma16(a, ldf(&sm.XT[0][0], 40, ct * 16 + fr, fq * 8), S[rt][ct]);
          st4(&sm.ST[ct * 16 + fr][w * 32 + rt * 16 + fq * 4], S[rt][ct][0], S[rt][ct][1], S[rt][ct][2], S[rt][ct][3]);
        }
      }
      if (mixer == 2) {
        if (tid < 128) {
          float sum = 0.f;
#pragma unroll
          for (int e = 0; e < 32; ++e) sum += bf2f(sm.KDT[tid][e]);
          sm.u.ml.nvec[tid] = dsc * sm.u.ml.nvec[tid] + sum;
        }
        mcar = mnew;
      }
    }
    __syncthreads();
  }
}

struct PrepW { float NM[32][36]; float TS[3][16][20]; float G[32]; float B[32]; };
__device__ __forceinline__ bf16x8 asbf(const uint4& u) { return __builtin_bit_cast(bf16x8, u); }
__device__ void ph_gdn_prep(const Params& p, int l, char* smem) {
  const int tid = otid();
  const int lane = tid & 63, w = tid >> 6, fr = lane & 15, fq = lane >> 4;
  PrepW& sw = ((PrepW*)smem)[w];
  const int gw = blockIdx.x * 4 + w, nw = gridDim.x * 4;
  for (int task = gw; task < 2304; task += nw) {
    const int chunk = task % 72, r = task / 72, dir = r & 1, h = (r >> 1) & 3, bl = r >> 3;
    const int tk = lane & 31;
    const float* gp = p.gates + (long)scan_row(bl, dir, chunk * 32 + tk) * GLD;
    float ig = gp[32 + dir * 4 + h] + p.ml_i_bias[l * 8 + dir * 4 + h];
    float F = -softplusf_(-(gp[40 + dir * 4 + h] + p.ml_f_bias[l * 8 + dir * 4 + h]));
#pragma unroll
    for (int o = 1; o < 32; o <<= 1) { float t2 = __shfl_up(F, o); if (tk >= o) F += t2; }
    float a = ig - F;
    float pm = a;
#pragma unroll
    for (int o = 1; o < 32; o <<= 1) { float t2 = __shfl_up(pm, o); if (tk >= o) pm = fmaxf(pm, t2); }
    if (lane < 32) { float* o_ = p.mprep + (long)task * 96; o_[tk] = F; o_[32 + tk] = a; o_[64 + tk] = pm; }
  }
  for (int task = gw; task < 4608; task += nw) {
    const int chunk = task % 72, r = task / 72, dir = r & 1, h = (r >> 1) & 7, bl = r >> 4;
    const int pos0 = chunk * 32;
    const float gA = -__expf(p.gdn_a_log[l * 16 + dir * 8 + h]), gDt = p.gdn_dt_bias[l * 16 + dir * 8 + h];
    uint4 kf[2][4], qf[2][4];
#pragma unroll
    for (int rt = 0; rt < 2; ++rt) {
      const u16* pr = p.proj + (long)scan_row(bl, dir, pos0 + rt * 16 + fr) * PLD + h * 128 + fq * 8;
#pragma unroll
      for (int kk = 0; kk < 4; ++kk) { kf[rt][kk] = *(const uint4*)(pr + C_GK + kk * 32); qf[rt][kk] = *(const uint4*)(pr + C_GQ + kk * 32); }
    }
    const int tk = lane & 31;
    float beta, G;
    {
      const float* gp = p.gates + (long)scan_row(bl, dir, pos0 + tk) * GLD;
      beta = sigmoidf_(gp[dir * 8 + h]);
      G = gA * softplusf_(gp[16 + dir * 8 + h] + gDt);
#pragma unroll
      for (int o = 1; o < 32; o <<= 1) { float t2 = __shfl_up(G, o); if (tk >= o) G += t2; }
      if (lane < 32) { sw.G[tk] = G; sw.B[tk] = beta; }
    }
    u16* outT = p.gprep + (long)task * 2176;
    u16* outA = outT + 1024;
    float* outS = (float*)(outT + 2048);
    if (lane < 32) { outS[tk] = G; outS[32 + tk] = beta; }
#pragma unroll
    for (int ti_ = 0; ti_ < 3; ++ti_) {
      const int ai = ti_ == 0 ? 0 : 1, bi = ti_ == 2 ? 1 : 0;
      f32x4 acc = f32x4{0.f, 0.f, 0.f, 0.f};
#pragma unroll
      for (int kk = 0; kk < 4; ++kk) acc = mfma16(asbf(kf[ai][kk]), asbf(kf[bi][kk]), acc);
      const int b = bi * 16 + fr;
      const float Gb = sw.G[b];
#pragma unroll
      for (int j = 0; j < 4; ++j) {
        int a = ai * 16 + fq * 4 + j;
        if (a > b) sw.NM[a][b] = sw.B[a] * acc[j] * __expf(sw.G[a] - Gb);
      }
    }
#pragma unroll
    for (int ti_ = 0; ti_ < 3; ++ti_) {
      const int si = ti_ == 2 ? 1 : 0, ti = ti_ == 0 ? 0 : 1;
      f32x4 acc = f32x4{0.f, 0.f, 0.f, 0.f};
#pragma unroll
      for (int kk = 0; kk < 4; ++kk) acc = mfma16(asbf(kf[si][kk]), asbf(qf[ti][kk]), acc);
      const int t = ti * 16 + fr;
      const float Gt = sw.G[t];
      float o4[4];
#pragma unroll
      for (int j = 0; j < 4; ++j) { int s_ = si * 16 + fq * 4 + j; o4[j] = (s_ <= t) ? acc[j] * __expf(Gt - sw.G[s_]) : 0.f; }
      st4(outA + t * 32 + si * 16 + fq * 4, o4[0], o4[1], o4[2], o4[3]);
    }
    { int t = lane >> 2, s4 = (lane & 3) * 4; *(uint2*)(outA + t * 32 + 16 + s4) = uint2{0u, 0u}; }
    {
      const int blk = (lane >> 4) & 1, c = lane & 15;
      float Tc[16];
#pragma unroll
      for (int t = 0; t < 16; ++t) {
        float v = (t == c) ? 1.f : 0.f;
#pragma unroll
        for (int s4 = 0; s4 < (t + 3) / 4; ++s4) {
          float4 n4 = *(const float4*)&sw.NM[blk * 16 + t][blk * 16 + s4 * 4];
          if (s4 * 4 + 0 < t) v -= n4.x * Tc[s4 * 4 + 0];
          if (s4 * 4 + 1 < t) v -= n4.y * Tc[s4 * 4 + 1];
          if (s4 * 4 + 2 < t) v -= n4.z * Tc[s4 * 4 + 2];
          if (s4 * 4 + 3 < t) v -= n4.w * Tc[s4 * 4 + 3];
        }
        Tc[t] = v;
        if (lane < 32) {
          sw.TS[blk][t][c] = v;
          outT[(blk * 16 + t) * 32 + blk * 16 + c] = f2bf(v);
          if (blk == 0) outT[t * 32 + 16 + c] = 0;
        }
        __builtin_amdgcn_sched_barrier(0);
      }
    }
    {
      const int a = lane >> 2, c4 = (lane & 3) * 4;
      float w0 = 0.f, w1 = 0.f, w2 = 0.f, w3 = 0.f;
#pragma unroll
      for (int s4 = 0; s4 < 4; ++s4) {
        float4 n4 = *(const float4*)&sw.NM[16 + a][s4 * 4];
        float nn[4] = {n4.x, n4.y, n4.z, n4.w};
#pragma unroll
        for (int k = 0; k < 4; ++k) {
          float4 t4 = *(const float4*)&sw.TS[0][s4 * 4 + k][c4];
          w0 += nn[k] * t4.x; w1 += nn[k] * t4.y; w2 += nn[k] * t4.z; w3 += nn[k] * t4.w;
        }
      }
      *(float4*)&sw.TS[2][a][c4] = float4{w0, w1, w2, w3};
    }
    {
      const int t = lane >> 2, c4 = (lane & 3) * 4;
      float r0 = 0.f, r1 = 0.f, r2 = 0.f, r3 = 0.f;
#pragma unroll
      for (int a4 = 0; a4 < 4; ++a4) {
        float4 q4 = *(const float4*)&sw.TS[1][t][a4 * 4];
        float qq[4] = {q4.x, q4.y, q4.z, q4.w};
#pragma unroll
        for (int k = 0; k < 4; ++k) {
          float4 w4 = *(const float4*)&sw.TS[2][a4 * 4 + k][c4];
          r0 += qq[k] * w4.x; r1 += qq[k] * w4.y; r2 += qq[k] * w4.z; r3 += qq[k] * w4.w;
        }
      }
      st4(outT + (16 + t) * 32 + c4, -r0, -r1, -r2, -r3);
    }
  }
}

__device__ void ph_scan(const Params& p, int l, int g, char* smem) {
  const int b = blockIdx.x;
  __shared__ int tb_s[2];
  int u0, ustep;
  if (gridDim.x == 512) {
    ustep = 512;
    u0 = b < 128 ? 128 + b : (b < 256 ? b - 128 : (b < 384 ? b : 384));
  } else { u0 = b; ustep = gridDim.x; }
  for (int u = u0; u < 384; u += ustep) scan_unit_mma(p, l, g, u, *(CSmem*)smem);
  __syncthreads();
  unsigned* ctr = p.bar + XB_CTR(l * 4 + g);
  for (int it = 0;; ++it) {
    if (threadIdx.x == 0) tb_s[it & 1] = (int)atomicAdd(ctr, 1u);
    __syncthreads();
    const int tb = tb_s[it & 1];
    if (tb >= QB_END) break;
    gemm_in_b_tile(p, l, smem, tb);
  }
}

__device__ void ph_brfin(const Params& p, int l, int g) {
  const int tid = otid();
  const int lane = tid & 63;
  const int gw = blockIdx.x * 4 + (tid >> 6), nw = gridDim.x * 4;
  uint4 na0, na1, nb0, nb1, nz0, nz1, ng0, ng1;
  float4 no0, no1, no2, no3;
  const uint4 zz = uint4{0u, 0u, 0u, 0u};
  na0 = na1 = nb0 = nb1 = nz0 = nz1 = ng0 = ng1 = zz;
  no0 = no1 = no2 = no3 = float4{0.f, 0.f, 0.f, 0.f};
#define BR_LOAD(J)                                                                                           \
  if ((J) < TG * 3) {                                                                                        \
    const int _mx = (J) / TG, _row = (J) % TG;                                                               \
    if (!(l == 1 && (_row % TPB) < CTX)) {                                                                   \
      const u16* _of = p.obuf + (long)_row * 3072 + _mx * 1024 + lane * 16;                                  \
      const u16* _ob = _of + (long)TG * 3072;                                                                \
      na0 = *(const uint4*)_of; na1 = *(const uint4*)(_of + 8);                                              \
      nb0 = *(const uint4*)_ob; nb1 = *(const uint4*)(_ob + 8);                                              \
      const int _zc = _mx == 0 ? C_HGZ : (_mx == 1 ? C_GZ : C_MZ);                                           \
      const u16* _zp = p.proj + (long)_row * PLD + _zc + lane * 16;                                          \
      nz0 = *(const uint4*)_zp; nz1 = *(const uint4*)(_zp + 8);                                              \
      if (_mx == 2) { const u16* _gp = p.proj + (long)_row * PLD + C_MO + lane * 16;                         \
                      ng0 = *(const uint4*)_gp; ng1 = *(const uint4*)(_gp + 8); }                            \
      const float4* _on = (const float4*)((_mx == 0 ? p.hg_onorm : (_mx == 1 ? p.gdn_onorm : p.ml_onorm)) + l * D + lane * 16); \
      no0 = _on[0]; no1 = _on[1]; no2 = _on[2]; no3 = _on[3];                                                \
    }                                                                                                        \
  }
  BR_LOAD(gw)
  for (int j = gw; j < TG * 3; j += nw) {
    const uint4 a0 = na0, a1 = na1, b0 = nb0, b1 = nb1, z0 = nz0, z1 = nz1, g0 = ng0, g1 = ng1;
    const float4 o0 = no0, o1 = no1, o2 = no2, o3 = no3;
    BR_LOAD(j + nw)
    const int mixer = j / TG, row = j % TG;
    if (l == 1 && (row % TPB) < CTX) continue;
    float o[16], t8[8];
    unpack8(a0, o); unpack8(a1, o + 8);
    unpack8(b0, t8);
#pragma unroll
    for (int e = 0; e < 8; ++e) o[e] += t8[e];
    unpack8(b1, t8);
#pragma unroll
    for (int e = 0; e < 8; ++e) o[8 + e] += t8[e];
    float ss = 0.f;
#pragma unroll
    for (int e = 0; e < 16; ++e) ss += o[e] * o[e];
    ss += __shfl_xor(ss, 1); ss += __shfl_xor(ss, 2); ss += __shfl_xor(ss, 4);
    float hd = 128.f;
    if (mixer == 2) { ss += __shfl_xor(ss, 8); hd = 256.f; }
    float rs = rsqrtf(ss / hd + 1e-6f);
    const float on[16] = {o0.x, o0.y, o0.z, o0.w, o1.x, o1.y, o1.z, o1.w, o2.x, o2.y, o2.z, o2.w, o3.x, o3.y, o3.z, o3.w};
    float z[16];
    unpack8(z0, z); unpack8(z1, z + 8);
    float res[16];
#pragma unroll
    for (int e = 0; e < 16; ++e) res[e] = o[e] * rs * on[e] * siluf_(z[e]);
    if (mixer == 2) {
      unpack8(g0, z); unpack8(g1, z + 8);
#pragma unroll
      for (int e = 0; e < 16; ++e) res[e] *= sigmoidf_(z[e]);
    }
    uint4 w0, w1;
    w0.x = pack2(res[0], res[1]); w0.y = pack2(res[2], res[3]); w0.z = pack2(res[4], res[5]); w0.w = pack2(res[6], res[7]);
    w1.x = pack2(res[8], res[9]); w1.y = pack2(res[10], res[11]); w1.z = pack2(res[12], res[13]); w1.w = pack2(res[14], res[15]);
    u16* dst = p.obuf + (long)row * 3072 + mixer * 1024 + lane * 16;
    *(uint4*)dst = w0; *(uint4*)(dst + 8) = w1;
  }
#undef BR_LOAD
}

__device__ void ph_gemm_merge(const Params& p, int l, char* smem) {
  for (int t = blockIdx.x; t < 72 * 8; t += gridDim.x) {
    int nt = t / 72, mt = t % 72;
    if (l == 1 && (mt % 18) < 2) continue;
    f32x4 tot[4][4];
#pragma unroll
    for (int m = 0; m < 4; ++m)
#pragma unroll
      for (int n = 0; n < 4; ++n) tot[m][n] = f32x4{0.f, 0.f, 0.f, 0.f};
    for (int i = 0; i < 3; ++i) {
      f32x4 acc[4][4];
#pragma unroll
      for (int m = 0; m < 4; ++m)
#pragma unroll
        for (int n = 0; n < 4; ++n) acc[m][n] = f32x4{0.f, 0.f, 0.f, 0.f};
      gemm_kloopT<4, 4>(p.obuf + (long)mt * 128 * 3072 + i * 1024, 3072, 32, p.WbrT + (long)i * D * D + (long)nt * 128 * 32, 32, (long)D * 32, D, smem, acc);
      const int tid2 = otid();
      const int wr = (tid2 >> 7) & 1, wc = (tid2 >> 6) & 1, fr = tid2 & 15, fq = (tid2 >> 4) & 3;
#pragma unroll
      for (int m = 0; m < 4; ++m) {
        int row = mt * 128 + wr * 64 + m * 16 + fr;
#pragma unroll
        for (int n = 0; n < 4; ++n) {
          int col = nt * 128 + wc * 64 + n * 16 + fq * 4;
          uint2 gr = *(const uint2*)(p.proj + (long)row * PLD + C_GATE + i * 1024 + col);
          tot[m][n][0] += sigmoidf_(__uint_as_float(gr.x << 16)) * acc[m][n][0];
          tot[m][n][1] += sigmoidf_(__uint_as_float(gr.x & 0xffff0000u)) * acc[m][n][1];
          tot[m][n][2] += sigmoidf_(__uint_as_float(gr.y << 16)) * acc[m][n][2];
          tot[m][n][3] += sigmoidf_(__uint_as_float(gr.y & 0xffff0000u)) * acc[m][n][3];
        }
      }
    }
    const int tid3 = otid();
    const int wr = (tid3 >> 7) & 1, wc = (tid3 >> 6) & 1, fr = tid3 & 15, fq = (tid3 >> 4) & 3;
#pragma unroll
    for (int m = 0; m < 4; ++m) {
      int row = mt * 128 + wr * 64 + m * 16 + fr;
#pragma unroll
      for (int n = 0; n < 4; ++n) {
        int col = nt * 128 + wc * 64 + n * 16 + fq * 4;
        uint2 o; o.x = pack2(tot[m][n][0], tot[m][n][1]); o.y = pack2(tot[m][n][2], tot[m][n][3]);
        *(uint2*)(p.obuf + (long)TG * 3072 + (long)row * D + col) = o;
      }
    }
  }
}

__device__ void ph_gemm_out(const Params& p, int l, int g, char* smem) {
  for (int t = (int)gridDim.x - 1 - (int)blockIdx.x; t < 72 * 8; t += gridDim.x) {
    int nt = t / 72, mt = t % 72;
    if (l == 1 && (mt % 18) < 2) continue;
    f32x4 acc[4][4];
#pragma unroll
    for (int m = 0; m < 4; ++m)
#pragma unroll
      for (int n = 0; n < 4; ++n) acc[m][n] = f32x4{0.f, 0.f, 0.f, 0.f};
    gemm_kloopT<4, 4>(p.obuf + (long)TG * 3072 + (long)mt * 128 * D, D, 32, p.WoT + (long)nt * 128 * 32, 32, (long)D * 32, D, smem, acc);
    const int tid = otid();
    const int wr = (tid >> 7) & 1, wc = (tid >> 6) & 1, fr = tid & 15, fq = (tid >> 4) & 3;
#pragma unroll
    for (int m = 0; m < 4; ++m) {
      int row = mt * 128 + wr * 64 + m * 16 + fr;
      int bl = row / TPB, pp = row % TPB, b = g * GB + bl;
      const float* src; float* dst; int mrow;
      if (pp < CTX) { src = p.ctx + ((long)b * CTX + pp) * D; dst = p.ctxs + ((long)b * CTX + pp) * D; mrow = 16; }
      else { long off = ((long)b * SEQ + (pp - CTX)) * D; src = (l == 0 ? p.x : p.out) + off; dst = p.out + off; mrow = b; }
      const float* gt = p.mod + ((long)l * 17 + mrow) * 3072 + 2048;
#pragma unroll
      for (int n = 0; n < 4; ++n) {
        int col = nt * 128 + wc * 64 + n * 16 + fq * 4;
        float4 xv = *(const float4*)(src + col), gv = *(const float4*)(gt + col);
        float4 o;
        o.x = xv.x + gv.x * acc[m][n][0]; o.y = xv.y + gv.y * acc[m][n][1];
        o.z = xv.z + gv.z * acc[m][n][2]; o.w = xv.w + gv.w * acc[m][n][3];
        *(float4*)(dst + col) = o;
      }
    }
  }
}

__device__ void ph_final(const Params& p) {
  const int tid = otid();
  const int lane = tid & 63;
  const int gw = blockIdx.x * 4 + (tid >> 6), nw = gridDim.x * 4;
  for (int row = gw; row < NB * SEQ; row += nw) {
    float4* src = (float4*)(p.out + (long)row * D);
    float4 v[4]; float ss = 0.f;
#pragma unroll
    for (int i = 0; i < 4; ++i) {
      v[i] = src[lane + 64 * i];
      ss += v[i].x * v[i].x + v[i].y * v[i].y + v[i].z * v[i].z + v[i].w * v[i].w;
    }
    ss = wave_sum(ss);
    float rs = rsqrtf(ss * (1.f / D) + 1e-6f);
#pragma unroll
    for (int i = 0; i < 4; ++i) {
      float4 g4 = ((const float4*)p.final_g)[lane + 64 * i];
      float4 o; o.x = v[i].x * rs * g4.x; o.y = v[i].y * rs * g4.y; o.z = v[i].z * rs * g4.z; o.w = v[i].w * rs * g4.w;
      src[lane + 64 * i] = o;
    }
  }
}


#define XB_TMO      128
#define XB_XCNT(j)  (256  + 64 * (j))
#define XB_XSUB(j)  (1280 + 64 * (j))
#define XB_XGEN(j)  (2304 + 64 * (j))
#define XB_TOP      3328
#define XB_TOPGEN   3392
#define XCD_BAR_WORDS 3456
#define XB_SPIN_CAP (1u << 22)
#define LAS __attribute__((address_space(3)))
__device__ __forceinline__ unsigned xb_ld(unsigned* p) { return __hip_atomic_load(p, __ATOMIC_RELAXED, __HIP_MEMORY_SCOPE_AGENT); }
__device__ __forceinline__ unsigned xb_add(unsigned* p, unsigned v) { return __hip_atomic_fetch_add(p, v, __ATOMIC_RELAXED, __HIP_MEMORY_SCOPE_AGENT); }
__device__ __forceinline__ unsigned xb_xcc_id() { return (unsigned)__builtin_amdgcn_s_getreg((3 << 11) | 20) & 0xFu; }
#define XB_SPIN(cond, bar) do { unsigned _sp = 0; while (cond) { __builtin_amdgcn_s_sleep(1); \
    if ((++_sp & 255u) == 0u) { if (xb_ld(&(bar)[XB_TMO])) break; if (_sp > XB_SPIN_CAP) { atomicAdd(&(bar)[XB_TMO], 1u); break; } } } } while (0)
struct XcdBarrier { unsigned* bar; unsigned x; volatile LAS unsigned* st; };
__device__ __forceinline__ XcdBarrier xcd_barrier_post(unsigned* bar, volatile LAS unsigned* st) {
  XcdBarrier b; b.bar = bar; b.x = xb_xcc_id(); b.st = st;
  if (threadIdx.x == 0) (void)xb_add(&bar[XB_XCNT(b.x)], 1u);
  return b;
}
__device__ __forceinline__ void xcd_barrier_complete(unsigned* bar, unsigned x, unsigned& nloc, unsigned& nx) {
  const unsigned G = gridDim.x * gridDim.y * gridDim.z;
  unsigned sum, cnt, mine, sp = 0u;
  for (;;) {
    sum = 0u; cnt = 0u; mine = 0u;
#pragma unroll
    for (unsigned j = 0; j < 16; ++j) { const unsigned c = xb_ld(&bar[XB_XCNT(j)]); sum += c; cnt += (c > 0u) ? 1u : 0u; mine = (j == x) ? c : mine; }
    if (sum == G) break;
    __builtin_amdgcn_s_sleep(1);
    if ((++sp & 255u) == 0u) { if (xb_ld(&bar[XB_TMO])) break; if (sp > XB_SPIN_CAP) { atomicAdd(&bar[XB_TMO], 1u); break; } }
  }
  nloc = mine > 0u ? mine : 1u; nx = cnt > 0u ? cnt : 1u;
}
__device__ __forceinline__ void xcd_barrier(const XcdBarrier& b) {
  asm volatile("s_waitcnt vmcnt(0)" ::: "memory");
  __syncthreads();
  if (threadIdx.x == 0) {
    unsigned* bar = b.bar;
    __builtin_amdgcn_s_waitcnt(0);
    unsigned nloc = b.st[0], nx = b.st[1];
    if (nloc == 0u) { xcd_barrier_complete(bar, b.x, nloc, nx); b.st[0] = nloc; b.st[1] = nx; }
    const unsigned old = xb_add(&bar[XB_XSUB(b.x)], 1u);
    const unsigned gen = old / nloc;
    if (old + 1u == (gen + 1u) * nloc) {
      __builtin_amdgcn_fence(__ATOMIC_RELEASE, "agent");
      asm volatile("s_waitcnt vmcnt(0)" ::: "memory");
      const unsigned og = xb_add(&bar[XB_TOP], 1u);
      const unsigned tg = og / nx;
      if (og + 1u == (tg + 1u) * nx) xb_add(&bar[XB_TOPGEN], 1u);
      else XB_SPIN(xb_ld(&bar[XB_TOPGEN]) == tg, bar);
      __builtin_amdgcn_fence(__ATOMIC_ACQUIRE, "agent");
      xb_add(&bar[XB_XGEN(b.x)], 1u);
      asm volatile("s_waitcnt vmcnt(0)" ::: "memory");
    } else {
      XB_SPIN(xb_ld(&bar[XB_XGEN(b.x)]) == gen, bar);
      __builtin_amdgcn_fence(__ATOMIC_ACQUIRE, "agent");
      asm volatile("s_waitcnt vmcnt(0)" ::: "memory");
    }
  }
  __syncthreads();
}

#if !COOP
#error multi-launch path removed
#else
__global__ void __launch_bounds__(256, 2) k_mega(Params p) {
  __shared__ __attribute__((aligned(16))) char smem[74240];
  __shared__ uint4 xb_words;
  cg::grid_group grid = cg::this_grid();
  if (threadIdx.x == 0) xb_words = make_uint4(0u, 0u, 0u, 0u);
  __syncthreads();
  XcdBarrier xb = xcd_barrier_post(p.bar, (volatile LAS unsigned*)&xb_words);
#define GSYNC() xcd_barrier(xb)
  ph_prep_small(p);
  ph_mod(p, smem);
  if (xb_ld(&p.bar[XB_TMO]) == 0x7fffffffu) grid.sync();
#pragma unroll 1
  for (int l = 0; l < 2; ++l) {
    ph_convert(p, l, smem);
    GSYNC();
#pragma unroll 1
    for (int g = 0; g < NGRP; ++g) {
      if (l == 0 && g == 0) { ph_prenorm(p, 0, 0); GSYNC(); }
      if (g == 0) { ph_gemm_in_a(p, l, smem); GSYNC(); }
      ph_conv(p, l); GSYNC();
      ph_gdn_prep(p, l, smem); GSYNC();
      ph_scan(p, l, g, smem); GSYNC();
      ph_brfin(p, l, g);
      if (g + 1 < NGRP) ph_prenorm(p, l, g + 1); else if (l == 0) ph_prenorm(p, 1, 0);
      GSYNC();
      ph_gemm_merge(p, l, smem); GSYNC();
      ph_gemm_out(p, l, g, smem);
      if (g + 1 < NGRP) ph_gemm_in_a(p, l, smem);
      GSYNC();
    }
  }
  ph_final(p);
}
#endif

extern "C" void kernel_launch(void* const* d_in, const int* in_sizes, int n_in, void* d_out, int out_size, void* d_ws,
                              size_t ws_size, hipStream_t stream) {
  Params p{};
  p.x = (const float*)d_in[0]; p.c = (const float*)d_in[1]; p.ctx = (const float*)d_in[2]; p.c_ctx = (const float*)d_in[3];
  p.ada_w = (const float*)d_in[4]; p.ada_b = (const float*)d_in[5]; p.norm_g = (const float*)d_in[6]; p.w_in = (const float*)d_in[7];
  p.hg_lb = (const float*)d_in[8]; p.hg_onorm = (const float*)d_in[9]; p.gdn_conv = (const float*)d_in[10];
  p.gdn_a_log = (const float*)d_in[11]; p.gdn_dt_bias = (const float*)d_in[12]; p.gdn_onorm = (const float*)d_in[13];
  p.ml_i_bias = (const float*)d_in[14]; p.ml_f_bias = (const float*)d_in[15]; p.ml_onorm = (const float*)d_in[16];
  p.w_branch = (const float*)d_in[17]; p.w_out = (const float*)d_in[18]; p.final_g = (const float*)d_in[19];
  p.out = (float*)d_out;
  char* ws = (char*)d_ws;
  size_t off = 0;
  auto take = [&](size_t bytes) { char* r = ws + off; off += (bytes + 255) & ~(size_t)255; return r; };
  p.WinT = (u16*)take((size_t)NPAD * D * 2);
  p.WbrT = (u16*)take((size_t)3 * D * D * 2);
  p.WoT = (u16*)take((size_t)D * D * 2);
  p.hbuf = (u16*)take((size_t)TG * D * 2);
  p.proj = (u16*)take((size_t)TG * PLD * 2);
  p.obuf = (u16*)take((size_t)2 * TG * 3072 * 2);
  p.mod = (float*)take((size_t)2 * 17 * 3072 * 4);
  p.lb = (float*)take((size_t)2 * D * 4);
  p.silc = (float*)take((size_t)17 * D * 4);
  p.gates = (float*)take((size_t)TG * GLD * 4);
  p.ctxs = (float*)take((size_t)NB * CTX * D * 4);
  p.bar = (unsigned*)take((size_t)BAR_TOTAL_WORDS * 4);
  p.gprep = (u16*)take((size_t)4608 * 4352);
  p.mprep = (float*)take((size_t)2304 * 96 * 4);
  if (off > ws_size) { fprintf(stderr, "workspace too small: need %zu have %zu\n", off, ws_size); return; }

  static int grid_blocks = 0;
  if (!grid_blocks) {
    int dev = 0, cus = 0, per_cu = 0;
    hipGetDevice(&dev);
    hipDeviceGetAttribute(&cus, hipDeviceAttributeMultiprocessorCount, dev);
#if COOP
    hipOccupancyMaxActiveBlocksPerMultiprocessor(&per_cu, k_mega, 256, 0);
#else
    hipOccupancyMaxActiveBlocksPerMultiprocessor(&per_cu, k_step, 256, 0);
#endif
    if (per_cu < 1) per_cu = 1;
    if (per_cu > 2) per_cu = 2;
    grid_blocks = cus * per_cu;
  }
#if COOP
  hipMemsetAsync(p.bar, 0, (size_t)BAR_TOTAL_WORDS * 4, stream);
  void* args[] = {&p};
  hipError_t e = hipLaunchCooperativeKernel((void*)k_mega, dim3(grid_blocks), dim3(256), args, 0, stream);
  if (e != hipSuccess) fprintf(stderr, "cooperative launch failed: %s (grid %d)\n", hipGetErrorString(e), grid_blocks);
#else
  for (int s = 0; s < NSTEPS; ++s) k_step<<<grid_blocks, 256, 0, stream>>>(p, s);
#endif
}
```
